# Optimizing an MI355X kernel written in HIP

```python
import math
import jax, jax.numpy as jnp
from jax import lax
import numpy as np

D_MODEL = 1024
BATCH = 16
SEQ = 2048
DEPTH = 1

PLE_DIM = 256
WIDTH_A = 1024
CONV_A = 3
WIDTH_B = 1024
CONV_B = 31
N_GROUPS = 4
EXPERTS_PER_GROUP = 8
N_EXPERTS = N_GROUPS * EXPERTS_PER_GROUP
TOP_K_IN_GROUP = 2
D_EXPERT = 512
ROW_BLOCK = 128
EPS = 1e-6
IN_COLS = 3 * WIDTH_A + 2 * WIDTH_B + 2 * D_MODEL

kernel_name = "hybrid_conv_conformer_hiermoe_ple"


def rmsnorm(x, g):
    xf = x.astype(jnp.float32)
    y = xf * lax.rsqrt(jnp.mean(xf * xf, axis=-1, keepdims=True) + EPS)
    return (y * g.astype(jnp.float32)).astype(x.dtype)


def layernorm(x, g, b):
    xf = x.astype(jnp.float32)
    mu = jnp.mean(xf, axis=-1, keepdims=True)
    var = jnp.mean(jnp.square(xf - mu), axis=-1, keepdims=True)
    y = (xf - mu) * lax.rsqrt(var + EPS)
    return (y * g.astype(jnp.float32) + b.astype(jnp.float32)).astype(x.dtype)


def causal_dwconv(u, w):
    k, c = w.shape
    return lax.conv_general_dilated(
        u, w.astype(u.dtype)[:, None, :], window_strides=(1,), padding=[(k - 1, 0)],
        dimension_numbers=("NWC", "WIO", "NWC"), feature_group_count=c)


def token_mixer(h, w_in, conv_a_w, w_out_a, conv_b_w, conv_b_b, ln_b_g, ln_b_b, w_out_b, b_gate, w_o):
    proj = h @ w_in
    cuts = [WIDTH_A, 2 * WIDTH_A, 3 * WIDTH_A, 3 * WIDTH_A + WIDTH_B, 3 * WIDTH_A + 2 * WIDTH_B]
    a_b, a_c, a_x, c_val, c_gate, gates = jnp.split(proj, cuts, axis=-1)
    y_a = (a_b * causal_dwconv(a_c * a_x, conv_a_w)) @ w_out_a
    u = c_val * jax.nn.sigmoid(c_gate)
    u = causal_dwconv(u, conv_b_w) + conv_b_b
    u = jax.nn.silu(layernorm(u, ln_b_g, ln_b_b))
    y_b = u @ w_out_b
    g = jax.nn.sigmoid(gates + b_gate)
    g_a, g_b = jnp.split(g, 2, axis=-1)
    return (g_a * y_a + g_b * y_b) @ w_o


def hierarchical_moe(h, w_rg, b_rg, w_re, b_re, w_gate, w_up, w_down):
    bsz, seq, d = h.shape
    t = bsz * seq
    hf = h.reshape(t, d)
    g_logits = (hf @ w_rg + b_rg).astype(jnp.float32)
    g_prob = jax.nn.softmax(g_logits, axis=-1)
    grp = jnp.argmax(g_logits, axis=-1).astype(jnp.int32)
    p_grp = jnp.take_along_axis(g_prob, grp[:, None], axis=-1)
    e_logits = (hf @ w_re + b_re).astype(jnp.float32).reshape(t, N_GROUPS, EXPERTS_PER_GROUP)
    e_logits = jnp.take_along_axis(e_logits, grp[:, None, None], axis=1)[:, 0]
    top_v, top_i = lax.top_k(e_logits, TOP_K_IN_GROUP)
    gate_w = jax.nn.softmax(top_v, axis=-1) * p_grp
    expert_id = grp[:, None] * EXPERTS_PER_GROUP + top_i.astype(jnp.int32)

    n_assign = t * TOP_K_IN_GROUP
    flat_e = expert_id.reshape(n_assign)
    flat_w = gate_w.reshape(n_assign)
    order = jnp.argsort(flat_e)
    sorted_e = flat_e[order]
    tok = order // TOP_K_IN_GROUP
    counts = jnp.bincount(flat_e, length=N_EXPERTS)
    padded = (counts + ROW_BLOCK - 1) // ROW_BLOCK * ROW_BLOCK
    start = jnp.cumsum(counts) - counts
    pad_end = jnp.cumsum(padded)
    pad_start = pad_end - padded
    dest = pad_start[sorted_e] + (jnp.arange(n_assign, dtype=jnp.int32) - start[sorted_e])
    n_blocks = -(-(n_assign + N_EXPERTS * (ROW_BLOCK - 1)) // ROW_BLOCK)
    buf = jnp.zeros((n_blocks * ROW_BLOCK, d), hf.dtype).at[dest].set(hf[tok])
    block_start = jnp.arange(n_blocks, dtype=jnp.int32) * ROW_BLOCK
    block_expert = jnp.minimum(jnp.searchsorted(pad_end, block_start, side="right"), N_EXPERTS - 1)

    def expert_block(args):
        xb, e = args
        a = xb @ w_gate[e]
        b = xb @ w_up[e]
        return (jax.nn.silu(a) * b) @ w_down[e]

    y_buf = lax.map(expert_block, (buf.reshape(n_blocks, ROW_BLOCK, d), block_expert)).reshape(-1, d)
    y = y_buf[dest] * flat_w[order][:, None].astype(hf.dtype)
    out = jax.ops.segment_sum(y, tok, num_segments=t)
    return out.reshape(bsz, seq, d)


def setup_inputs(seed: int = 0) -> dict:
    key = jax.random.key(seed)
    ks = jax.random.split(key, 32)
    n = lambda k, shape, s: jax.random.normal(k, shape, jnp.float32) * s
    L, D = DEPTH, D_MODEL
    return {
        "x": n(ks[0], (BATCH, SEQ, D), 1.0),
        "p": n(ks[1], (DEPTH, BATCH, SEQ, PLE_DIM), 1.0),
        "mix_norm_g": 1.0 + n(ks[2], (L, D), 0.02),
        "w_in": n(ks[3], (L, D, IN_COLS), D ** -0.5),
        "conv_a_w": n(ks[4], (L, CONV_A, WIDTH_A), CONV_A ** -0.5),
        "w_out_a": n(ks[5], (L, WIDTH_A, D), WIDTH_A ** -0.5),
        "conv_b_w": n(ks[6], (L, CONV_B, WIDTH_B), CONV_B ** -0.5),
        "conv_b_b": n(ks[7], (L, WIDTH_B), 0.02),
        "ln_b_g": 1.0 + n(ks[8], (L, WIDTH_B), 0.02),
        "ln_b_b": n(ks[9], (L, WIDTH_B), 0.02),
        "w_out_b": n(ks[10], (L, WIDTH_B, D), WIDTH_B ** -0.5),
        "b_gate": n(ks[11], (L, 2 * D), 0.02),
        "w_o": n(ks[12], (L, D, D), D ** -0.5),
        "ffn_norm_g": 1.0 + n(ks[13], (L, D), 0.02),
        "w_router_group": n(ks[14], (L, D, N_GROUPS), D ** -0.5),
        "b_router_group": n(ks[15], (L, N_GROUPS), 0.01),
        "w_router_expert": n(ks[16], (L, D, N_EXPERTS), D ** -0.5),
        "b_router_expert": n(ks[17], (L, N_EXPERTS), 0.01),
        "w_exp_gate": n(ks[18], (L, N_EXPERTS, D, D_EXPERT), D ** -0.5),
        "w_exp_up": n(ks[19], (L, N_EXPERTS, D, D_EXPERT), D ** -0.5),
        "w_exp_down": n(ks[20], (L, N_EXPERTS, D_EXPERT, D), D_EXPERT ** -0.5),
        "ple_norm_g": 1.0 + n(ks[21], (L, D), 0.02),
        "w_ple_gate": n(ks[22], (L, D, D), D ** -0.5),
        "w_ple_proj": n(ks[23], (L, PLE_DIM, D), PLE_DIM ** -0.5),
        "final_norm_g": 1.0 + n(ks[24], (D,), 0.02),
    }


def reference(x, p, mix_norm_g, w_in, conv_a_w, w_out_a, conv_b_w, conv_b_b, ln_b_g, ln_b_b,
              w_out_b, b_gate, w_o, ffn_norm_g, w_router_group, b_router_group, w_router_expert,
              b_router_expert, w_exp_gate, w_exp_up, w_exp_down, ple_norm_g, w_ple_gate, w_ple_proj,
              final_norm_g):
    for i in range(DEPTH):
        h = rmsnorm(x, mix_norm_g[i])
        x = x + token_mixer(h, w_in[i], conv_a_w[i], w_out_a[i], conv_b_w[i], conv_b_b[i],
                            ln_b_g[i], ln_b_b[i], w_out_b[i], b_gate[i], w_o[i])
        h = rmsnorm(x, ffn_norm_g[i])
        x = x + hierarchical_moe(h, w_router_group[i], b_router_group[i], w_router_expert[i],
                                 b_router_expert[i], w_exp_gate[i], w_exp_up[i], w_exp_down[i])
        hp = rmsnorm(x, ple_norm_g[i])
        x = x + jax.nn.sigmoid(hp @ w_ple_gate[i]) * (p[i] @ w_ple_proj[i])
    return rmsnorm(x, final_norm_g)
```

```cpp
#include <hip/hip_runtime.h>
#include <cstdio>
#include <cstdint>

typedef unsigned short bf16;
constexpr int T = 32768, D = 1024, SEQ = 2048, PLE = 256, NE = 32, NG = 4, EPG = 8, DE = 512, INC = 7168;
constexpr float EPS = 1e-6f;
constexpr size_t MiB = 1u << 20;
constexpr size_t WS_CTL = 0;
constexpr size_t WS_TOK = 1 * MiB;
constexpr size_t WS_SSP1 = 2 * MiB;
constexpr size_t WS_SSP3 = 4 * MiB;
constexpr size_t WS_LTOK = 6 * MiB;
constexpr size_t WS_LW = 10 * MiB;
constexpr size_t WS_RA = 144 * MiB, WS_RB = 208 * MiB, WS_RC = 272 * MiB, WS_RD = 336 * MiB, WS_RE = 400 * MiB;
constexpr size_t WS_END = 464 * MiB;
constexpr int APITCH = 1280;
constexpr int CW_CNT = 64;

__device__ __forceinline__ unsigned f2bf(float f) { unsigned u = __builtin_bit_cast(unsigned, f); return (u + 0x7fffu + ((u >> 16) & 1u)) >> 16; }
__device__ __forceinline__ float bf2f(unsigned short b) { return __builtin_bit_cast(float, (unsigned)b << 16); }
__device__ __forceinline__ float sigmoidf_(float v) { return 1.f / (1.f + __expf(-v)); }
__device__ __forceinline__ float siluf_(float v) { return v / (1.f + __expf(-v)); }
__device__ __forceinline__ float wave_sum(float v) {
#pragma unroll
    for (int o = 1; o < 64; o <<= 1) v += __shfl_xor(v, o);
    return v;
}

__global__ void __launch_bounds__(256) nv_rms_bf16(const float* __restrict__ x, const float* __restrict__ g, bf16* __restrict__ out, int opitch, int ooff) {
    const int lane = threadIdx.x & 63, row = blockIdx.x * 4 + (threadIdx.x >> 6);
    const float4* xr = (const float4*)(x + (size_t)row * D);
    float4 v[4]; float s = 0.f;
#pragma unroll
    for (int j = 0; j < 4; ++j) { v[j] = xr[lane + 64 * j]; s += v[j].x * v[j].x + v[j].y * v[j].y + v[j].z * v[j].z + v[j].w * v[j].w; }
    const float r = rsqrtf(wave_sum(s) * (1.f / D) + EPS);
#pragma unroll
    for (int j = 0; j < 4; ++j) { const int c = 4 * (lane + 64 * j); const float4 gg = *(const float4*)(g + c);
        uint2 o; o.x = f2bf(v[j].x * r * gg.x) | (f2bf(v[j].y * r * gg.y) << 16); o.y = f2bf(v[j].z * r * gg.z) | (f2bf(v[j].w * r * gg.w) << 16);
        *(uint2*)(out + (size_t)row * opitch + ooff + c) = o; }
}

__global__ void __launch_bounds__(256) nv_inproj(const bf16* __restrict__ h, const float* __restrict__ w_in, const float* __restrict__ b_gate,
                                                  bf16* UA, bf16* UB, bf16* AB, bf16* GA, bf16* GB) {
    __shared__ float a[8][1024];
    const int tid = threadIdx.x, t0 = blockIdx.x * 8, c = blockIdx.y * 256 + tid;
    for (int i = tid; i < 8 * 1024; i += 256) a[i >> 10][i & 1023] = bf2f(h[(size_t)(t0 + (i >> 10)) * D + (i & 1023)]);
    __syncthreads();
    float acc[7][8];
#pragma unroll
    for (int s = 0; s < 7; ++s)
#pragma unroll
        for (int i = 0; i < 8; ++i) acc[s][i] = 0.f;
    for (int k = 0; k < 1024; ++k) {
        float w[7];
#pragma unroll
        for (int s = 0; s < 7; ++s) w[s] = w_in[(size_t)k * INC + s * 1024 + c];
#pragma unroll
        for (int i = 0; i < 8; ++i) { const float av = a[i][k];
#pragma unroll
            for (int s = 0; s < 7; ++s) acc[s][i] += av * w[s]; }
    }
    const float bga = b_gate[c], bgb = b_gate[1024 + c];
#pragma unroll
    for (int i = 0; i < 8; ++i) { const size_t o = (size_t)(t0 + i) * D + c;
        AB[o] = f2bf(acc[0][i]); UA[o] = f2bf(acc[1][i] * acc[2][i]); UB[o] = f2bf(acc[3][i] * sigmoidf_(acc[4][i]));
        GA[o] = f2bf(sigmoidf_(acc[5][i] + bga)); GB[o] = f2bf(sigmoidf_(acc[6][i] + bgb)); }
}

__global__ void __launch_bounds__(256) nv_conv(const bf16* __restrict__ UA, const bf16* __restrict__ UB, const bf16* __restrict__ AB,
                                                const float* __restrict__ wa, const float* __restrict__ wb, const float* __restrict__ bb,
                                                const float* __restrict__ lg, const float* __restrict__ lb, bf16* ZZ) {
    __shared__ float red[8];
    const int tid = threadIdx.x, t = blockIdx.x, s = t & (SEQ - 1);
    float v[4], za[4];
#pragma unroll
    for (int j = 0; j < 4; ++j) { const int c = tid * 4 + j;
        float ca = 0.f;
#pragma unroll
        for (int k = 0; k < 3; ++k) if (s - 2 + k >= 0) ca += wa[k * 1024 + c] * bf2f(UA[(size_t)(t - 2 + k) * D + c]);
        za[j] = bf2f(AB[(size_t)t * D + c]) * ca;
        float cb = bb[c];
        for (int k = 0; k < 31; ++k) if (s - 30 + k >= 0) cb += wb[k * 1024 + c] * bf2f(UB[(size_t)(t - 30 + k) * D + c]);
        v[j] = cb; }
    float sm = wave_sum(v[0] + v[1] + v[2] + v[3]);
    if ((tid & 63) == 0) red[tid >> 6] = sm;
    __syncthreads();
    const float mu = (red[0] + red[1] + red[2] + red[3]) * (1.f / 1024.f);
    float q = 0.f;
#pragma unroll
    for (int j = 0; j < 4; ++j) { const float d = v[j] - mu; q += d * d; }
    q = wave_sum(q);
    if ((tid & 63) == 0) red[4 + (tid >> 6)] = q;
    __syncthreads();
    const float rstd = rsqrtf((red[4] + red[5] + red[6] + red[7]) * (1.f / 1024.f) + EPS);
#pragma unroll
    for (int j = 0; j < 4; ++j) { const int c = tid * 4 + j; const float y = (v[j] - mu) * rstd * lg[c] + lb[c];
        ZZ[(size_t)t * 2048 + c] = f2bf(za[j]); ZZ[(size_t)t * 2048 + 1024 + c] = f2bf(siluf_(y)); }
}

__global__ void __launch_bounds__(256) nv_outab(const bf16* __restrict__ ZZ, const float* __restrict__ wA, const float* __restrict__ wB,
                                                 const bf16* __restrict__ GA, const bf16* __restrict__ GB, bf16* MIX) {
    __shared__ float a[8][1024];
    const int tid = threadIdx.x, t0 = blockIdx.x * 8, c = blockIdx.y * 256 + tid;
    float res[8];
#pragma unroll
    for (int i = 0; i < 8; ++i) res[i] = 0.f;
    for (int br = 0; br < 2; ++br) {
        __syncthreads();
        for (int i = tid; i < 8 * 1024; i += 256) a[i >> 10][i & 1023] = bf2f(ZZ[(size_t)(t0 + (i >> 10)) * 2048 + br * 1024 + (i & 1023)]);
        __syncthreads();
        const float* W = br ? wB : wA; const bf16* G = br ? GB : GA;
        float acc[8];
#pragma unroll
        for (int i = 0; i < 8; ++i) acc[i] = 0.f;
        for (int k = 0; k < 1024; ++k) { const float w = W[(size_t)k * D + c];
#pragma unroll
            for (int i = 0; i < 8; ++i) acc[i] += a[i][k] * w; }
#pragma unroll
        for (int i = 0; i < 8; ++i) res[i] += bf2f(G[(size_t)(t0 + i) * D + c]) * acc[i];
    }
#pragma unroll
    for (int i = 0; i < 8; ++i) MIX[(size_t)(t0 + i) * D + c] = f2bf(res[i]);
}

__global__ void __launch_bounds__(256) nv_wo(const bf16* __restrict__ MIX, const float* __restrict__ wo, const float* __restrict__ x, float* X1, bf16* APLE) {
    __shared__ float a[8][1024];
    const int tid = threadIdx.x, t0 = blockIdx.x * 8, c = blockIdx.y * 256 + tid;
    for (int i = tid; i < 8 * 1024; i += 256) a[i >> 10][i & 1023] = bf2f(MIX[(size_t)(t0 + (i >> 10)) * D + (i & 1023)]);
    __syncthreads();
    float acc[8];
#pragma unroll
    for (int i = 0; i < 8; ++i) acc[i] = 0.f;
    for (int k = 0; k < 1024; ++k) { const float w = wo[(size_t)k * D + c];
#pragma unroll
        for (int i = 0; i < 8; ++i) acc[i] += a[i][k] * w; }
#pragma unroll
    for (int i = 0; i < 8; ++i) { const float v = x[(size_t)(t0 + i) * D + c] + acc[i]; X1[(size_t)(t0 + i) * D + c] = v; APLE[(size_t)(t0 + i) * APITCH + 256 + c] = f2bf(v); }
}
__global__ void __launch_bounds__(256) nv_rowss(const float* __restrict__ X, float* ssp) {
    const int lane = threadIdx.x & 63, row = blockIdx.x * 4 + (threadIdx.x >> 6);
    const float4* xr = (const float4*)(X + (size_t)row * D); float s = 0.f;
#pragma unroll
    for (int j = 0; j < 4; ++j) { const float4 v = xr[lane + 64 * j]; s += v.x * v.x + v.y * v.y + v.z * v.z + v.w * v.w; }
    s = wave_sum(s);
    if (lane < 16) ssp[(size_t)row * 16 + lane] = lane == 0 ? s : 0.f;
}

__global__ void __launch_bounds__(256) nv_router(const float* __restrict__ X1, const float* __restrict__ ssp1, const float* __restrict__ gf,
                                                  const float* __restrict__ wrg, const float* __restrict__ brg, const float* __restrict__ wre, const float* __restrict__ bre,
                                                  unsigned* cnt, int* tok_e, float* tok_w, int* tok_pos, float* r1, int* ltok, float* lw) {
    const int lane = threadIdx.x & 63, t = blockIdx.x * 4 + (threadIdx.x >> 6);
    float ss = 0.f;
    { float pv = lane < 16 ? ssp1[(size_t)t * 16 + lane] : 0.f; ss = wave_sum(pv); }
    const float r = rsqrtf(ss * (1.f / D) + EPS);
    float acc[36];
#pragma unroll
    for (int i = 0; i < 36; ++i) acc[i] = 0.f;
    for (int j = 0; j < 16; ++j) { const int k = lane + 64 * j; const float hv = X1[(size_t)t * D + k] * r * gf[k];
#pragma unroll
        for (int i = 0; i < 4; ++i) acc[i] += hv * wrg[k * 4 + i];
#pragma unroll
        for (int i = 0; i < 32; ++i) acc[4 + i] += hv * wre[k * 32 + i]; }
#pragma unroll
    for (int i = 0; i < 36; ++i) acc[i] = wave_sum(acc[i]);
    if (lane == 0) {
        float gl[4]; int grp = 0; float gm;
#pragma unroll
        for (int i = 0; i < 4; ++i) gl[i] = acc[i] + brg[i];
        gm = gl[0];
#pragma unroll
        for (int i = 1; i < 4; ++i) if (gl[i] > gm) { gm = gl[i]; grp = i; }
        float den = 0.f;
#pragma unroll
        for (int i = 0; i < 4; ++i) den += __expf(gl[i] - gm);
        const float pg = 1.f / den;
        float el[8];
#pragma unroll
        for (int i = 0; i < 8; ++i) { float v = 0.f;
#pragma unroll
            for (int g2 = 0; g2 < 4; ++g2) v = (grp == g2) ? acc[4 + g2 * 8 + i] + bre[g2 * 8 + i] : v;
            el[i] = v; }
        int i0 = 0; float v0 = el[0];
#pragma unroll
        for (int i = 1; i < 8; ++i) if (el[i] > v0) { v0 = el[i]; i0 = i; }
        int i1 = -1; float v1 = -3.0e38f;
#pragma unroll
        for (int i = 0; i < 8; ++i) if (i != i0 && el[i] > v1) { v1 = el[i]; i1 = i; }
        const float e1 = __expf(v1 - v0), s0 = 1.f / (1.f + e1), s1 = e1 / (1.f + e1);
        const int ea = grp * 8 + i0, eb = grp * 8 + i1; const float wa_ = s0 * pg, wb_ = s1 * pg;
        const unsigned pa = atomicAdd(&cnt[ea], 1u), pb = atomicAdd(&cnt[eb], 1u);
        tok_e[t * 2] = ea; tok_e[t * 2 + 1] = eb; tok_w[t * 2] = wa_; tok_w[t * 2 + 1] = wb_; tok_pos[t * 2] = (int)pa; tok_pos[t * 2 + 1] = (int)pb;
        ltok[(size_t)ea * T + pa] = t; lw[(size_t)ea * T + pa] = wa_; ltok[(size_t)eb * T + pb] = t; lw[(size_t)eb * T + pb] = wb_;
        r1[t] = r;
    }
}
__global__ void __launch_bounds__(256) nv_pcvt(const float* __restrict__ p, bf16* APLE) {
    const size_t i = (size_t)blockIdx.x * 256 + threadIdx.x;
    const size_t t = i >> 6; const int c = (int)(i & 63) * 4; const float4 v = *(const float4*)(p + t * PLE + c);
    uint2 o; o.x = f2bf(v.x) | (f2bf(v.y) << 16); o.y = f2bf(v.z) | (f2bf(v.w) << 16);
    *(uint2*)(APLE + t * APITCH + c) = o;
}

__global__ void __launch_bounds__(256) nv_moe_up(const float* __restrict__ X1, const float* __restrict__ r1, const float* __restrict__ gf,
                                                  const float* __restrict__ wg, const float* __restrict__ wu, const unsigned* __restrict__ cnt, const int* __restrict__ ltok, bf16* HMID) {
    __shared__ float a[8][1024];
    const int tid = threadIdx.x, e = blockIdx.y, row0 = blockIdx.x * 8; const int n = (int)cnt[e];
    if (row0 >= n) return;
    int start = 0; for (int i = 0; i < e; ++i) start += (int)cnt[i];
    for (int i = tid; i < 8 * 1024; i += 256) { const int rr = i >> 10, k = i & 1023; float v = 0.f;
        if (row0 + rr < n) { const int tk = ltok[(size_t)e * T + row0 + rr]; v = X1[(size_t)tk * D + k] * r1[tk] * gf[k]; }
        a[rr][k] = v; }
    __syncthreads();
    float ag[2][8], au[2][8];
#pragma unroll
    for (int q = 0; q < 2; ++q)
#pragma unroll
        for (int i = 0; i < 8; ++i) { ag[q][i] = 0.f; au[q][i] = 0.f; }
    const float* Wg = wg + (size_t)e * D * DE; const float* Wu = wu + (size_t)e * D * DE;
    for (int k = 0; k < 1024; ++k) {
        const float g0 = Wg[(size_t)k * DE + tid], g1 = Wg[(size_t)k * DE + 256 + tid], u0 = Wu[(size_t)k * DE + tid], u1 = Wu[(size_t)k * DE + 256 + tid];
#pragma unroll
        for (int i = 0; i < 8; ++i) { const float av = a[i][k]; ag[0][i] += av * g0; ag[1][i] += av * g1; au[0][i] += av * u0; au[1][i] += av * u1; }
    }
#pragma unroll
    for (int i = 0; i < 8; ++i) if (row0 + i < n) {
#pragma unroll
        for (int q = 0; q < 2; ++q) HMID[(size_t)(start + row0 + i) * DE + q * 256 + tid] = f2bf(siluf_(ag[q][i]) * au[q][i]); }
}
__global__ void __launch_bounds__(256) nv_moe_down(const bf16* __restrict__ HMID, const float* __restrict__ wd, const unsigned* __restrict__ cnt, const float* __restrict__ lw, bf16* YB) {
    __shared__ float a[8][512];
    const int tid = threadIdx.x, e = blockIdx.y, row0 = blockIdx.x * 8; const int n = (int)cnt[e];
    if (row0 >= n) return;
    int start = 0; for (int i = 0; i < e; ++i) start += (int)cnt[i];
    for (int i = tid; i < 8 * 512; i += 256) { const int rr = i >> 9, k = i & 511; a[rr][k] = (row0 + rr < n) ? bf2f(HMID[(size_t)(start + row0 + rr) * DE + k]) : 0.f; }
    __syncthreads();
    float acc[4][8];
#pragma unroll
    for (int q = 0; q < 4; ++q)
#pragma unroll
        for (int i = 0; i < 8; ++i) acc[q][i] = 0.f;
    const float* W = wd + (size_t)e * DE * D;
    for (int k = 0; k < 512; ++k) {
        float w[4];
#pragma unroll
        for (int q = 0; q < 4; ++q) w[q] = W[(size_t)k * D + q * 256 + tid];
#pragma unroll
        for (int i = 0; i < 8; ++i) { const float av = a[i][k];
#pragma unroll
            for (int q = 0; q < 4; ++q) acc[q][i] += av * w[q]; }
    }
#pragma unroll
    for (int i = 0; i < 8; ++i) if (row0 + i < n) { const float gw = lw[(size_t)e * T + row0 + i];
#pragma unroll
        for (int q = 0; q < 4; ++q) YB[(size_t)(start + row0 + i) * D + q * 256 + tid] = f2bf(gw * acc[q][i]); }
}
__global__ void __launch_bounds__(256) nv_combine(float* X, const bf16* __restrict__ YB, const unsigned* __restrict__ cnt, const int* __restrict__ tok_e, const int* __restrict__ tok_pos, bf16* APLE, float* r2) {
    const int lane = threadIdx.x & 63, t = blockIdx.x * 4 + (threadIdx.x >> 6);
    const int ea = tok_e[t * 2], eb = tok_e[t * 2 + 1];
    int sa = tok_pos[t * 2], sb = tok_pos[t * 2 + 1];
    for (int i = 0; i < NE; ++i) { const int c = (int)cnt[i]; if (i < ea) sa += c; if (i < eb) sb += c; }
    float s = 0.f;
#pragma unroll
    for (int j = 0; j < 4; ++j) { const int c = 4 * (lane + 64 * j);
        float4 v = *(const float4*)(X + (size_t)t * D + c);
        const uint2 ya = *(const uint2*)(YB + (size_t)sa * D + c), yb = *(const uint2*)(YB + (size_t)sb * D + c);
        v.x += bf2f(ya.x & 0xffff) + bf2f(yb.x & 0xffff); v.y += bf2f(ya.x >> 16) + bf2f(yb.x >> 16);
        v.z += bf2f(ya.y & 0xffff) + bf2f(yb.y & 0xffff); v.w += bf2f(ya.y >> 16) + bf2f(yb.y >> 16);
        s += v.x * v.x + v.y * v.y + v.z * v.z + v.w * v.w;
        *(float4*)(X + (size_t)t * D + c) = v;
        uint2 o; o.x = f2bf(v.x) | (f2bf(v.y) << 16); o.y = f2bf(v.z) | (f2bf(v.w) << 16);
        *(uint2*)(APLE + (size_t)t * APITCH + 256 + c) = o; }
    s = wave_sum(s);
    if (lane == 0) r2[t] = rsqrtf(s * (1.f / D) + EPS);
}
__global__ void __launch_bounds__(256) nv_ple(const float* __restrict__ X2, const float* __restrict__ r2, const float* __restrict__ gp, const float* __restrict__ wpg,
                                               const float* __restrict__ p, const float* __restrict__ wpp, float* X3) {
    __shared__ float a[8][1024];
    const int tid = threadIdx.x, t0 = blockIdx.x * 8, c = blockIdx.y * 256 + tid;
    for (int i = tid; i < 8 * 1024; i += 256) { const int rr = i >> 10, k = i & 1023; a[rr][k] = X2[(size_t)(t0 + rr) * D + k] * r2[t0 + rr] * gp[k]; }
    __syncthreads();
    float acc[8], prj[8];
#pragma unroll
    for (int i = 0; i < 8; ++i) { acc[i] = 0.f; prj[i] = 0.f; }
    for (int k = 0; k < 1024; ++k) { const float w = wpg[(size_t)k * D + c];
#pragma unroll
        for (int i = 0; i < 8; ++i) acc[i] += a[i][k] * w; }
    __syncthreads();
    for (int i = tid; i < 8 * 256; i += 256) a[i >> 8][i & 255] = p[(size_t)(t0 + (i >> 8)) * PLE + (i & 255)];
    __syncthreads();
    for (int k = 0; k < 256; ++k) { const float w = wpp[(size_t)k * D + c];
#pragma unroll
        for (int i = 0; i < 8; ++i) prj[i] += a[i][k] * w; }
#pragma unroll
    for (int i = 0; i < 8; ++i) X3[(size_t)(t0 + i) * D + c] = X2[(size_t)(t0 + i) * D + c] + sigmoidf_(acc[i]) * prj[i];
}
__global__ void __launch_bounds__(256) nv_final(const float* __restrict__ X3, const float* __restrict__ g, float* out) {
    const int lane = threadIdx.x & 63, row = blockIdx.x * 4 + (threadIdx.x >> 6);
    const float4* xr = (const float4*)(X3 + (size_t)row * D);
    float4 v[4]; float s = 0.f;
#pragma unroll
    for (int j = 0; j < 4; ++j) { v[j] = xr[lane + 64 * j]; s += v[j].x * v[j].x + v[j].y * v[j].y + v[j].z * v[j].z + v[j].w * v[j].w; }
    const float r = rsqrtf(wave_sum(s) * (1.f / D) + EPS);
#pragma unroll
    for (int j = 0; j < 4; ++j) { const int c = 4 * (lane + 64 * j); const float4 gg = *(const float4*)(g + c);
        *(float4*)(out + (size_t)row * D + c) = make_float4(v[j].x * r * gg.x, v[j].y * r * gg.y, v[j].z * r * gg.z, v[j].w * r * gg.w); }
}

extern "C" void kernel_launch(void* const* d_in, const int* in_sizes, int n_in, void* d_out, int out_size, void* d_ws, size_t ws_size, hipStream_t stream) {
    if (n_in != 25 || in_sizes[0] != T * D || out_size != T * D || ws_size < WS_END) { fprintf(stderr, "kernel_launch: unexpected shapes (n_in %d, in0 %d, out %d, ws %zu)\n", n_in, n_in > 0 ? in_sizes[0] : -1, out_size, ws_size); return; }
    const float* x = (const float*)d_in[0]; const float* p = (const float*)d_in[1]; const float* mix_g = (const float*)d_in[2]; const float* w_in = (const float*)d_in[3];
    const float* conv_a_w = (const float*)d_in[4]; const float* w_out_a = (const float*)d_in[5]; const float* conv_b_w = (const float*)d_in[6]; const float* conv_b_b = (const float*)d_in[7];
    const float* ln_b_g = (const float*)d_in[8]; const float* ln_b_b = (const float*)d_in[9]; const float* w_out_b = (const float*)d_in[10]; const float* b_gate = (const float*)d_in[11];
    const float* w_o = (const float*)d_in[12]; const float* ffn_g = (const float*)d_in[13]; const float* w_rg = (const float*)d_in[14]; const float* b_rg = (const float*)d_in[15];
    const float* w_re = (const float*)d_in[16]; const float* b_re = (const float*)d_in[17]; const float* w_eg = (const float*)d_in[18]; const float* w_eu = (const float*)d_in[19];
    const float* w_ed = (const float*)d_in[20]; const float* ple_g = (const float*)d_in[21]; const float* w_pg = (const float*)d_in[22]; const float* w_pp = (const float*)d_in[23];
    const float* fin_g = (const float*)d_in[24];
    unsigned char* ws = (unsigned char*)d_ws; float* out = (float*)d_out;
    unsigned* ctl = (unsigned*)(ws + WS_CTL);
    int* tok_e = (int*)(ws + WS_TOK); float* tok_w = (float*)(ws + WS_TOK + 256 * 1024); int* tok_pos = (int*)(ws + WS_TOK + 512 * 1024);
    float* r1 = (float*)(ws + WS_TOK + 768 * 1024); float* r2 = (float*)(ws + WS_TOK + 896 * 1024);
    float* ssp1 = (float*)(ws + WS_SSP1); int* ltok = (int*)(ws + WS_LTOK); float* lw = (float*)(ws + WS_LW);
    bf16* H = (bf16*)d_out;
    bf16* UA = (bf16*)(ws + WS_RA); bf16* UB = (bf16*)(ws + WS_RB); bf16* AB = (bf16*)(ws + WS_RC); bf16* GA = (bf16*)(ws + WS_RD); bf16* GB = (bf16*)(ws + WS_RE);
    bf16* ZZ = (bf16*)d_out;
    bf16* MIX = (bf16*)(ws + WS_RC);
    float* X1 = (float*)(ws + WS_RA);
    bf16* APLE = (bf16*)d_out;
    bf16* HMID = (bf16*)(ws + WS_RC); bf16* YB = (bf16*)(ws + WS_RD);
    float* X3 = (float*)(ws + WS_RC);

    hipMemsetAsync(ws + WS_CTL, 0, 1 * MiB, stream);
    nv_rms_bf16<<<T / 4, 256, 0, stream>>>(x, mix_g, H, D, 0);
    nv_inproj<<<dim3(T / 8, 4), 256, 0, stream>>>(H, w_in, b_gate, UA, UB, AB, GA, GB);
    nv_conv<<<T, 256, 0, stream>>>(UA, UB, AB, conv_a_w, conv_b_w, conv_b_b, ln_b_g, ln_b_b, ZZ);
    nv_outab<<<dim3(T / 8, 4), 256, 0, stream>>>(ZZ, w_out_a, w_out_b, GA, GB, MIX);
    nv_wo<<<dim3(T / 8, 4), 256, 0, stream>>>(MIX, w_o, x, X1, APLE);
    nv_rowss<<<T / 4, 256, 0, stream>>>(X1, ssp1);
    nv_router<<<T / 4, 256, 0, stream>>>(X1, ssp1, ffn_g, w_rg, b_rg, w_re, b_re, ctl + CW_CNT, tok_e, tok_w, tok_pos, r1, ltok, lw);
    nv_pcvt<<<T * PLE / 4 / 256, 256, 0, stream>>>(p, APLE);
    nv_moe_up<<<dim3(T / 8, NE), 256, 0, stream>>>(X1, r1, ffn_g, w_eg, w_eu, ctl + CW_CNT, ltok, HMID);
    nv_moe_down<<<dim3(T / 8, NE), 256, 0, stream>>>(HMID, w_ed, ctl + CW_CNT, lw, YB);
    nv_combine<<<T / 4, 256, 0, stream>>>(X1, YB, ctl + CW_CNT, tok_e, tok_pos, APLE, r2);
    nv_ple<<<dim3(T / 8, 4), 256, 0, stream>>>(X1, r2, ple_g, w_pg, p, w_pp, X3);
    nv_final<<<T / 4, 256, 0, stream>>>(X3, fin_g, out);
}
```

```cpp
#include <hip/hip_runtime.h>
#include <cstdio>
#include <cstdint>

typedef unsigned short bf16;
constexpr int T = 32768, D = 1024, SEQ = 2048, PLE = 256, NE = 32, NG = 4, EPG = 8, DE = 512, INC = 7168;
constexpr float EPS = 1e-6f;
constexpr size_t MiB = 1u << 20;
constexpr size_t WS_CTL = 0;
constexpr size_t WS_TOK = 1 * MiB;
constexpr size_t WS_SSP1 = 2 * MiB;
constexpr size_t WS_SSP3 = 4 * MiB;
constexpr size_t WS_LTOK = 6 * MiB;
constexpr size_t WS_LW = 136 * MiB;
constexpr size_t WS_RA = 144 * MiB, WS_RB = 208 * MiB, WS_RC = 272 * MiB, WS_RD = 336 * MiB, WS_RE = 400 * MiB;
constexpr size_t WS_END = 464 * MiB;
constexpr int APITCH = 1280;
constexpr int CW_CNT = 64;

__device__ __forceinline__ unsigned f2bf(float f) { unsigned u = __builtin_bit_cast(unsigned, f); return (u + 0x7fffu + ((u >> 16) & 1u)) >> 16; }
__device__ __forceinline__ float bf2f(unsigned short b) { return __builtin_bit_cast(float, (unsigned)b << 16); }
__device__ __forceinline__ float sigmoidf_(float v) { return 1.f / (1.f + __expf(-v)); }
__device__ __forceinline__ float siluf_(float v) { return v / (1.f + __expf(-v)); }
__device__ __forceinline__ float wave_sum(float v) {
#pragma unroll
    for (int o = 1; o < 64; o <<= 1) v += __shfl_xor(v, o);
    return v;
}

__global__ void __launch_bounds__(256) nv_rms_bf16(const float* __restrict__ x, const float* __restrict__ g, bf16* __restrict__ out, int opitch, int ooff) {
    const int lane = threadIdx.x & 63, row = blockIdx.x * 4 + (threadIdx.x >> 6);
    const float4* xr = (const float4*)(x + (size_t)row * D);
    float4 v[4]; float s = 0.f;
#pragma unroll
    for (int j = 0; j < 4; ++j) { v[j] = xr[lane + 64 * j]; s += v[j].x * v[j].x + v[j].y * v[j].y + v[j].z * v[j].z + v[j].w * v[j].w; }
    const float r = rsqrtf(wave_sum(s) * (1.f / D) + EPS);
#pragma unroll
    for (int j = 0; j < 4; ++j) { const int c = 4 * (lane + 64 * j); const float4 gg = *(const float4*)(g + c);
        uint2 o; o.x = f2bf(v[j].x * r * gg.x) | (f2bf(v[j].y * r * gg.y) << 16); o.y = f2bf(v[j].z * r * gg.z) | (f2bf(v[j].w * r * gg.w) << 16);
        *(uint2*)(out + (size_t)row * opitch + ooff + c) = o; }
}

__global__ void __launch_bounds__(256) nv_inproj(const bf16* __restrict__ h, const float* __restrict__ w_in, const float* __restrict__ b_gate,
                                                  bf16* UA, bf16* UB, bf16* AB, bf16* GA, bf16* GB) {
    __shared__ float a[8][1024];
    const int tid = threadIdx.x, t0 = blockIdx.x * 8, c = blockIdx.y * 256 + tid;
    for (int i = tid; i < 8 * 1024; i += 256) a[i >> 10][i & 1023] = bf2f(h[(size_t)(t0 + (i >> 10)) * D + (i & 1023)]);
    __syncthreads();
    float acc[7][8];
#pragma unroll
    for (int s = 0; s < 7; ++s)
#pragma unroll
        for (int i = 0; i < 8; ++i) acc[s][i] = 0.f;
    for (int k = 0; k < 1024; ++k) {
        float w[7];
#pragma unroll
        for (int s = 0; s < 7; ++s) w[s] = w_in[(size_t)k * INC + s * 1024 + c];
#pragma unroll
        for (int i = 0; i < 8; ++i) { const float av = a[i][k];
#pragma unroll
            for (int s = 0; s < 7; ++s) acc[s][i] += av * w[s]; }
    }
    const float bga = b_gate[c], bgb = b_gate[1024 + c];
#pragma unroll
    for (int i = 0; i < 8; ++i) { const size_t o = (size_t)(t0 + i) * D + c;
        AB[o] = f2bf(acc[0][i]); UA[o] = f2bf(acc[1][i] * acc[2][i]); UB[o] = f2bf(acc[3][i] * sigmoidf_(acc[4][i]));
        GA[o] = f2bf(sigmoidf_(acc[5][i] + bga)); GB[o] = f2bf(sigmoidf_(acc[6][i] + bgb)); }
}

__global__ void __launch_bounds__(256) nv_conv(const bf16* __restrict__ UA, const bf16* __restrict__ UB, const bf16* __restrict__ AB,
                                                const float* __restrict__ wa, const float* __restrict__ wb, const float* __restrict__ bb,
                                                const float* __restrict__ lg, const float* __restrict__ lb, bf16* ZZ) {
    __shared__ float red[8];
    const int tid = threadIdx.x, t = blockIdx.x, s = t & (SEQ - 1);
    float v[4], za[4];
#pragma unroll
    for (int j = 0; j < 4; ++j) { const int c = tid * 4 + j;
        float ca = 0.f;
#pragma unroll
        for (int k = 0; k < 3; ++k) if (s - 2 + k >= 0) ca += wa[k * 1024 + c] * bf2f(UA[(size_t)(t - 2 + k) * D + c]);
        za[j] = bf2f(AB[(size_t)t * D + c]) * ca;
        float cb = bb[c];
        for (int k = 0; k < 31; ++k) if (s - 30 + k >= 0) cb += wb[k * 1024 + c] * bf2f(UB[(size_t)(t - 30 + k) * D + c]);
        v[j] = cb; }
    float sm = wave_sum(v[0] + v[1] + v[2] + v[3]);
    if ((tid & 63) == 0) red[tid >> 6] = sm;
    __syncthreads();
    const float mu = (red[0] + red[1] + red[2] + red[3]) * (1.f / 1024.f);
    float q = 0.f;
#pragma unroll
    for (int j = 0; j < 4; ++j) { const float d = v[j] - mu; q += d * d; }
    q = wave_sum(q);
    if ((tid & 63) == 0) red[4 + (tid >> 6)] = q;
    __syncthreads();
    const float rstd = rsqrtf((red[4] + red[5] + red[6] + red[7]) * (1.f / 1024.f) + EPS);
#pragma unroll
    for (int j = 0; j < 4; ++j) { const int c = tid * 4 + j; const float y = (v[j] - mu) * rstd * lg[c] + lb[c];
        ZZ[(size_t)t * 2048 + c] = f2bf(za[j]); ZZ[(size_t)t * 2048 + 1024 + c] = f2bf(siluf_(y)); }
}

__global__ void __launch_bounds__(256) nv_outab(const bf16* __restrict__ ZZ, const float* __restrict__ wA, const float* __restrict__ wB,
                                                 const bf16* __restrict__ GA, const bf16* __restrict__ GB, bf16* MIX) {
    __shared__ float a[8][1024];
    const int tid = threadIdx.x, t0 = blockIdx.x * 8, c = blockIdx.y * 256 + tid;
    float res[8];
#pragma unroll
    for (int i = 0; i < 8; ++i) res[i] = 0.f;
    for (int br = 0; br < 2; ++br) {
        __syncthreads();
        for (int i = tid; i < 8 * 1024; i += 256) a[i >> 10][i & 1023] = bf2f(ZZ[(size_t)(t0 + (i >> 10)) * 2048 + br * 1024 + (i & 1023)]);
        __syncthreads();
        const float* W = br ? wB : wA; const bf16* G = br ? GB : GA;
        float acc[8];
#pragma unroll
        for (int i = 0; i < 8; ++i) acc[i] = 0.f;
        for (int k = 0; k < 1024; ++k) { const float w = W[(size_t)k * D + c];
#pragma unroll
            for (int i = 0; i < 8; ++i) acc[i] += a[i][k] * w; }
#pragma unroll
        for (int i = 0; i < 8; ++i) res[i] += bf2f(G[(size_t)(t0 + i) * D + c]) * acc[i];
    }
#pragma unroll
    for (int i = 0; i < 8; ++i) MIX[(size_t)(t0 + i) * D + c] = f2bf(res[i]);
}

__global__ void __launch_bounds__(256) nv_wo(const bf16* __restrict__ MIX, const float* __restrict__ wo, const float* __restrict__ x, float* X1, bf16* APLE) {
    __shared__ float a[8][1024];
    const int tid = threadIdx.x, t0 = blockIdx.x * 8, c = blockIdx.y * 256 + tid;
    for (int i = tid; i < 8 * 1024; i += 256) a[i >> 10][i & 1023] = bf2f(MIX[(size_t)(t0 + (i >> 10)) * D + (i & 1023)]);
    __syncthreads();
    float acc[8];
#pragma unroll
    for (int i = 0; i < 8; ++i) acc[i] = 0.f;
    for (int k = 0; k < 1024; ++k) { const float w = wo[(size_t)k * D + c];
#pragma unroll
        for (int i = 0; i < 8; ++i) acc[i] += a[i][k] * w; }
#pragma unroll
    for (int i = 0; i < 8; ++i) { const float v = x[(size_t)(t0 + i) * D + c] + acc[i]; X1[(size_t)(t0 + i) * D + c] = v; APLE[(size_t)(t0 + i) * APITCH + 256 + c] = f2bf(v); }
}
__global__ void __launch_bounds__(256) nv_rowss(const float* __restrict__ X, float* ssp) {
    const int lane = threadIdx.x & 63, row = blockIdx.x * 4 + (threadIdx.x >> 6);
    const float4* xr = (const float4*)(X + (size_t)row * D); float s = 0.f;
#pragma unroll
    for (int j = 0; j < 4; ++j) { const float4 v = xr[lane + 64 * j]; s += v.x * v.x + v.y * v.y + v.z * v.z + v.w * v.w; }
    s = wave_sum(s);
    if (lane < 16) ssp[(size_t)row * 16 + lane] = lane == 0 ? s : 0.f;
}

__global__ void __launch_bounds__(256) nv_router(const float* __restrict__ X1, const float* __restrict__ ssp1, const float* __restrict__ gf,
                                                  const float* __restrict__ wrg, const float* __restrict__ brg, const float* __restrict__ wre, const float* __restrict__ bre,
                                                  unsigned* cnt, int* tok_e, float* tok_w, int* tok_pos, float* r1, int* ltok, float* lw) {
    const int lane = threadIdx.x & 63, t = blockIdx.x * 4 + (threadIdx.x >> 6);
    float ss = 0.f;
    { float pv = lane < 16 ? ssp1[(size_t)t * 16 + lane] : 0.f; ss = wave_sum(pv); }
    const float r = rsqrtf(ss * (1.f / D) + EPS);
    float acc[36];
#pragma unroll
    for (int i = 0; i < 36; ++i) acc[i] = 0.f;
    for (int j = 0; j < 16; ++j) { const int k = lane + 64 * j; const float hv = X1[(size_t)t * D + k] * r * gf[k];
#pragma unroll
        for (int i = 0; i < 4; ++i) acc[i] += hv * wrg[k * 4 + i];
#pragma unroll
        for (int i = 0; i < 32; ++i) acc[4 + i] += hv * wre[k * 32 + i]; }
#pragma unroll
    for (int i = 0; i < 36; ++i) acc[i] = wave_sum(acc[i]);
    if (lane == 0) {
        float gl[4]; int grp = 0; float gm;
#pragma unroll
        for (int i = 0; i < 4; ++i) gl[i] = acc[i] + brg[i];
        gm = gl[0];
#pragma unroll
        for (int i = 1; i < 4; ++i) if (gl[i] > gm) { gm = gl[i]; grp = i; }
        float den = 0.f;
#pragma unroll
        for (int i = 0; i < 4; ++i) den += __expf(gl[i] - gm);
        const float pg = 1.f / den;
        float el[8];
#pragma unroll
        for (int i = 0; i < 8; ++i) { float v = 0.f;
#pragma unroll
            for (int g2 = 0; g2 < 4; ++g2) v = (grp == g2) ? acc[4 + g2 * 8 + i] + bre[g2 * 8 + i] : v;
            el[i] = v; }
        int i0 = 0; float v0 = el[0];
#pragma unroll
        for (int i = 1; i < 8; ++i) if (el[i] > v0) { v0 = el[i]; i0 = i; }
        int i1 = -1; float v1 = -3.0e38f;
#pragma unroll
        for (int i = 0; i < 8; ++i) if (i != i0 && el[i] > v1) { v1 = el[i]; i1 = i; }
        const float e1 = __expf(v1 - v0), s0 = 1.f / (1.f + e1), s1 = e1 / (1.f + e1);
        const int ea = grp * 8 + i0, eb = grp * 8 + i1; const float wa_ = s0 * pg, wb_ = s1 * pg;
        const unsigned pa = atomicAdd(&cnt[ea], 1u), pb = atomicAdd(&cnt[eb], 1u);
        tok_e[t * 2] = ea; tok_e[t * 2 + 1] = eb; tok_w[t * 2] = wa_; tok_w[t * 2 + 1] = wb_; tok_pos[t * 2] = (int)pa; tok_pos[t * 2 + 1] = (int)pb;
        ltok[(size_t)ea * T + pa] = t; lw[(size_t)ea * T + pa] = wa_; ltok[(size_t)eb * T + pb] = t; lw[(size_t)eb * T + pb] = wb_;
        r1[t] = r;
    }
}
__global__ void __launch_bounds__(256) nv_pcvt(const float* __restrict__ p, bf16* APLE) {
    const size_t i = (size_t)blockIdx.x * 256 + threadIdx.x;
    const size_t t = i >> 6; const int c = (int)(i & 63) * 4; const float4 v = *(const float4*)(p + t * PLE + c);
    uint2 o; o.x = f2bf(v.x) | (f2bf(v.y) << 16); o.y = f2bf(v.z) | (f2bf(v.w) << 16);
    *(uint2*)(APLE + t * APITCH + c) = o;
}

__global__ void __launch_bounds__(256) nv_moe_up(const float* __restrict__ X1, const float* __restrict__ r1, const float* __restrict__ gf,
                                                  const float* __restrict__ wg, const float* __restrict__ wu, const unsigned* __restrict__ cnt, const int* __restrict__ ltok, bf16* HMID) {
    __shared__ float a[8][1024];
    const int tid = threadIdx.x, e = blockIdx.y, row0 = blockIdx.x * 8; const int n = (int)cnt[e];
    if (row0 >= n) return;
    int start = 0; for (int i = 0; i < e; ++i) start += (int)cnt[i];
    for (int i = tid; i < 8 * 1024; i += 256) { const int rr = i >> 10, k = i & 1023; float v = 0.f;
        if (row0 + rr < n) { const int tk = ltok[(size_t)e * T + row0 + rr]; v = X1[(size_t)tk * D + k] * r1[tk] * gf[k]; }
        a[rr][k] = v; }
    __syncthreads();
    float ag[2][8], au[2][8];
#pragma unroll
    for (int q = 0; q < 2; ++q)
#pragma unroll
        for (int i = 0; i < 8; ++i) { ag[q][i] = 0.f; au[q][i] = 0.f; }
    const float* Wg = wg + (size_t)e * D * DE; const float* Wu = wu + (size_t)e * D * DE;
    for (int k = 0; k < 1024; ++k) {
        const float g0 = Wg[(size_t)k * DE + tid], g1 = Wg[(size_t)k * DE + 256 + tid], u0 = Wu[(size_t)k * DE + tid], u1 = Wu[(size_t)k * DE + 256 + tid];
#pragma unroll
        for (int i = 0; i < 8; ++i) { const float av = a[i][k]; ag[0][i] += av * g0; ag[1][i] += av * g1; au[0][i] += av * u0; au[1][i] += av * u1; }
    }
#pragma unroll
    for (int i = 0; i < 8; ++i) if (row0 + i < n) {
#pragma unroll
        for (int q = 0; q < 2; ++q) HMID[(size_t)(start + row0 + i) * DE + q * 256 + tid] = f2bf(siluf_(ag[q][i]) * au[q][i]); }
}
__global__ void __launch_bounds__(256) nv_moe_down(const bf16* __restrict__ HMID, const float* __restrict__ wd, const unsigned* __restrict__ cnt, const float* __restrict__ lw, bf16* YB) {
    __shared__ float a[8][512];
    const int tid = threadIdx.x, e = blockIdx.y, row0 = blockIdx.x * 8; const int n = (int)cnt[e];
    if (row0 >= n) return;
    int start = 0; for (int i = 0; i < e; ++i) start += (int)cnt[i];
    for (int i = tid; i < 8 * 512; i += 256) { const int rr = i >> 9, k = i & 511; a[rr][k] = (row0 + rr < n) ? bf2f(HMID[(size_t)(start + row0 + rr) * DE + k]) : 0.f; }
    __syncthreads();
    float acc[4][8];
#pragma unroll
    for (int q = 0; q < 4; ++q)
#pragma unroll
        for (int i = 0; i < 8; ++i) acc[q][i] = 0.f;
    const float* W = wd + (size_t)e * DE * D;
    for (int k = 0; k < 512; ++k) {
        float w[4];
#pragma unroll
        for (int q = 0; q < 4; ++q) w[q] = W[(size_t)k * D + q * 256 + tid];
#pragma unroll
        for (int i = 0; i < 8; ++i) { const float av = a[i][k];
#pragma unroll
            for (int q = 0; q < 4; ++q) acc[q][i] += av * w[q]; }
    }
#pragma unroll
    for (int i = 0; i < 8; ++i) if (row0 + i < n) { const float gw = lw[(size_t)e * T + row0 + i];
#pragma unroll
        for (int q = 0; q < 4; ++q) YB[(size_t)(start + row0 + i) * D + q * 256 + tid] = f2bf(gw * acc[q][i]); }
}
__global__ void __launch_bounds__(256) nv_combine(float* X, const bf16* __restrict__ YB, const unsigned* __restrict__ cnt, const int* __restrict__ tok_e, const int* __restrict__ tok_pos, bf16* APLE, float* r2) {
    const int lane = threadIdx.x & 63, t = blockIdx.x * 4 + (threadIdx.x >> 6);
    const int ea = tok_e[t * 2], eb = tok_e[t * 2 + 1];
    int sa = tok_pos[t * 2], sb = tok_pos[t * 2 + 1];
    for (int i = 0; i < NE; ++i) { const int c = (int)cnt[i]; if (i < ea) sa += c; if (i < eb) sb += c; }
    float s = 0.f;
#pragma unroll
    for (int j = 0; j < 4; ++j) { const int c = 4 * (lane + 64 * j);
        float4 v = *(const float4*)(X + (size_t)t * D + c);
        const uint2 ya = *(const uint2*)(YB + (size_t)sa * D + c), yb = *(const uint2*)(YB + (size_t)sb * D + c);
        v.x += bf2f(ya.x & 0xffff) + bf2f(yb.x & 0xffff); v.y += bf2f(ya.x >> 16) + bf2f(yb.x >> 16);
        v.z += bf2f(ya.y & 0xffff) + bf2f(yb.y & 0xffff); v.w += bf2f(ya.y >> 16) + bf2f(yb.y >> 16);
        s += v.x * v.x + v.y * v.y + v.z * v.z + v.w * v.w;
        *(float4*)(X + (size_t)t * D + c) = v;
        uint2 o; o.x = f2bf(v.x) | (f2bf(v.y) << 16); o.y = f2bf(v.z) | (f2bf(v.w) << 16);
        *(uint2*)(APLE + (size_t)t * APITCH + 256 + c) = o; }
    s = wave_sum(s);
    if (lane == 0) r2[t] = rsqrtf(s * (1.f / D) + EPS);
}
__global__ void __launch_bounds__(256) nv_ple(const float* __restrict__ X2, const float* __restrict__ r2, const float* __restrict__ gp, const float* __restrict__ wpg,
                                               const float* __restrict__ p, const float* __restrict__ wpp, float* X3) {
    __shared__ float a[8][1024];
    const int tid = threadIdx.x, t0 = blockIdx.x * 8, c = blockIdx.y * 256 + tid;
    for (int i = tid; i < 8 * 1024; i += 256) { const int rr = i >> 10, k = i & 1023; a[rr][k] = X2[(size_t)(t0 + rr) * D + k] * r2[t0 + rr] * gp[k]; }
    __syncthreads();
    float acc[8], prj[8];
#pragma unroll
    for (int i = 0; i < 8; ++i) { acc[i] = 0.f; prj[i] = 0.f; }
    for (int k = 0; k < 1024; ++k) { const float w = wpg[(size_t)k * D + c];
#pragma unroll
        for (int i = 0; i < 8; ++i) acc[i] += a[i][k] * w; }
    __syncthreads();
    for (int i = tid; i < 8 * 256; i += 256) a[i >> 8][i & 255] = p[(size_t)(t0 + (i >> 8)) * PLE + (i & 255)];
    __syncthreads();
    for (int k = 0; k < 256; ++k) { const float w = wpp[(size_t)k * D + c];
#pragma unroll
        for (int i = 0; i < 8; ++i) prj[i] += a[i][k] * w; }
#pragma unroll
    for (int i = 0; i < 8; ++i) X3[(size_t)(t0 + i) * D + c] = X2[(size_t)(t0 + i) * D + c] + sigmoidf_(acc[i]) * prj[i];
}
__global__ void __launch_bounds__(256) nv_final(const float* __restrict__ X3, const float* __restrict__ g, float* out) {
    const int lane = threadIdx.x & 63, row = blockIdx.x * 4 + (threadIdx.x >> 6);
    const float4* xr = (const float4*)(X3 + (size_t)row * D);
    float4 v[4]; float s = 0.f;
#pragma unroll
    for (int j = 0; j < 4; ++j) { v[j] = xr[lane + 64 * j]; s += v[j].x * v[j].x + v[j].y * v[j].y + v[j].z * v[j].z + v[j].w * v[j].w; }
    const float r = rsqrtf(wave_sum(s) * (1.f / D) + EPS);
#pragma unroll
    for (int j = 0; j < 4; ++j) { const int c = 4 * (lane + 64 * j); const float4 gg = *(const float4*)(g + c);
        *(float4*)(out + (size_t)row * D + c) = make_float4(v[j].x * r * gg.x, v[j].y * r * gg.y, v[j].z * r * gg.z, v[j].w * r * gg.w); }
}

namespace pg8 {
#define PG8_LAS __attribute__((address_space(3)))
typedef unsigned short bf16_t;
typedef short bf16x8 __attribute__((ext_vector_type(8)));
typedef float f32x4 __attribute__((ext_vector_type(4)));
typedef unsigned u32x4 __attribute__((ext_vector_type(4)));
typedef unsigned u32x2 __attribute__((ext_vector_type(2)));
constexpr int BM = 256, BK = 64, HALF = 128, HTB = HALF * BK * 2, STAGE_BYTES = 8 * HTB, NXCD = 8, WGM = 8;
__host__ __device__ __forceinline__ int lds_byte(int r, int c) { const int st = (r >> 4) * 2 + (c >> 5), rr = r & 15, cc = c & 31, ob = rr * 64 + cc * 2; return st * 1024 + (ob ^ (((ob >> 9) & 1) << 5)); }
__host__ __device__ __forceinline__ void stage_rc(int b, int& R, int& C) { const int st = b / 1024, sb = b % 1024, swz = sb ^ (((sb >> 9) & 1) << 5); R = (st >> 1) * 16 + swz / 64; C = (st & 1) * 32 + (swz % 64) / 2; }
__host__ __device__ __forceinline__ int perm32(int rho) { const int n = rho >> 4, i = rho & 15; return 8 * (i >> 2) + 4 * n + (i & 3); }

struct Unit { int pm, pn, e, nrow, slot0; };
struct Gemm { int lda, ldb, K; };

__device__ __forceinline__ unsigned cvt_pk_bf16(float lo, float hi) { unsigned r; asm volatile("v_cvt_pk_bf16_f32 %0, %1, %2" : "=v"(r) : "v"(lo), "v"(hi)); return r; }
__device__ __forceinline__ float fsig(float v) { return __builtin_amdgcn_rcpf(1.f + __expf(-v)); }
__device__ __forceinline__ f32x4 sig4(f32x4 v) { return (f32x4){fsig(v[0]), fsig(v[1]), fsig(v[2]), fsig(v[3])}; }
__device__ __forceinline__ f32x4 bfx4(u32x2 w) { return (f32x4){__builtin_bit_cast(float, w.x << 16), __builtin_bit_cast(float, w.x & 0xffff0000u), __builtin_bit_cast(float, w.y << 16), __builtin_bit_cast(float, w.y & 0xffff0000u)}; }

struct StaticOrder {
    static constexpr bool GATHER = false;
    int nM, nN, nwg, G, c; const char* A; const char* Bt; size_t atile, btile;
    __device__ __forceinline__ void init(int M, int N, int G_, int c_, const void* A_, int lda, const void* Bt_, int ldb) { nM = M / BM; nN = N / BM; nwg = nM * nN; G = G_; c = c_; A = (const char*)A_; Bt = (const char*)Bt_; atile = (size_t)BM * lda * 2; btile = (size_t)BM * ldb * 2; }
    __device__ __forceinline__ bool next(int i, Unit& u) const {
        const long L = (long)i * G + c; if (L >= nwg) return false;
        int wgid = (int)L; { const int q = nwg / NXCD, r = nwg % NXCD, xcd = wgid % NXCD, off = wgid / NXCD; wgid = (xcd < r ? xcd * (q + 1) : r * (q + 1) + (xcd - r) * q) + off; }
        const int nig = WGM * nN, gid = wgid / nig, fm = gid * WGM, gsz = (nM - fm) < WGM ? (nM - fm) : WGM;
        u.pm = fm + ((wgid % nig) % gsz); u.pn = (wgid % nig) / gsz; u.e = 0; u.nrow = 256; u.slot0 = 0; return true;
    }
    __device__ __forceinline__ void ptrs(const Unit& u, const char*& cA, const char*& cB) const { cA = A + (size_t)u.pm * atile; cB = Bt + (size_t)u.pn * btile; }
    __device__ __forceinline__ void rows(const Unit&, const int (&)[2], const int (&)[2], unsigned (&)[2][2]) const {}
};

template <class Epi, class Sched, bool ALIGN_EPI>
__device__ __forceinline__ void gemm_phase(PG8_LAS unsigned char* lds, const Gemm g, const Sched& S, const Epi& E) {
    const int tid = threadIdx.x, wid = __builtin_amdgcn_readfirstlane(tid >> 6), lane = tid & 63, wr = wid >> 2, wc = wid & 3, fr = lane & 15, fq = lane >> 4;
    const int K = g.K, nt = K / BK;
    int Rr[2], Cc[2]; unsigned vA[2][2], vN[2][2], voffB[2];
#pragma unroll
    for (int i = 0; i < 2; ++i) { int R, C; stage_rc(tid * 16 + i * 8192, R, C); Rr[i] = R; Cc[i] = C; const int Rb = Epi::PERM ? ((R & ~31) + perm32(R & 31)) : R;
        voffB[i] = (unsigned)(Rb * g.ldb + C) * 2u; vA[0][i] = (unsigned)(R * g.lda + C) * 2u; vA[1][i] = (unsigned)((R + HALF) * g.lda + C) * 2u; vN[0][i] = vA[0][i]; vN[1][i] = vA[1][i]; }
    const size_t kstep = (size_t)(BK * 2);
    const size_t hstepB = (size_t)HALF * g.ldb * 2;
    const unsigned ldsw = (unsigned)wid * 1024u;
    const int aoff = lds_byte(wr * 64 + fr, fq * 8), boff = lds_byte(wc * 32 + fr, fq * 8);
#define PG8_SA(b, h) (((b) * 2 + (h)) * HTB)
#define PG8_SB(b, h) ((4 + (b) * 2 + (h)) * HTB)
#define PG8_STAGE(bufoff, gbase, voff) do { _Pragma("unroll") for (int _i = 0; _i < 2; ++_i) \
        __builtin_amdgcn_global_load_lds((const unsigned*)((const char*)(gbase) + (voff)[_i]), (PG8_LAS unsigned*)(lds + (bufoff) + ldsw + _i * 8192), 16, 0, 0); } while (0)
#define PG8_LDA(dst, b, h) do { _Pragma("unroll") for (int m = 0; m < 4; ++m) _Pragma("unroll") for (int k = 0; k < 2; ++k) dst[m][k] = *(const PG8_LAS bf16x8*)(lds + PG8_SA(b, h) + aoff + m * 2048 + k * 1024); } while (0)
#define PG8_LDB(dst, b, h) do { _Pragma("unroll") for (int n = 0; n < 2; ++n) _Pragma("unroll") for (int k = 0; k < 2; ++k) dst[n][k] = *(const PG8_LAS bf16x8*)(lds + PG8_SB(b, h) + boff + n * 2048 + k * 1024); } while (0)
#define PG8_MMA(ai, bj, At, Bt) do { __builtin_amdgcn_s_setprio(1); _Pragma("unroll") for (int m = 0; m < 4; ++m) _Pragma("unroll") for (int n = 0; n < 2; ++n) _Pragma("unroll") for (int k = 0; k < 2; ++k) \
        acc[ai][bj][m][n] = __builtin_amdgcn_mfma_f32_16x16x32_bf16(Bt[n][k], At[m][k], acc[ai][bj][m][n], 0, 0, 0); __builtin_amdgcn_s_setprio(0); } while (0)
#define PG8_WAIT_V(n) asm volatile("s_waitcnt vmcnt(" #n ")" ::: "memory")
#define PG8_WAIT_L(n) asm volatile("s_waitcnt lgkmcnt(" #n ")" ::: "memory")
#define PG8_BAR __builtin_amdgcn_s_barrier()
#define PG8_SCHED __builtin_amdgcn_sched_barrier(0)
    Unit cur, nxt; int ui = 0;
    if (!S.next(0, cur)) return;
    f32x4 acc[2][2][4][2];
#pragma unroll
    for (int a = 0; a < 2; ++a)
#pragma unroll
        for (int b = 0; b < 2; ++b)
#pragma unroll
            for (int m = 0; m < 4; ++m)
#pragma unroll
                for (int n = 0; n < 2; ++n) acc[a][b][m][n] = (f32x4){0.f, 0.f, 0.f, 0.f};
    bf16x8 At[4][2], B0[2][2], B1[2][2];
    const char* cA; const char* cB; S.ptrs(cur, cA, cB);
    if constexpr (Sched::GATHER) S.rows(cur, Rr, Cc, vA);
    PG8_STAGE(PG8_SB(0, 0), cB, voffB); PG8_STAGE(PG8_SB(0, 1), cB + hstepB, voffB); PG8_STAGE(PG8_SA(0, 0), cA, vA[0]); PG8_STAGE(PG8_SA(0, 1), cA, vA[1]);
    if (wr == 1) PG8_BAR;
    PG8_WAIT_V(2); PG8_BAR;
    PG8_STAGE(PG8_SB(1, 0), cB + kstep, voffB); PG8_STAGE(PG8_SA(1, 0), cA + kstep, vA[0]); PG8_STAGE(PG8_SB(1, 1), cB + hstepB + kstep, voffB);
    PG8_WAIT_V(6); PG8_BAR;
    for (;;) {
        const bool has_next = S.next(ui + 1, nxt);
        const char* nA = cA; const char* nB = cB;
        if (has_next) { S.ptrs(nxt, nA, nB); if constexpr (Sched::GATHER) S.rows(nxt, Rr, Cc, vN); }
        else { if constexpr (Sched::GATHER) {
#pragma unroll
            for (int h = 0; h < 2; ++h)
#pragma unroll
                for (int i = 0; i < 2; ++i) vN[h][i] = vA[h][i]; } }
        for (int t = 0; t < nt; t += 2) {
            const bool last = (t == nt - 2);
            if constexpr (Epi::MID_T > 0) { if (t == Epi::MID_T) E.mid(acc, cur, wr, wc, fr, fq); }
            const char* a1 = cA + (size_t)(t + 1) * kstep;
            const char* a2 = last ? nA : cA + (size_t)(t + 2) * kstep; const char* b2 = last ? nB : cB + (size_t)(t + 2) * kstep;
            const char* a3 = a2 + kstep; const char* b3 = b2 + kstep;
            PG8_LDB(B0, 0, 0); PG8_LDB(B1, 0, 1); PG8_SCHED; PG8_LDA(At, 0, 0); PG8_STAGE(PG8_SA(1, 1), a1, vA[1]);
            PG8_WAIT_V(8); PG8_WAIT_L(0); PG8_BAR; PG8_MMA(0, 0, At, B0); PG8_MMA(0, 1, At, B1); PG8_BAR; PG8_SCHED;
            if constexpr (Sched::GATHER) { if (last) {
#pragma unroll
                for (int h = 0; h < 2; ++h)
#pragma unroll
                    for (int i = 0; i < 2; ++i) vA[h][i] = vN[h][i]; } }
            PG8_LDA(At, 0, 1); PG8_STAGE(PG8_SB(0, 0), b2, voffB); PG8_STAGE(PG8_SB(0, 1), b2 + hstepB, voffB); PG8_STAGE(PG8_SA(0, 0), a2, vA[0]);
            PG8_WAIT_V(8); PG8_WAIT_L(0); PG8_BAR; PG8_MMA(1, 0, At, B0); PG8_MMA(1, 1, At, B1); PG8_BAR; PG8_SCHED;
            PG8_LDB(B0, 1, 0); PG8_LDB(B1, 1, 1); PG8_SCHED; PG8_LDA(At, 1, 0); PG8_STAGE(PG8_SA(0, 1), a2, vA[1]);
            PG8_WAIT_V(8); PG8_WAIT_L(0); PG8_BAR; PG8_MMA(0, 0, At, B0); PG8_MMA(0, 1, At, B1); PG8_BAR; PG8_SCHED;
            PG8_LDA(At, 1, 1); PG8_STAGE(PG8_SB(1, 0), b3, voffB); PG8_STAGE(PG8_SB(1, 1), b3 + hstepB, voffB); PG8_STAGE(PG8_SA(1, 0), a3, vA[0]);
            PG8_WAIT_V(8); PG8_WAIT_L(0); PG8_BAR; PG8_MMA(1, 0, At, B0); PG8_MMA(1, 1, At, B1); PG8_BAR; PG8_SCHED;
        }
        if constexpr (ALIGN_EPI) { if (wr == 0) PG8_BAR; }
        if constexpr (!Epi::AFTER_DRAIN) { E(acc, cur, wr, wc, fr, fq); }
        if (!has_next) break;
#pragma unroll
        for (int a = 0; a < 2; ++a)
#pragma unroll
            for (int b = 0; b < 2; ++b)
#pragma unroll
                for (int m = 0; m < 4; ++m)
#pragma unroll
                    for (int n = 0; n < 2; ++n) acc[a][b][m][n] = (f32x4){0.f, 0.f, 0.f, 0.f};
        cur = nxt; cA = nA; cB = nB; ++ui;
        if constexpr (ALIGN_EPI) { if (wr == 1) PG8_BAR; }
    }
    PG8_WAIT_V(0);
    if constexpr (!ALIGN_EPI) { if (wr == 0) PG8_BAR; }
    PG8_BAR;
    if constexpr (Epi::AFTER_DRAIN) { E.fused(acc, cur, wr, wc, fr, fq, lds, wid, lane); }
#undef PG8_SA
#undef PG8_SB
#undef PG8_STAGE
#undef PG8_LDA
#undef PG8_LDB
#undef PG8_MMA
#undef PG8_WAIT_V
#undef PG8_WAIT_L
#undef PG8_BAR
#undef PG8_SCHED
}

struct EpiInProj {
    static constexpr bool PERM = true, AFTER_DRAIN = false; static constexpr int MID_T = 0;
    bf16_t* R0; size_t rs; const float* b_gate;
    __device__ __forceinline__ void operator()(const f32x4 (&acc)[2][2][4][2], const Unit& u, int wr, int wc, int fr, int fq) const {
        const int row0 = u.pm * BM + wr * 64 + fr, cc = wc * 32 + 8 * fq;
        if (u.pn < 16) {
            const bool sg = u.pn >= 8; bf16_t* O = R0 + (size_t)(sg ? 1 : 0) * rs + (u.pn & 7) * 128 + cc;
#pragma unroll
            for (int ai = 0; ai < 2; ++ai)
#pragma unroll
                for (int m = 0; m < 4; ++m) {
                    f32x4 b0 = acc[ai][1][m][0], b1 = acc[ai][1][m][1];
                    if (sg) { b0 = sig4(b0); b1 = sig4(b1); }
                    const f32x4 v0 = acc[ai][0][m][0] * b0, v1 = acc[ai][0][m][1] * b1;
                    u32x4 w; w.x = cvt_pk_bf16(v0[0], v0[1]); w.y = cvt_pk_bf16(v0[2], v0[3]); w.z = cvt_pk_bf16(v1[0], v1[1]); w.w = cvt_pk_bf16(v1[2], v1[3]);
                    *(u32x4*)(O + (size_t)(row0 + ai * HALF + m * 16) * 1024) = w; }
        } else {
            const int sec = (u.pn - 16) >> 2, ct = ((u.pn - 16) & 3) * 256 + cc;
            bf16_t* O = R0 + (size_t)(2 + sec) * rs + ct;
            f32x4 bv[2][2];
#pragma unroll
            for (int bj = 0; bj < 2; ++bj)
#pragma unroll
                for (int n = 0; n < 2; ++n) bv[bj][n] = sec ? *(const f32x4*)(b_gate + (sec - 1) * 1024 + ct + bj * HALF + 4 * n) : (f32x4){0.f, 0.f, 0.f, 0.f};
#pragma unroll
            for (int ai = 0; ai < 2; ++ai)
#pragma unroll
                for (int m = 0; m < 4; ++m)
#pragma unroll
                    for (int bj = 0; bj < 2; ++bj) {
                        f32x4 v0 = acc[ai][bj][m][0] + bv[bj][0], v1 = acc[ai][bj][m][1] + bv[bj][1];
                        if (sec) { v0 = sig4(v0); v1 = sig4(v1); }
                        u32x4 w; w.x = cvt_pk_bf16(v0[0], v0[1]); w.y = cvt_pk_bf16(v0[2], v0[3]); w.z = cvt_pk_bf16(v1[0], v1[1]); w.w = cvt_pk_bf16(v1[2], v1[3]);
                        *(u32x4*)(O + (size_t)(row0 + ai * HALF + m * 16) * 1024 + bj * HALF) = w; }
        }
    }
};

struct EpiMix {
    static constexpr bool PERM = true, AFTER_DRAIN = false; static constexpr int MID_T = 16;
    const bf16_t *GA, *GB; bf16_t* MIX;
    __device__ __forceinline__ void mid(f32x4 (&acc)[2][2][4][2], const Unit& u, int wr, int wc, int fr, int fq) const {
        int row0 = u.pm * BM + wr * 64 + fr, col0 = u.pn * BM + wc * 32 + 8 * fq;
        asm volatile("" : "+v"(row0), "+v"(col0));
#pragma unroll
        for (int ai = 0; ai < 2; ++ai)
#pragma unroll
            for (int m = 0; m < 4; ++m)
#pragma unroll
                for (int bj = 0; bj < 2; ++bj) { const size_t o = (size_t)(row0 + ai * HALF + m * 16) * 1024 + col0 + bj * HALF;
                    const u32x4 ga = *(const u32x4*)(GA + o), gb = *(const u32x4*)(GB + o);
                    const f32x4 a0 = bfx4((u32x2){ga.x, ga.y}), a1 = bfx4((u32x2){ga.z, ga.w}), b0 = bfx4((u32x2){gb.x, gb.y}), b1 = bfx4((u32x2){gb.z, gb.w});
#pragma unroll
                    for (int j = 0; j < 4; ++j) { acc[ai][bj][m][0][j] *= a0[j] * __builtin_amdgcn_rcpf(b0[j]); acc[ai][bj][m][1][j] *= a1[j] * __builtin_amdgcn_rcpf(b1[j]); }
                    asm volatile("" : "+v"(acc[ai][bj][m][0]), "+v"(acc[ai][bj][m][1]) :: "memory"); }
    }
    __device__ __forceinline__ void operator()(const f32x4 (&acc)[2][2][4][2], const Unit& u, int wr, int wc, int fr, int fq) const {
        const int row0 = u.pm * BM + wr * 64 + fr, col0 = u.pn * BM + wc * 32 + 8 * fq;
#pragma unroll
        for (int ai = 0; ai < 2; ++ai)
#pragma unroll
            for (int m = 0; m < 4; ++m)
#pragma unroll
                for (int bj = 0; bj < 2; ++bj) { const size_t o = (size_t)(row0 + ai * HALF + m * 16) * 1024 + col0 + bj * HALF;
                    const u32x4 gb = *(const u32x4*)(GB + o);
                    const f32x4 v0 = acc[ai][bj][m][0] * bfx4((u32x2){gb.x, gb.y}), v1 = acc[ai][bj][m][1] * bfx4((u32x2){gb.z, gb.w});
                    u32x4 w; w.x = cvt_pk_bf16(v0[0], v0[1]); w.y = cvt_pk_bf16(v0[2], v0[3]); w.z = cvt_pk_bf16(v1[0], v1[1]); w.w = cvt_pk_bf16(v1[2], v1[3]);
                    *(u32x4*)(MIX + o) = w; asm volatile("" ::: "memory"); }
    }
};
struct EpiWo {
    static constexpr bool PERM = false, AFTER_DRAIN = false; static constexpr int MID_T = 0;
    const float* x; float* X1; bf16_t* APLE; float* ssp;
    __device__ __forceinline__ void operator()(const f32x4 (&acc)[2][2][4][2], const Unit& u, int wr, int wc, int fr, int fq) const {
        const int row0 = u.pm * BM + wr * 64 + fr, col0 = u.pn * BM + wc * 32 + 4 * fq;
#pragma unroll
        for (int ai = 0; ai < 2; ++ai)
#pragma unroll
            for (int m = 0; m < 4; ++m) { const int row = row0 + ai * HALF + m * 16; float ss = 0.f;
#pragma unroll
                for (int bj = 0; bj < 2; ++bj)
#pragma unroll
                    for (int n = 0; n < 2; ++n) { const size_t o = (size_t)row * 1024 + col0 + bj * HALF + n * 16;
                        const f32x4 v = *(const f32x4*)(x + o) + acc[ai][bj][m][n];
                        *(f32x4*)(X1 + o) = v; ss += (v[0] * v[0] + v[1] * v[1]) + (v[2] * v[2] + v[3] * v[3]);
                        u32x2 w; w.x = cvt_pk_bf16(v[0], v[1]); w.y = cvt_pk_bf16(v[2], v[3]);
                        *(u32x2*)(APLE + (size_t)row * 1280 + 256 + col0 + bj * HALF + n * 16) = w; }
                ss += __shfl_xor(ss, 16); ss += __shfl_xor(ss, 32);
                if (fq == 0) ssp[(size_t)row * 16 + u.pn * 4 + wc] = ss; }
    }
};
struct EpiRouter {
    static constexpr bool PERM = false, AFTER_DRAIN = true; static constexpr int MID_T = 0;
    const float* ssp1; const float* brg; const float* bre; unsigned* cnt; int* tok_e; float* tok_w; int* tok_pos; float* r1; int* ltok; float* lw; float* lr;
    __device__ __forceinline__ void fused(f32x4 (&acc)[2][2][4][2], const Unit& u, int wr, int wc, int fr, int fq, PG8_LAS unsigned char* lds, int wid, int lane) const {
        PG8_LAS float* L = (PG8_LAS float*)lds;
        PG8_LAS int* hist = (PG8_LAS int*)(lds + 40960);
        const int tid = wid * 64 + lane;
        if (tid < 64) hist[tid] = 0;
        if (wc == 0) {
#pragma unroll
            for (int ai = 0; ai < 2; ++ai)
#pragma unroll
                for (int m = 0; m < 4; ++m)
#pragma unroll
                    for (int n = 0; n < 2; ++n) *(PG8_LAS f32x4*)(L + (ai * HALF + wr * 64 + m * 16 + fr) * 40 + 16 * n + 4 * fq) = acc[ai][0][m][n];
        } else if (wc == 1 && fq == 0) {
#pragma unroll
            for (int ai = 0; ai < 2; ++ai)
#pragma unroll
                for (int m = 0; m < 4; ++m) *(PG8_LAS f32x4*)(L + (ai * HALF + wr * 64 + m * 16 + fr) * 40 + 32) = acc[ai][0][m][0];
        }
        asm volatile("s_waitcnt lgkmcnt(0)" ::: "memory"); __builtin_amdgcn_s_barrier(); asm volatile("" ::: "memory");
        int ea = 0, eb = 0, la = 0, lb = 0; float wa_ = 0.f, wb_ = 0.f, r = 0.f; const int t = u.pm * BM + tid;
        if (tid < 256) {
            float ss = 0.f;
#pragma unroll
            for (int i = 0; i < 16; i += 4) { const f32x4 pv = *(const f32x4*)(ssp1 + (size_t)t * 16 + i); ss += (pv[0] + pv[1]) + (pv[2] + pv[3]); }
            r = rsqrtf(ss * (1.f / 1024.f) + 1e-6f);
            float lg[40];
#pragma unroll
            for (int i = 0; i < 36; i += 4) { const f32x4 v = *(const PG8_LAS f32x4*)(L + tid * 40 + i); lg[i] = v[0]; lg[i + 1] = v[1]; lg[i + 2] = v[2]; lg[i + 3] = v[3]; }
            float gl[4]; int grp = 0;
#pragma unroll
            for (int i = 0; i < 4; ++i) gl[i] = lg[i] * r + brg[i];
            float gm = gl[0];
#pragma unroll
            for (int i = 1; i < 4; ++i) if (gl[i] > gm) { gm = gl[i]; grp = i; }
            float den = 0.f;
#pragma unroll
            for (int i = 0; i < 4; ++i) den += __expf(gl[i] - gm);
            const float pg = 1.f / den;
            float el[8];
#pragma unroll
            for (int i = 0; i < 8; ++i) { float v = 0.f;
#pragma unroll
                for (int g2 = 0; g2 < 4; ++g2) v = (grp == g2) ? lg[4 + g2 * 8 + i] * r + bre[g2 * 8 + i] : v;
                el[i] = v; }
            int i0 = 0; float v0 = el[0];
#pragma unroll
            for (int i = 1; i < 8; ++i) if (el[i] > v0) { v0 = el[i]; i0 = i; }
            int i1 = -1; float v1 = -3.0e38f;
#pragma unroll
            for (int i = 0; i < 8; ++i) if (i != i0 && el[i] > v1) { v1 = el[i]; i1 = i; }
            const float e1 = __expf(v1 - v0); const float s0 = 1.f / (1.f + e1), s1 = e1 / (1.f + e1);
            ea = grp * 8 + i0; eb = grp * 8 + i1; wa_ = s0 * pg; wb_ = s1 * pg;
            la = __hip_atomic_fetch_add(&hist[ea], 1, __ATOMIC_RELAXED, __HIP_MEMORY_SCOPE_WORKGROUP); lb = __hip_atomic_fetch_add(&hist[eb], 1, __ATOMIC_RELAXED, __HIP_MEMORY_SCOPE_WORKGROUP);
        }
        asm volatile("s_waitcnt lgkmcnt(0)" ::: "memory"); __builtin_amdgcn_s_barrier(); asm volatile("" ::: "memory");
        if (tid < 32) { const int h = hist[tid]; hist[32 + tid] = h ? (int)atomicAdd(cnt + tid, (unsigned)h) : 0; }
        asm volatile("s_waitcnt vmcnt(0) lgkmcnt(0)" ::: "memory"); __builtin_amdgcn_s_barrier(); asm volatile("" ::: "memory");
        if (tid < 256) {
            const int pa = hist[32 + ea] + la, pb = hist[32 + eb] + lb;
            tok_e[t * 2] = ea; tok_e[t * 2 + 1] = eb; tok_w[t * 2] = wa_; tok_w[t * 2 + 1] = wb_; tok_pos[t * 2] = pa; tok_pos[t * 2 + 1] = pb; r1[t] = r;
            ltok[(size_t)ea * 32768 + pa] = t; lw[(size_t)ea * 32768 + pa] = wa_; lr[(size_t)ea * 32768 + pa] = r;
            ltok[(size_t)eb * 32768 + pb] = t; lw[(size_t)eb * 32768 + pb] = wb_; lr[(size_t)eb * 32768 + pb] = r;
        }
    }
};
template <bool GATHER_> struct MoeOrder {
    static constexpr bool GATHER = GATHER_;
    const PG8_LAS int* tab; int nwg, G, c; const char* A; const char* Bt; size_t bexp, btile; int lda; const int* ltok;
    __device__ __forceinline__ bool next(int i, Unit& u) const {
        const long L = (long)i * G + c; if (L >= nwg) return false;
        int wgid = (int)L; { const int q = nwg / NXCD, r = nwg % NXCD, xcd = wgid % NXCD, off = wgid / NXCD; wgid = (xcd < r ? xcd * (q + 1) : r * (q + 1) + (xcd - r) * q) + off; }
        int e = 0;
        for (int k = 1; k < 32; ++k) e += (__builtin_amdgcn_readfirstlane(tab[k]) <= wgid) ? 1 : 0;
        const int rem = wgid - __builtin_amdgcn_readfirstlane(tab[e]);
        u.pn = rem & 3; u.pm = rem >> 2; u.e = e; u.nrow = __builtin_amdgcn_readfirstlane(tab[80 + e]) - 256 * u.pm; u.slot0 = __builtin_amdgcn_readfirstlane(tab[40 + e]) + 256 * u.pm; return true;
    }
    __device__ __forceinline__ void ptrs(const Unit& u, const char*& cA, const char*& cB) const {
        cA = GATHER ? A : A + (size_t)u.slot0 * lda * 2; cB = Bt + (size_t)u.e * bexp + (size_t)u.pn * btile; }
    __device__ __forceinline__ void rows(const Unit& u, const int (&Rr)[2], const int (&Cc)[2], unsigned (&off)[2][2]) const {
#pragma unroll
        for (int h = 0; h < 2; ++h)
#pragma unroll
            for (int i = 0; i < 2; ++i) { const int r = h * HALF + Rr[i]; const int tok = (r < u.nrow) ? ltok[(size_t)u.e * 32768 + 256 * u.pm + r] : 0; off[h][i] = (unsigned)(tok * lda + Cc[i]) * 2u; }
    }
};
struct EpiMoeUp {
    static constexpr bool PERM = true, AFTER_DRAIN = false; static constexpr int MID_T = 0;
    const float* lr; bf16_t* HMID;
    __device__ __forceinline__ void operator()(const f32x4 (&acc)[2][2][4][2], const Unit& u, int wr, int wc, int fr, int fq) const {
        const int cc = u.pn * 128 + wc * 32 + 8 * fq;
#pragma unroll
        for (int ai = 0; ai < 2; ++ai)
#pragma unroll
            for (int m = 0; m < 4; ++m) { const int row = ai * HALF + wr * 64 + m * 16 + fr;
                if (row < u.nrow) { const float r = lr[(size_t)u.e * 32768 + 256 * u.pm + row];
                    f32x4 v[2];
#pragma unroll
                    for (int n = 0; n < 2; ++n)
#pragma unroll
                        for (int j = 0; j < 4; ++j) { const float g = acc[ai][0][m][n][j] * r, up = acc[ai][1][m][n][j] * r; v[n][j] = g * fsig(g) * up; }
                    u32x4 w; w.x = cvt_pk_bf16(v[0][0], v[0][1]); w.y = cvt_pk_bf16(v[0][2], v[0][3]); w.z = cvt_pk_bf16(v[1][0], v[1][1]); w.w = cvt_pk_bf16(v[1][2], v[1][3]);
                    *(u32x4*)(HMID + (size_t)(u.slot0 + row) * 512 + cc) = w; } }
    }
};
struct EpiMoeDown {
    static constexpr bool PERM = true, AFTER_DRAIN = false; static constexpr int MID_T = 0;
    const float* lw; bf16_t* YB;
    __device__ __forceinline__ void operator()(const f32x4 (&acc)[2][2][4][2], const Unit& u, int wr, int wc, int fr, int fq) const {
        const int cc = u.pn * 256 + wc * 32 + 8 * fq;
#pragma unroll
        for (int ai = 0; ai < 2; ++ai)
#pragma unroll
            for (int m = 0; m < 4; ++m) { const int row = ai * HALF + wr * 64 + m * 16 + fr;
                if (row < u.nrow) { const float gw = lw[(size_t)u.e * 32768 + 256 * u.pm + row];
#pragma unroll
                    for (int bj = 0; bj < 2; ++bj) { const f32x4 v0 = acc[ai][bj][m][0] * gw, v1 = acc[ai][bj][m][1] * gw;
                        u32x4 w; w.x = cvt_pk_bf16(v0[0], v0[1]); w.y = cvt_pk_bf16(v0[2], v0[3]); w.z = cvt_pk_bf16(v1[0], v1[1]); w.w = cvt_pk_bf16(v1[2], v1[3]);
                        *(u32x4*)(YB + (size_t)(u.slot0 + row) * 1024 + cc + bj * HALF) = w; } } }
    }
};
struct EpiPle {
    static constexpr bool PERM = false, AFTER_DRAIN = false; static constexpr int MID_T = 4;
    const float* X2; const float* r2; float* X3; float* ssp; u32x2* scr;
    __device__ __forceinline__ void mid(f32x4 (&acc)[2][2][4][2], const Unit&, int, int, int, int) const {
        int tid = threadIdx.x;
        asm volatile("" : "+v"(tid));
#pragma unroll
        for (int ai = 0; ai < 2; ++ai)
#pragma unroll
            for (int bj = 0; bj < 2; ++bj)
#pragma unroll
                for (int m = 0; m < 4; ++m)
#pragma unroll
                    for (int n = 0; n < 2; ++n) { const f32x4 v = acc[ai][bj][m][n]; u32x2 w; w.x = cvt_pk_bf16(v[0], v[1]); w.y = cvt_pk_bf16(v[2], v[3]);
                        scr[(((ai * 2 + bj) * 4 + m) * 2 + n) * 512 + tid] = w; acc[ai][bj][m][n] = (f32x4){0.f, 0.f, 0.f, 0.f}; asm volatile("" ::: "memory"); }
    }
    __device__ __forceinline__ void operator()(const f32x4 (&acc)[2][2][4][2], const Unit& u, int wr, int wc, int fr, int fq) const {
        int tid = threadIdx.x; int row0 = u.pm * BM + wr * 64 + fr, col0 = u.pn * BM + wc * 32 + 4 * fq;
        asm volatile("" : "+v"(tid), "+v"(row0), "+v"(col0));
#pragma unroll
        for (int ai = 0; ai < 2; ++ai)
#pragma unroll
            for (int m = 0; m < 4; ++m) { const int row = row0 + ai * HALF + m * 16; const float rr = r2[row]; float ss = 0.f;
#pragma unroll
                for (int bj = 0; bj < 2; ++bj)
#pragma unroll
                    for (int n = 0; n < 2; ++n) { const size_t o = (size_t)row * 1024 + col0 + bj * HALF + n * 16;
                        const f32x4 pr = bfx4(scr[(((ai * 2 + bj) * 4 + m) * 2 + n) * 512 + tid]); const f32x4 a = acc[ai][bj][m][n] * rr;
                        const f32x4 v = *(const f32x4*)(X2 + o) + sig4(a) * pr;
                        *(f32x4*)(X3 + o) = v; ss += (v[0] * v[0] + v[1] * v[1]) + (v[2] * v[2] + v[3] * v[3]); }
                ss += __shfl_xor(ss, 16); ss += __shfl_xor(ss, 32);
                if (fq == 0) ssp[(size_t)row * 16 + u.pn * 4 + wc] = ss; asm volatile("" ::: "memory"); }
    }
};
}

#define GAS __attribute__((address_space(1)))
#define LAS __attribute__((address_space(3)))
typedef unsigned v4u __attribute__((ext_vector_type(4)));
typedef GAS unsigned gu32;
constexpr int NWAVES = 8;
constexpr int RING_BYTES = 131072, LDSCTL_OFF = RING_BYTES, MISC_OFF = LDSCTL_OFF + 320, LDS_BYTES = 147456;
constexpr size_t WS_WIN = 12 * MiB, WS_WAB = 26 * MiB, WS_WO = 30 * MiB, WS_WPLE = 32 * MiB, WS_WR = 35 * MiB, WS_WGU = 36 * MiB, WS_WD = 100 * MiB;
constexpr size_t WS_LR = 132 * MiB;
constexpr size_t WS_SCR = 464 * MiB;
constexpr size_t WS_END2 = 496 * MiB;
constexpr int CW_BAR = 4096;
#define LDS_WAIT() asm volatile("s_waitcnt lgkmcnt(0)" ::: "memory")
#define VM_WAIT() asm volatile("s_waitcnt vmcnt(0)" ::: "memory")

#define XB_TMO      128
#define XB_XCNT(j)  (256  + 64 * (j))
#define XB_XSUB(j)  (1280 + 64 * (j))
#define XB_XGEN(j)  (2304 + 64 * (j))
#define XB_TOP      3328
#define XB_TOPGEN   3392
#define XCD_BAR_WORDS 3456
#define XB_SPIN_CAP (1u << 18)
__device__ __forceinline__ unsigned xb_ld(unsigned* p)              { return __hip_atomic_load(p, __ATOMIC_RELAXED, __HIP_MEMORY_SCOPE_AGENT); }
__device__ __forceinline__ unsigned xb_add(unsigned* p, unsigned v) { return __hip_atomic_fetch_add(p, v, __ATOMIC_RELAXED, __HIP_MEMORY_SCOPE_AGENT); }
__device__ __forceinline__ unsigned xb_xcc_id() { return (unsigned)__builtin_amdgcn_s_getreg((3 << 11) | 20) & 0xFu; }
#define XB_SPIN(cond, bar) do { unsigned _sp = 0; while (cond) { __builtin_amdgcn_s_sleep(1); \
    if ((++_sp & 255u) == 0u) { if (xb_ld(&(bar)[XB_TMO])) break; if (_sp > XB_SPIN_CAP) { atomicAdd(&(bar)[XB_TMO], 1u); break; } } } } while (0)
struct XcdBarrier { unsigned* bar; unsigned x; volatile LAS unsigned* st; };
__device__ __forceinline__ XcdBarrier xcd_barrier_post(unsigned* bar, volatile LAS unsigned* st) {
    XcdBarrier b; b.bar = bar; b.x = xb_xcc_id(); b.st = st;
    if (threadIdx.x == 0) (void)xb_add(&bar[XB_XCNT(b.x)], 1u);
    return b;
}
__device__ __forceinline__ void xcd_barrier_complete(unsigned* bar, unsigned x, unsigned& nloc, unsigned& nx) {
    const unsigned G = gridDim.x * gridDim.y * gridDim.z;
    unsigned sum, cnt, mine, sp = 0u;
    for (;;) {
        sum = 0u; cnt = 0u; mine = 0u;
#pragma unroll
        for (unsigned j = 0; j < 16; ++j) { const unsigned c = xb_ld(&bar[XB_XCNT(j)]); sum += c; cnt += (c > 0u) ? 1u : 0u; mine = (j == x) ? c : mine; }
        if (sum == G) break;
        __builtin_amdgcn_s_sleep(1);
        if ((++sp & 255u) == 0u) { if (xb_ld(&bar[XB_TMO])) break; if (sp > XB_SPIN_CAP) { atomicAdd(&bar[XB_TMO], 1u); break; } }
    }
    nloc = mine > 0u ? mine : 1u; nx = cnt > 0u ? cnt : 1u;
}
__device__ __forceinline__ void xcd_barrier(const XcdBarrier& b) {
    asm volatile("s_waitcnt vmcnt(0)" ::: "memory");
    __syncthreads();
    if (threadIdx.x == 0) {
        unsigned* bar = b.bar;
        __builtin_amdgcn_s_waitcnt(0);
        unsigned nloc = b.st[0], nx = b.st[1];
        if (nloc == 0u) { xcd_barrier_complete(bar, b.x, nloc, nx); b.st[0] = nloc; b.st[1] = nx; }
        const unsigned old = xb_add(&bar[XB_XSUB(b.x)], 1u);
        const unsigned gen = old / nloc;
        if (old + 1u == (gen + 1u) * nloc) {
            __builtin_amdgcn_fence(__ATOMIC_RELEASE, "agent");
            asm volatile("s_waitcnt vmcnt(0)" ::: "memory");
            const unsigned og = xb_add(&bar[XB_TOP], 1u);
            const unsigned tg = og / nx;
            if (og + 1u == (tg + 1u) * nx) xb_add(&bar[XB_TOPGEN], 1u);
            else XB_SPIN(xb_ld(&bar[XB_TOPGEN]) == tg, bar);
            __builtin_amdgcn_fence(__ATOMIC_ACQUIRE, "agent");
            xb_add(&bar[XB_XGEN(b.x)], 1u);
            asm volatile("s_waitcnt vmcnt(0)" ::: "memory");
        } else {
            XB_SPIN(xb_ld(&bar[XB_XGEN(b.x)]) == gen, bar);
            __builtin_amdgcn_fence(__ATOMIC_ACQUIRE, "agent");
            asm volatile("s_waitcnt vmcnt(0)" ::: "memory");
        }
    }
    __syncthreads();
}

__device__ __forceinline__ unsigned pk2(float lo, float hi) { return f2bf(lo) | (f2bf(hi) << 16); }
__device__ __forceinline__ void tr_item(const float* __restrict__ W, int ldn, int k0, int n0, bf16* dst, int ldb, int drow0, int dk0, const float* __restrict__ scale, LAS float* scr, int lane) {
#pragma unroll 8
    for (int i = 0; i < 32; ++i) { const int kk = 2 * i + (lane >> 5); float v = W[(size_t)(k0 + kk) * ldn + n0 + (lane & 31)]; if (scale) v *= scale[k0 + kk]; scr[kk * 33 + (lane & 31)] = v; }
    LDS_WAIT(); asm volatile("" ::: "memory");
    const int c = lane & 7;
#pragma unroll
    for (int j = 0; j < 4; ++j) { const int n = (lane >> 3) + 8 * j; const LAS float* s = scr + (8 * c) * 33 + n;
        v4u o; o.x = pk2(s[0 * 33], s[1 * 33]); o.y = pk2(s[2 * 33], s[3 * 33]); o.z = pk2(s[4 * 33], s[5 * 33]); o.w = pk2(s[6 * 33], s[7 * 33]);
        *(GAS v4u*)(dst + (size_t)(drow0 + n) * ldb + dk0 + k0 + 8 * c) = o; }
    LDS_WAIT(); asm volatile("" ::: "memory");
}
__device__ __forceinline__ int map_in(int n0) {
    const int q = n0 >> 7, s = q >> 3, i = q & 7, off = n0 & 127;
    if (s == 0) return 4096 + 128 * i + off;
    if (s == 1) return 256 * i + off;
    if (s == 2) return 256 * i + 128 + off;
    if (s == 3) return 256 * (8 + i) + off;
    if (s == 4) return 256 * (8 + i) + 128 + off;
    if (s == 5) return 5120 + 128 * i + off;
    return 6144 + 128 * i + off;
}

struct Args { const float* in[25]; float* out; unsigned char* ws; int ph_lo, ph_hi; };

__global__ void __launch_bounds__(NWAVES * 64, 2) mega(Args args) {
    extern __shared__ __attribute__((aligned(16))) unsigned char lds_raw[];
    LAS unsigned char* lds = (LAS unsigned char*)lds_raw;
    volatile LAS unsigned* MISC = (volatile LAS unsigned*)(lds + MISC_OFF);
    const int tid = threadIdx.x, lane = tid & 63, wave = __builtin_amdgcn_readfirstlane(tid >> 6);
    const int G = gridDim.x; const int bx = blockIdx.x; const int vcu = (G % 8 == 0) ? (bx % 8) * (G / 8) + bx / 8 : bx;
    unsigned char* ws = args.ws;
    gu32* ctl = (gu32*)(ws + WS_CTL);
    for (int u = tid; u < (LDS_BYTES - LDSCTL_OFF) / 4; u += NWAVES * 64) ((LAS unsigned*)(lds + LDSCTL_OFF))[u] = 0u;
    __syncthreads();
    XcdBarrier bar = xcd_barrier_post((unsigned*)(ctl + CW_BAR), MISC + 8);
    const int lo = args.ph_lo, hi = args.ph_hi;
#ifndef PH_MASK
#define PH_MASK 0x7ff
#endif
#define IN(k) (((PH_MASK >> (k)) & 1) && lo <= (k) && (k) < hi)
#define BOTH(k) (IN(k) && IN((k) + 1))
    const float* x = args.in[0];
    bf16* H = (bf16*)args.out;
    bf16* WinT = (bf16*)(ws + WS_WIN); bf16* WabT = (bf16*)(ws + WS_WAB); bf16* WoT = (bf16*)(ws + WS_WO); bf16* WpleT = (bf16*)(ws + WS_WPLE); bf16* WrT = (bf16*)(ws + WS_WR);
    bf16* WguT = (bf16*)(ws + WS_WGU); bf16* WdT = (bf16*)(ws + WS_WD);
    bf16* UA = (bf16*)(ws + WS_RA); bf16* UB = (bf16*)(ws + WS_RB); bf16* AB = (bf16*)(ws + WS_RC); bf16* GA = (bf16*)(ws + WS_RD); bf16* GB = (bf16*)(ws + WS_RE);

    if (IN(0)) {
        LAS float* scr = (LAS float*)(lds + wave * 16384);
        const int gw = vcu * NWAVES + wave, NGW = G * NWAVES;
        constexpr int I_IN = 16 * 224, I_SQ = 16 * 32, I_PP = 4 * 32, I_EG = 32 * 16 * 16, I_ED = 32 * 8 * 32;
        constexpr int NITEMS = I_IN + 4 * I_SQ + I_PP + 2 * I_EG + I_ED;
        for (int it = gw; it < NITEMS; it += NGW) {
            int r = it;
            if (r < I_IN) { const int kb = r / 224, nb = r % 224; tr_item(args.in[3], INC, 64 * kb, 32 * nb, WinT, 1024, map_in(32 * nb), 0, nullptr, scr, lane); continue; } r -= I_IN;
            if (r < I_SQ) { tr_item(args.in[5], D, 64 * (r / 32), 32 * (r % 32), WabT, 2048, 32 * (r % 32), 0, nullptr, scr, lane); continue; } r -= I_SQ;
            if (r < I_SQ) { tr_item(args.in[10], D, 64 * (r / 32), 32 * (r % 32), WabT, 2048, 32 * (r % 32), 1024, nullptr, scr, lane); continue; } r -= I_SQ;
            if (r < I_SQ) { tr_item(args.in[12], D, 64 * (r / 32), 32 * (r % 32), WoT, 1024, 32 * (r % 32), 0, nullptr, scr, lane); continue; } r -= I_SQ;
            if (r < I_SQ) { tr_item(args.in[22], D, 64 * (r / 32), 32 * (r % 32), WpleT, 1280, 32 * (r % 32), 256, args.in[21], scr, lane); continue; } r -= I_SQ;
            if (r < I_PP) { tr_item(args.in[23], D, 64 * (r / 32), 32 * (r % 32), WpleT, 1280, 32 * (r % 32), 0, nullptr, scr, lane); continue; } r -= I_PP;
            if (r < 2 * I_EG) { const int up = r >= I_EG; if (up) r -= I_EG; const int e = r / 256, q = r % 256, kb = q / 16, nb = q % 16, n0 = 32 * nb;
                tr_item((up ? args.in[19] : args.in[18]) + (size_t)e * D * DE, DE, 64 * kb, n0, WguT + (size_t)e * 1024 * 1024, 1024, 256 * (n0 >> 7) + (up ? 128 : 0) + (n0 & 127), 0, args.in[13], scr, lane); continue; } r -= 2 * I_EG;
            { const int e = r / 256, q = r % 256, kb = q / 32, nb = q % 32; tr_item(args.in[20] + (size_t)e * DE * D, D, 64 * kb, 32 * nb, WdT + (size_t)e * 1024 * 512, 512, 32 * nb, 0, nullptr, scr, lane); }
        }
        for (int i = vcu * 512 + tid; i < 256 * 1024; i += G * 512) { const int rr = i >> 10, k = i & 1023; float v = 0.f;
            if (rr < 4) v = args.in[14][k * 4 + rr] * args.in[13][k]; else if (rr < 36) v = args.in[16][k * 32 + rr - 4] * args.in[13][k];
            WrT[i] = (bf16)f2bf(v); }
        const float* g = args.in[2];
        for (int row = gw; row < T; row += NGW) {
            const float4* xr = (const float4*)(x + (size_t)row * D);
            float4 v[4]; float s = 0.f;
#pragma unroll
            for (int j = 0; j < 4; ++j) { v[j] = xr[lane + 64 * j]; s += v[j].x * v[j].x + v[j].y * v[j].y + v[j].z * v[j].z + v[j].w * v[j].w; }
            const float r = rsqrtf(wave_sum(s) * (1.f / D) + EPS);
#pragma unroll
            for (int j = 0; j < 4; ++j) { const int c = 4 * (lane + 64 * j); const float4 gg = *(const float4*)(g + c);
                uint2 o; o.x = pk2(v[j].x * r * gg.x, v[j].y * r * gg.y); o.y = pk2(v[j].z * r * gg.z, v[j].w * r * gg.w);
                *(uint2*)(H + (size_t)row * D + c) = o; }
        }
        if (BOTH(0)) xcd_barrier(bar);
    }
    if (IN(1)) {
        pg8::Gemm g{1024, 1024, 1024}; pg8::StaticOrder S; S.init(T, INC, G, bx, H, 1024, WinT, 1024);
        pg8::EpiInProj E{UA, (size_t)(WS_RB - WS_RA) / 2, args.in[11]};
        pg8::gemm_phase<pg8::EpiInProj, pg8::StaticOrder, true>(lds, g, S, E);
        if (BOTH(1)) xcd_barrier(bar);
    }

    bf16* ZZ = (bf16*)args.out; bf16* MIX = (bf16*)(ws + WS_RC); float* X1 = (float*)(ws + WS_RA); bf16* APLE = (bf16*)args.out;
    bf16* HMID = (bf16*)(ws + WS_RC); bf16* YB = (bf16*)(ws + WS_RD); float* X3 = (float*)(ws + WS_RC);
    int* tok_e = (int*)(ws + WS_TOK); float* tok_w = (float*)(ws + WS_TOK + 256 * 1024); int* tok_pos = (int*)(ws + WS_TOK + 512 * 1024);
    float* r1 = (float*)(ws + WS_TOK + 768 * 1024); float* r2 = (float*)(ws + WS_TOK + 896 * 1024);
    float* ssp1 = (float*)(ws + WS_SSP1); float* ssp3 = (float*)(ws + WS_SSP3); int* ltok = (int*)(ws + WS_LTOK); float* lw = (float*)(ws + WS_LW); float* lr = (float*)(ws + WS_LR);
    unsigned* cnt = (unsigned*)(ctl + CW_CNT);
    LAS int* tab = (LAS int*)(lds + LDSCTL_OFF + 1024);
#define MOE_TABLES() do { if (tid == 0) { int us = 0, es = 0; for (int e = 0; e < NE; ++e) { const int c = (int)cnt[e]; tab[e] = us; tab[40 + e] = es; tab[80 + e] = c; us += 4 * ((c + 255) >> 8); es += c; } tab[32] = us; tab[72] = es; } \
        LDS_WAIT(); __syncthreads(); } while (0)

    if (IN(2)) {
        typedef float f32x2 __attribute__((ext_vector_type(2)));
        const int c0 = 2 * tid;
        const float* cwb = args.in[6]; const float* cwa = args.in[4];
        LAS float* red = (LAS float*)lds; LAS float* tot = (LAS float*)(lds + 4096);
        const int upw = (1024 + G - 1) / G;
        for (int un = vcu * upw; un < (vcu + 1) * upw && un < 1024; ++un) {
            const int t0 = un * 32; const bool first = (t0 & (SEQ - 1)) == 0;
            f32x2 wb[31];
#pragma unroll
            for (int k = 0; k < 31; ++k) wb[k] = *(const f32x2*)(cwb + k * 1024 + c0);
            const f32x2 bb = *(const f32x2*)(args.in[7] + c0);
            f32x2 acc[32];
#pragma unroll
            for (int j = 0; j < 32; ++j) acc[j] = bb;
#pragma unroll
            for (int si = 0; si < 62; ++si) {
                const bool dead = first && si < 30;
                const unsigned w = *(const unsigned*)(UB + (size_t)(dead ? t0 : t0 - 30 + si) * 1024 + c0);
                f32x2 uv = (f32x2){__builtin_bit_cast(float, w << 16), __builtin_bit_cast(float, w & 0xffff0000u)};
                if (dead) uv = (f32x2){0.f, 0.f};
#pragma unroll
                for (int j = (si > 30 ? si - 30 : 0); j <= (si < 31 ? si : 31); ++j) acc[j] += wb[si - j] * uv;
            }
            float v1[32], v2[32];
#pragma unroll
            for (int j = 0; j < 32; ++j) { v1[j] = acc[j].x + acc[j].y; v2[j] = acc[j].x * acc[j].x + acc[j].y * acc[j].y; }
#define BFLY(v, NN, bit) _Pragma("unroll") for (int i = 0; i < (NN) / 2; ++i) { const bool up_ = (lane & (bit)) != 0; const float keep_ = up_ ? v[i + (NN) / 2] : v[i], send_ = up_ ? v[i] : v[i + (NN) / 2]; v[i] = keep_ + __shfl_xor(send_, (bit)); }
            BFLY(v1, 32, 16) BFLY(v1, 16, 8) BFLY(v1, 8, 4) BFLY(v1, 4, 2) BFLY(v1, 2, 1)
            BFLY(v2, 32, 16) BFLY(v2, 16, 8) BFLY(v2, 8, 4) BFLY(v2, 4, 2) BFLY(v2, 2, 1)
#undef BFLY
            v1[0] += __shfl_xor(v1[0], 32); v2[0] += __shfl_xor(v2[0], 32);
            red[wave * 64 + lane] = lane < 32 ? v1[0] : v2[0];
            LDS_WAIT(); __syncthreads();
            if (tid < 64) { float sm = 0.f;
#pragma unroll
                for (int w8 = 0; w8 < 8; ++w8) sm += red[w8 * 64 + tid];
                tot[tid] = sm; }
            LDS_WAIT(); __syncthreads();
            const f32x2 lg = *(const f32x2*)(args.in[8] + c0), lb = *(const f32x2*)(args.in[9] + c0);
#pragma unroll
            for (int j = 0; j < 32; ++j) { const float mu = tot[j] * (1.f / 1024.f); const float var = tot[32 + j] * (1.f / 1024.f) - mu * mu; const float rstd = rsqrtf(var + EPS);
                const f32x2 y = (acc[j] - mu) * rstd * lg + lb;
                *(unsigned*)(ZZ + (size_t)(t0 + j) * 2048 + 1024 + c0) = pg8::cvt_pk_bf16(y.x * pg8::fsig(y.x), y.y * pg8::fsig(y.y)); }
            const f32x2 wa0 = *(const f32x2*)(cwa + c0), wa1 = *(const f32x2*)(cwa + 1024 + c0), wa2 = *(const f32x2*)(cwa + 2048 + c0);
            f32x2 u0, u1;
            { const unsigned w0 = *(const unsigned*)(UA + (size_t)(first ? t0 : t0 - 2) * 1024 + c0), w1 = *(const unsigned*)(UA + (size_t)(first ? t0 : t0 - 1) * 1024 + c0);
              u0 = (f32x2){__builtin_bit_cast(float, w0 << 16), __builtin_bit_cast(float, w0 & 0xffff0000u)}; u1 = (f32x2){__builtin_bit_cast(float, w1 << 16), __builtin_bit_cast(float, w1 & 0xffff0000u)};
              if (first) { u0 = (f32x2){0.f, 0.f}; u1 = (f32x2){0.f, 0.f}; } }
#pragma unroll 8
            for (int j = 0; j < 32; ++j) { const unsigned w2 = *(const unsigned*)(UA + (size_t)(t0 + j) * 1024 + c0), wab = *(const unsigned*)(AB + (size_t)(t0 + j) * 1024 + c0);
                const f32x2 u2 = (f32x2){__builtin_bit_cast(float, w2 << 16), __builtin_bit_cast(float, w2 & 0xffff0000u)}, ab = (f32x2){__builtin_bit_cast(float, wab << 16), __builtin_bit_cast(float, wab & 0xffff0000u)};
                const f32x2 za = ab * (wa0 * u0 + wa1 * u1 + wa2 * u2);
                *(unsigned*)(ZZ + (size_t)(t0 + j) * 2048 + c0) = pg8::cvt_pk_bf16(za.x, za.y); u0 = u1; u1 = u2; }
        }
        if (BOTH(2)) xcd_barrier(bar);
    }
    if (IN(3)) {
        pg8::Gemm g{2048, 2048, 2048}; pg8::StaticOrder S; S.init(T, D, G, bx, ZZ, 2048, WabT, 2048);
        pg8::EpiMix E{GA, GB, MIX};
        pg8::gemm_phase<pg8::EpiMix, pg8::StaticOrder, true>(lds, g, S, E);
        if (BOTH(3)) xcd_barrier(bar);
    }
    if (IN(4)) {
        pg8::Gemm g{1024, 1024, 1024}; pg8::StaticOrder S; S.init(T, D, G, bx, MIX, 1024, WoT, 1024);
        pg8::EpiWo E{x, X1, APLE, ssp1};
        pg8::gemm_phase<pg8::EpiWo, pg8::StaticOrder, true>(lds, g, S, E);
        if (BOTH(4)) xcd_barrier(bar);
    }
    if (IN(5)) {
        pg8::Gemm g{1280, 1024, 1024}; pg8::StaticOrder S; S.init(T, 256, G, bx, APLE + 256, 1280, WrT, 1024);
        pg8::EpiRouter E{ssp1, args.in[15], args.in[17], cnt, tok_e, tok_w, tok_pos, r1, ltok, lw, lr};
        pg8::gemm_phase<pg8::EpiRouter, pg8::StaticOrder, false>(lds, g, S, E);
        const int nidle = G > 128 ? G - 128 : G, me = G > 128 ? bx - 128 : bx;
        if (me >= 0) { const float* p = args.in[1];
            for (size_t i = (size_t)me * 512 + tid; i < (size_t)T * 64; i += (size_t)nidle * 512) { const size_t t = i >> 6; const int c = (int)(i & 63) * 4; const float4 v = *(const float4*)(p + t * PLE + c);
                uint2 o; o.x = pk2(v.x, v.y); o.y = pk2(v.z, v.w); *(uint2*)(APLE + t * APITCH + c) = o; } }
        if (BOTH(5)) xcd_barrier(bar);
    }
    if (IN(6)) {
        MOE_TABLES();
        pg8::Gemm g{1280, 1024, 1024};
        pg8::MoeOrder<true> S{tab, tab[32], G, bx, (const char*)(APLE + 256), (const char*)WguT, (size_t)1024 * 1024 * 2, (size_t)256 * 1024 * 2, 1280, ltok};
        pg8::EpiMoeUp E{lr, HMID};
        pg8::gemm_phase<pg8::EpiMoeUp, pg8::MoeOrder<true>, true>(lds, g, S, E);
        if (BOTH(6)) xcd_barrier(bar);
    }
    if (IN(7)) {
        MOE_TABLES();
        pg8::Gemm g{512, 512, 512};
        pg8::MoeOrder<false> S{tab, tab[32], G, bx, (const char*)HMID, (const char*)WdT, (size_t)1024 * 512 * 2, (size_t)256 * 512 * 2, 512, ltok};
        pg8::EpiMoeDown E{lw, YB};
        pg8::gemm_phase<pg8::EpiMoeDown, pg8::MoeOrder<false>, true>(lds, g, S, E);
        if (BOTH(7)) xcd_barrier(bar);
    }
    if (IN(8)) {
        MOE_TABLES();
        const int gw = vcu * NWAVES + wave, NGW = G * NWAVES;
        for (int t = gw; t < T; t += NGW) {
            const int sa = tab[40 + tok_e[t * 2]] + tok_pos[t * 2], sb = tab[40 + tok_e[t * 2 + 1]] + tok_pos[t * 2 + 1];
            float s = 0.f;
#pragma unroll
            for (int j = 0; j < 4; ++j) { const int c = 4 * (lane + 64 * j);
                float4 v = *(const float4*)(X1 + (size_t)t * D + c);
                const uint2 ya = *(const uint2*)(YB + (size_t)sa * D + c), yb = *(const uint2*)(YB + (size_t)sb * D + c);
                v.x += bf2f(ya.x & 0xffff) + bf2f(yb.x & 0xffff); v.y += bf2f(ya.x >> 16) + bf2f(yb.x >> 16);
                v.z += bf2f(ya.y & 0xffff) + bf2f(yb.y & 0xffff); v.w += bf2f(ya.y >> 16) + bf2f(yb.y >> 16);
                s += v.x * v.x + v.y * v.y + v.z * v.z + v.w * v.w;
                *(float4*)(X1 + (size_t)t * D + c) = v;
                uint2 o; o.x = pk2(v.x, v.y); o.y = pk2(v.z, v.w);
                *(uint2*)(APLE + (size_t)t * APITCH + 256 + c) = o; }
            s = wave_sum(s);
            if (lane == 0) r2[t] = rsqrtf(s * (1.f / D) + EPS);
        }
        if (BOTH(8)) xcd_barrier(bar);
    }
    if (IN(9)) {
        pg8::Gemm g{1280, 1280, 1280}; pg8::StaticOrder S; S.init(T, D, G, bx, APLE, 1280, WpleT, 1280);
        pg8::EpiPle E{X1, r2, X3, ssp3, (pg8::u32x2*)(ws + WS_SCR + (size_t)bx * 131072)};
        pg8::gemm_phase<pg8::EpiPle, pg8::StaticOrder, true>(lds, g, S, E);
        if (BOTH(9)) xcd_barrier(bar);
    }
    if (IN(10)) {
        const int gw = vcu * NWAVES + wave, NGW = G * NWAVES; const float* gfin = args.in[24];
        for (int row = gw; row < T; row += NGW) {
            float ss = lane < 16 ? ssp3[(size_t)row * 16 + lane] : 0.f; ss = wave_sum(ss);
            const float r = rsqrtf(ss * (1.f / D) + EPS);
#pragma unroll
            for (int j = 0; j < 4; ++j) { const int c = 4 * (lane + 64 * j); const float4 v = *(const float4*)(X3 + (size_t)row * D + c); const float4 gg = *(const float4*)(gfin + c);
                *(float4*)(args.out + (size_t)row * D + c) = make_float4(v.x * r * gg.x, v.y * r * gg.y, v.z * r * gg.z, v.w * r * gg.w); }
        }
    }
#undef MOE_TABLES
#undef IN
#undef BOTH
}

#ifndef OPT_UPTO
#define OPT_UPTO 11
#endif
extern "C" void kernel_launch(void* const* d_in, const int* in_sizes, int n_in, void* d_out, int out_size, void* d_ws, size_t ws_size, hipStream_t stream) {
    static int grid = 0;
    if (grid == 0) {
        if (n_in != 25 || in_sizes[0] != T * D || out_size != T * D || ws_size < WS_END2) { fprintf(stderr, "kernel_launch: unexpected shapes (n_in %d, in0 %d, out %d, ws %zu)\n", n_in, n_in > 0 ? in_sizes[0] : -1, out_size, ws_size); grid = -1; return; }
        int dev = 0, cus = 0, per_cu = 0;
        if (hipGetDevice(&dev) != hipSuccess || hipDeviceGetAttribute(&cus, hipDeviceAttributeMultiprocessorCount, dev) != hipSuccess) { fprintf(stderr, "kernel_launch: device query failed\n"); grid = -1; return; }
        if (hipFuncSetAttribute((const void*)mega, hipFuncAttributeMaxDynamicSharedMemorySize, LDS_BYTES) != hipSuccess) { fprintf(stderr, "kernel_launch: hipFuncSetAttribute failed\n"); grid = -1; return; }
        if (hipOccupancyMaxActiveBlocksPerMultiprocessor(&per_cu, (const void*)mega, NWAVES * 64, LDS_BYTES) != hipSuccess || per_cu < 1) { fprintf(stderr, "kernel_launch: occupancy query says %d blocks per CU\n", per_cu); (void)hipGetLastError(); grid = -1; return; }
        grid = cus;
    }
    if (grid < 0) return;
    const float* x = (const float*)d_in[0]; const float* p = (const float*)d_in[1];
    const float* conv_a_w = (const float*)d_in[4]; const float* w_out_a = (const float*)d_in[5]; const float* conv_b_w = (const float*)d_in[6]; const float* conv_b_b = (const float*)d_in[7];
    const float* ln_b_g = (const float*)d_in[8]; const float* ln_b_b = (const float*)d_in[9]; const float* w_out_b = (const float*)d_in[10];
    const float* w_o = (const float*)d_in[12]; const float* ffn_g = (const float*)d_in[13]; const float* w_rg = (const float*)d_in[14]; const float* b_rg = (const float*)d_in[15];
    const float* w_re = (const float*)d_in[16]; const float* b_re = (const float*)d_in[17]; const float* w_eg = (const float*)d_in[18]; const float* w_eu = (const float*)d_in[19];
    const float* w_ed = (const float*)d_in[20]; const float* ple_g = (const float*)d_in[21]; const float* w_pg = (const float*)d_in[22]; const float* w_pp = (const float*)d_in[23];
    const float* fin_g = (const float*)d_in[24];
    unsigned char* ws = (unsigned char*)d_ws; float* out = (float*)d_out;
    unsigned* ctl = (unsigned*)(ws + WS_CTL);
    int* tok_e = (int*)(ws + WS_TOK); float* tok_w = (float*)(ws + WS_TOK + 256 * 1024); int* tok_pos = (int*)(ws + WS_TOK + 512 * 1024);
    float* r1 = (float*)(ws + WS_TOK + 768 * 1024); float* r2 = (float*)(ws + WS_TOK + 896 * 1024);
    float* ssp1 = (float*)(ws + WS_SSP1); int* ltok = (int*)(ws + WS_LTOK); float* lw = (float*)(ws + WS_LW);
    bf16* UA = (bf16*)(ws + WS_RA); bf16* UB = (bf16*)(ws + WS_RB); bf16* AB = (bf16*)(ws + WS_RC); bf16* GA = (bf16*)(ws + WS_RD); bf16* GB = (bf16*)(ws + WS_RE);
    bf16* ZZ = (bf16*)d_out; bf16* MIX = (bf16*)(ws + WS_RC); float* X1 = (float*)(ws + WS_RA); bf16* APLE = (bf16*)d_out;
    bf16* HMID = (bf16*)(ws + WS_RC); bf16* YB = (bf16*)(ws + WS_RD); float* X3 = (float*)(ws + WS_RC);

    if (hipMemsetAsync(ws + WS_CTL, 0, 1 * MiB, stream) != hipSuccess) { fprintf(stderr, "kernel_launch: memset failed\n"); return; }
    Args a{};
    for (int i = 0; i < 25; ++i) a.in[i] = (const float*)d_in[i];
    a.out = out; a.ws = ws; a.ph_lo = 0; a.ph_hi = OPT_UPTO;
    void* kargs[] = {&a};
    const hipError_t le = hipLaunchCooperativeKernel((const void*)mega, dim3(grid), dim3(NWAVES * 64), kargs, LDS_BYTES, stream);
    if (le != hipSuccess) { fprintf(stderr, "kernel_launch: cooperative launch failed: %s (grid %d)\n", hipGetErrorString(le), grid); return; }
    if (OPT_UPTO <= 1) nv_inproj<<<dim3(T / 8, 4), 256, 0, stream>>>((const bf16*)d_out, (const float*)d_in[3], (const float*)d_in[11], UA, UB, AB, GA, GB);
    if (OPT_UPTO <= 2) nv_conv<<<T, 256, 0, stream>>>(UA, UB, AB, conv_a_w, conv_b_w, conv_b_b, ln_b_g, ln_b_b, ZZ);
    if (OPT_UPTO <= 3) nv_outab<<<dim3(T / 8, 4), 256, 0, stream>>>(ZZ, w_out_a, w_out_b, GA, GB, MIX);
    if (OPT_UPTO <= 4) { nv_wo<<<dim3(T / 8, 4), 256, 0, stream>>>(MIX, w_o, x, X1, APLE); nv_rowss<<<T / 4, 256, 0, stream>>>(X1, ssp1); }
    if (OPT_UPTO <= 5) { nv_router<<<T / 4, 256, 0, stream>>>(X1, ssp1, ffn_g, w_rg, b_rg, w_re, b_re, ctl + CW_CNT, tok_e, tok_w, tok_pos, r1, ltok, lw); nv_pcvt<<<T * PLE / 4 / 256, 256, 0, stream>>>(p, APLE); }
    if (OPT_UPTO <= 6) nv_moe_up<<<dim3(T / 8, NE), 256, 0, stream>>>(X1, r1, ffn_g, w_eg, w_eu, ctl + CW_CNT, ltok, HMID);
    if (OPT_UPTO <= 7) nv_moe_down<<<dim3(T / 8, NE), 256, 0, stream>>>(HMID, w_ed, ctl + CW_CNT, lw, YB);
    if (OPT_UPTO <= 8) nv_combine<<<T / 4, 256, 0, stream>>>(X1, YB, ctl + CW_CNT, tok_e, tok_pos, APLE, r2);
    if (OPT_UPTO <= 9) nv_ple<<<dim3(T / 8, 4), 256, 0, stream>>>(X1, r2, ple_g, w_pg, p, w_pp, X3);
    if (OPT_UPTO <= 10) nv_final<<<T / 4, 256, 0, stream>>>(X3, fin_g, out);
}
```

```cpp
#include <hip/hip_runtime.h>
#include <cstdio>
#include <cstdint>

typedef unsigned short bf16;
constexpr int T = 32768, D = 1024, SEQ = 2048, PLE = 256, NE = 32, NG = 4, EPG = 8, DE = 512, INC = 7168;
constexpr float EPS = 1e-6f;
constexpr size_t MiB = 1u << 20;
constexpr size_t WS_CTL = 0;
constexpr size_t WS_TOK = 1 * MiB;
constexpr size_t WS_SSP1 = 2 * MiB;
constexpr size_t WS_SSP3 = 4 * MiB;
constexpr size_t WS_LTOK = 6 * MiB;
constexpr size_t WS_LW = 136 * MiB;
constexpr size_t WS_RA = 144 * MiB, WS_RB = 208 * MiB, WS_RC = 272 * MiB, WS_RD = 336 * MiB, WS_RE = 400 * MiB;
constexpr size_t WS_END = 464 * MiB;
constexpr int APITCH = 1280;
constexpr int CW_CNT = 64;

__device__ __forceinline__ unsigned f2bf(float f) { unsigned u = __builtin_bit_cast(unsigned, f); return (u + 0x7fffu + ((u >> 16) & 1u)) >> 16; }
__device__ __forceinline__ float bf2f(unsigned short b) { return __builtin_bit_cast(float, (unsigned)b << 16); }
__device__ __forceinline__ float sigmoidf_(float v) { return 1.f / (1.f + __expf(-v)); }
__device__ __forceinline__ float siluf_(float v) { return v / (1.f + __expf(-v)); }
__device__ __forceinline__ float wave_sum(float v) {
#pragma unroll
    for (int o = 1; o < 64; o <<= 1) v += __shfl_xor(v, o);
    return v;
}

#define REP_MASK 0
#define OPT_UPTO 11
namespace pg8 {
#define PG8_LAS __attribute__((address_space(3)))
typedef unsigned short bf16_t;
typedef short bf16x8 __attribute__((ext_vector_type(8)));
typedef float f32x4 __attribute__((ext_vector_type(4)));
typedef unsigned u32x4 __attribute__((ext_vector_type(4)));
typedef unsigned u32x2 __attribute__((ext_vector_type(2)));
constexpr int BM = 256, BK = 64, HALF = 128, HTB = HALF * BK * 2, STAGE_BYTES = 8 * HTB, NXCD = 8, WGM = 8;
__host__ __device__ __forceinline__ int lds_byte(int r, int c) { const int st = (r >> 4) * 2 + (c >> 5), rr = r & 15, cc = c & 31, ob = rr * 64 + cc * 2; return st * 1024 + (ob ^ (((ob >> 9) & 1) << 5)); }
__host__ __device__ __forceinline__ void stage_rc(int b, int& R, int& C) { const int st = b / 1024, sb = b % 1024, swz = sb ^ (((sb >> 9) & 1) << 5); R = (st >> 1) * 16 + swz / 64; C = (st & 1) * 32 + (swz % 64) / 2; }
__host__ __device__ __forceinline__ int perm32(int rho) { const int n = rho >> 4, i = rho & 15; return 8 * (i >> 2) + 4 * n + (i & 3); }

struct Unit { int pm, pn, e, nrow, slot0; };
struct Gemm { int lda, ldb, K; };

__device__ __forceinline__ unsigned cvt_pk_bf16(float lo, float hi) { unsigned r; asm volatile("v_cvt_pk_bf16_f32 %0, %1, %2" : "=v"(r) : "v"(lo), "v"(hi)); return r; }
__device__ __forceinline__ float fsig(float v) { return __builtin_amdgcn_rcpf(1.f + __expf(-v)); }
__device__ __forceinline__ f32x4 sig4(f32x4 v) { return (f32x4){fsig(v[0]), fsig(v[1]), fsig(v[2]), fsig(v[3])}; }
__device__ __forceinline__ f32x4 bfx4(u32x2 w) { return (f32x4){__builtin_bit_cast(float, w.x << 16), __builtin_bit_cast(float, w.x & 0xffff0000u), __builtin_bit_cast(float, w.y << 16), __builtin_bit_cast(float, w.y & 0xffff0000u)}; }

struct StaticOrder {
    static constexpr bool GATHER = false;
    int nM, nN, nwg, G, c; const char* A; const char* Bt; size_t atile, btile;
    __device__ __forceinline__ void init(int M, int N, int G_, int c_, const void* A_, int lda, const void* Bt_, int ldb) { nM = M / BM; nN = N / BM; nwg = nM * nN; G = G_; c = c_; A = (const char*)A_; Bt = (const char*)Bt_; atile = (size_t)BM * lda * 2; btile = (size_t)BM * ldb * 2; }
    __device__ __forceinline__ bool next(int i, Unit& u) const {
        const long L = (long)i * G + c; if (L >= nwg) return false;
        int wgid = (int)L; { const int q = nwg / NXCD, r = nwg % NXCD, xcd = wgid % NXCD, off = wgid / NXCD; wgid = (xcd < r ? xcd * (q + 1) : r * (q + 1) + (xcd - r) * q) + off; }
        const int nig = WGM * nN, gid = wgid / nig, fm = gid * WGM, gsz = (nM - fm) < WGM ? (nM - fm) : WGM;
        u.pm = fm + ((wgid % nig) % gsz); u.pn = (wgid % nig) / gsz; u.e = 0; u.nrow = 256; u.slot0 = 0; return true;
    }
    __device__ __forceinline__ void ptrs(const Unit& u, const char*& cA, const char*& cB) const { cA = A + (size_t)u.pm * atile; cB = Bt + (size_t)u.pn * btile; }
    __device__ __forceinline__ void rows(const Unit&, const int (&)[2], const int (&)[2], unsigned (&)[2][2]) const {}
};

template <class Epi, class Sched, bool ALIGN_EPI>
__device__ __forceinline__ void gemm_phase(PG8_LAS unsigned char* lds, const Gemm g, const Sched& S, const Epi& E) {
    const int tid = threadIdx.x, wid = __builtin_amdgcn_readfirstlane(tid >> 6), lane = tid & 63, wr = wid >> 2, wc = wid & 3, fr = lane & 15, fq = lane >> 4;
    const int K = g.K, nt = K / BK;
    int Rr[2], Cc[2]; unsigned vA[2][2], vN[2][2], voffB[2];
#pragma unroll
    for (int i = 0; i < 2; ++i) { int R, C; stage_rc(tid * 16 + i * 8192, R, C); Rr[i] = R; Cc[i] = C; const int Rb = Epi::PERM ? ((R & ~31) + perm32(R & 31)) : R;
        voffB[i] = (unsigned)(Rb * g.ldb + C) * 2u; vA[0][i] = (unsigned)(R * g.lda + C) * 2u; vA[1][i] = (unsigned)((R + HALF) * g.lda + C) * 2u; vN[0][i] = vA[0][i]; vN[1][i] = vA[1][i]; }
    const size_t kstep = (size_t)(BK * 2);
    const size_t hstepB = (size_t)HALF * g.ldb * 2;
    const unsigned ldsw = (unsigned)wid * 1024u;
    const int aoff = lds_byte(wr * 64 + fr, fq * 8), boff = lds_byte(wc * 32 + fr, fq * 8);
#define PG8_SA(b, h) (((b) * 2 + (h)) * HTB)
#define PG8_SB(b, h) ((4 + (b) * 2 + (h)) * HTB)
#define PG8_STAGE(bufoff, gbase, voff) do { _Pragma("unroll") for (int _i = 0; _i < 2; ++_i) \
        __builtin_amdgcn_global_load_lds((const unsigned*)((const char*)(gbase) + (voff)[_i]), (PG8_LAS unsigned*)(lds + (bufoff) + ldsw + _i * 8192), 16, 0, 0); } while (0)
#define PG8_LDA(dst, b, h) do { _Pragma("unroll") for (int m = 0; m < 4; ++m) _Pragma("unroll") for (int k = 0; k < 2; ++k) dst[m][k] = *(const PG8_LAS bf16x8*)(lds + PG8_SA(b, h) + aoff + m * 2048 + k * 1024); } while (0)
#define PG8_LDB(dst, b, h) do { _Pragma("unroll") for (int n = 0; n < 2; ++n) _Pragma("unroll") for (int k = 0; k < 2; ++k) dst[n][k] = *(const PG8_LAS bf16x8*)(lds + PG8_SB(b, h) + boff + n * 2048 + k * 1024); } while (0)
#define PG8_MMA(ai, bj, At, Bt) do { __builtin_amdgcn_s_setprio(1); _Pragma("unroll") for (int m = 0; m < 4; ++m) _Pragma("unroll") for (int n = 0; n < 2; ++n) _Pragma("unroll") for (int k = 0; k < 2; ++k) \
        acc[ai][bj][m][n] = __builtin_amdgcn_mfma_f32_16x16x32_bf16(Bt[n][k], At[m][k], acc[ai][bj][m][n], 0, 0, 0); __builtin_amdgcn_s_setprio(0); } while (0)
#define PG8_WAIT_V(n) asm volatile("s_waitcnt vmcnt(" #n ")" ::: "memory")
#define PG8_WAIT_L(n) asm volatile("s_waitcnt lgkmcnt(" #n ")" ::: "memory")
#define PG8_BAR __builtin_amdgcn_s_barrier()
#define PG8_SCHED __builtin_amdgcn_sched_barrier(0)
    Unit cur, nxt; int ui = 0;
    if (!S.next(0, cur)) return;
    f32x4 acc[2][2][4][2];
#pragma unroll
    for (int a = 0; a < 2; ++a)
#pragma unroll
        for (int b = 0; b < 2; ++b)
#pragma unroll
            for (int m = 0; m < 4; ++m)
#pragma unroll
                for (int n = 0; n < 2; ++n) acc[a][b][m][n] = (f32x4){0.f, 0.f, 0.f, 0.f};
    bf16x8 At[4][2], B0[2][2], B1[2][2];
    const char* cA; const char* cB; S.ptrs(cur, cA, cB);
    if constexpr (Sched::GATHER) S.rows(cur, Rr, Cc, vA);
    PG8_STAGE(PG8_SB(0, 0), cB, voffB); PG8_STAGE(PG8_SB(0, 1), cB + hstepB, voffB); PG8_STAGE(PG8_SA(0, 0), cA, vA[0]); PG8_STAGE(PG8_SA(0, 1), cA, vA[1]);
    if (wr == 1) PG8_BAR;
    PG8_WAIT_V(2); PG8_BAR;
    PG8_STAGE(PG8_SB(1, 0), cB + kstep, voffB); PG8_STAGE(PG8_SA(1, 0), cA + kstep, vA[0]); PG8_STAGE(PG8_SB(1, 1), cB + hstepB + kstep, voffB);
    PG8_WAIT_V(6); PG8_BAR;
    for (;;) {
        const bool has_next = S.next(ui + 1, nxt);
        const char* nA = cA; const char* nB = cB;
        if (has_next) { S.ptrs(nxt, nA, nB); if constexpr (Sched::GATHER) S.rows(nxt, Rr, Cc, vN); }
        else { if constexpr (Sched::GATHER) {
#pragma unroll
            for (int h = 0; h < 2; ++h)
#pragma unroll
                for (int i = 0; i < 2; ++i) vN[h][i] = vA[h][i]; } }
        for (int t = 0; t < nt; t += 2) {
            const bool last = (t == nt - 2);
            if constexpr (Epi::MID_T > 0) { if (t == Epi::MID_T) E.mid(acc, cur, wr, wc, fr, fq); }
            const char* a1 = cA + (size_t)(t + 1) * kstep;
            const char* a2 = last ? nA : cA + (size_t)(t + 2) * kstep; const char* b2 = last ? nB : cB + (size_t)(t + 2) * kstep;
            const char* a3 = a2 + kstep; const char* b3 = b2 + kstep;
            PG8_LDB(B0, 0, 0); PG8_LDB(B1, 0, 1); PG8_SCHED; PG8_LDA(At, 0, 0); PG8_STAGE(PG8_SA(1, 1), a1, vA[1]);
            PG8_WAIT_V(8); PG8_WAIT_L(0); PG8_BAR; PG8_MMA(0, 0, At, B0); PG8_MMA(0, 1, At, B1); PG8_BAR; PG8_SCHED;
            if constexpr (Sched::GATHER) { if (last) {
#pragma unroll
                for (int h = 0; h < 2; ++h)
#pragma unroll
                    for (int i = 0; i < 2; ++i) vA[h][i] = vN[h][i]; } }
            PG8_LDA(At, 0, 1); PG8_STAGE(PG8_SB(0, 0), b2, voffB); PG8_STAGE(PG8_SB(0, 1), b2 + hstepB, voffB); PG8_STAGE(PG8_SA(0, 0), a2, vA[0]);
            PG8_WAIT_V(8); PG8_WAIT_L(0); PG8_BAR; PG8_MMA(1, 0, At, B0); PG8_MMA(1, 1, At, B1); PG8_BAR; PG8_SCHED;
            PG8_LDB(B0, 1, 0); PG8_LDB(B1, 1, 1); PG8_SCHED; PG8_LDA(At, 1, 0); PG8_STAGE(PG8_SA(0, 1), a2, vA[1]);
            PG8_WAIT_V(8); PG8_WAIT_L(0); PG8_BAR; PG8_MMA(0, 0, At, B0); PG8_MMA(0, 1, At, B1); PG8_BAR; PG8_SCHED;
            PG8_LDA(At, 1, 1); PG8_STAGE(PG8_SB(1, 0), b3, voffB); PG8_STAGE(PG8_SB(1, 1), b3 + hstepB, voffB); PG8_STAGE(PG8_SA(1, 0), a3, vA[0]);
            PG8_WAIT_V(8); PG8_WAIT_L(0); PG8_BAR; PG8_MMA(1, 0, At, B0); PG8_MMA(1, 1, At, B1); PG8_BAR; PG8_SCHED;
        }
        if constexpr (ALIGN_EPI) { if (wr == 0) PG8_BAR; }
        if constexpr (!Epi::AFTER_DRAIN) { E(acc, cur, wr, wc, fr, fq); }
        if (!has_next) break;
#pragma unroll
        for (int a = 0; a < 2; ++a)
#pragma unroll
            for (int b = 0; b < 2; ++b)
#pragma unroll
                for (int m = 0; m < 4; ++m)
#pragma unroll
                    for (int n = 0; n < 2; ++n) acc[a][b][m][n] = (f32x4){0.f, 0.f, 0.f, 0.f};
        cur = nxt; cA = nA; cB = nB; ++ui;
        if constexpr (ALIGN_EPI) { if (wr == 1) PG8_BAR; }
    }
    PG8_WAIT_V(0);
    if constexpr (!ALIGN_EPI) { if (wr == 0) PG8_BAR; }
    PG8_BAR;
    if constexpr (Epi::AFTER_DRAIN) { E.fused(acc, cur, wr, wc, fr, fq, lds, wid, lane); }
#undef PG8_SA
#undef PG8_SB
#undef PG8_STAGE
#undef PG8_LDA
#undef PG8_LDB
#undef PG8_MMA
#undef PG8_WAIT_V
#undef PG8_WAIT_L
#undef PG8_BAR
#undef PG8_SCHED
}

struct EpiInProj {
    static constexpr bool PERM = true, AFTER_DRAIN = false; static constexpr int MID_T = 0;
    bf16_t* R0; size_t rs; const float* b_gate;
    __device__ __forceinline__ void operator()(const f32x4 (&acc)[2][2][4][2], const Unit& u, int wr, int wc, int fr, int fq) const {
        const int row0 = u.pm * BM + wr * 64 + fr, cc = wc * 32 + 8 * fq;
        if (u.pn < 16) {
            const bool sg = u.pn >= 8; bf16_t* O = R0 + (size_t)(sg ? 1 : 0) * rs + (u.pn & 7) * 128 + cc;
#pragma unroll
            for (int ai = 0; ai < 2; ++ai)
#pragma unroll
                for (int m = 0; m < 4; ++m) {
                    f32x4 b0 = acc[ai][1][m][0], b1 = acc[ai][1][m][1];
                    if (sg) { b0 = sig4(b0); b1 = sig4(b1); }
                    const f32x4 v0 = acc[ai][0][m][0] * b0, v1 = acc[ai][0][m][1] * b1;
                    u32x4 w; w.x = cvt_pk_bf16(v0[0], v0[1]); w.y = cvt_pk_bf16(v0[2], v0[3]); w.z = cvt_pk_bf16(v1[0], v1[1]); w.w = cvt_pk_bf16(v1[2], v1[3]);
                    *(u32x4*)(O + (size_t)(row0 + ai * HALF + m * 16) * 1024) = w; }
        } else {
            const int sec = (u.pn - 16) >> 2, ct = ((u.pn - 16) & 3) * 256 + cc;
            bf16_t* O = R0 + (size_t)(2 + sec) * rs + ct;
            f32x4 bv[2][2];
#pragma unroll
            for (int bj = 0; bj < 2; ++bj)
#pragma unroll
                for (int n = 0; n < 2; ++n) bv[bj][n] = sec ? *(const f32x4*)(b_gate + (sec - 1) * 1024 + ct + bj * HALF + 4 * n) : (f32x4){0.f, 0.f, 0.f, 0.f};
#pragma unroll
            for (int ai = 0; ai < 2; ++ai)
#pragma unroll
                for (int m = 0; m < 4; ++m)
#pragma unroll
                    for (int bj = 0; bj < 2; ++bj) {
                        f32x4 v0 = acc[ai][bj][m][0] + bv[bj][0], v1 = acc[ai][bj][m][1] + bv[bj][1];
                        if (sec) { v0 = sig4(v0); v1 = sig4(v1); }
                        u32x4 w; w.x = cvt_pk_bf16(v0[0], v0[1]); w.y = cvt_pk_bf16(v0[2], v0[3]); w.z = cvt_pk_bf16(v1[0], v1[1]); w.w = cvt_pk_bf16(v1[2], v1[3]);
                        *(u32x4*)(O + (size_t)(row0 + ai * HALF + m * 16) * 1024 + bj * HALF) = w; }
        }
    }
};

struct EpiMix {
    static constexpr bool PERM = true, AFTER_DRAIN = false; static constexpr int MID_T = 16;
    const bf16_t *GA, *GB; bf16_t* MIX;
    __device__ __forceinline__ void mid(f32x4 (&acc)[2][2][4][2], const Unit& u, int wr, int wc, int fr, int fq) const {
        int row0 = u.pm * BM + wr * 64 + fr, col0 = u.pn * BM + wc * 32 + 8 * fq;
        asm volatile("" : "+v"(row0), "+v"(col0));
#pragma unroll
        for (int ai = 0; ai < 2; ++ai)
#pragma unroll
            for (int m = 0; m < 4; ++m)
#pragma unroll
                for (int bj = 0; bj < 2; ++bj) { const size_t o = (size_t)(row0 + ai * HALF + m * 16) * 1024 + col0 + bj * HALF;
                    const u32x4 ga = *(const u32x4*)(GA + o), gb = *(const u32x4*)(GB + o);
                    const f32x4 a0 = bfx4((u32x2){ga.x, ga.y}), a1 = bfx4((u32x2){ga.z, ga.w}), b0 = bfx4((u32x2){gb.x, gb.y}), b1 = bfx4((u32x2){gb.z, gb.w});
#pragma unroll
                    for (int j = 0; j < 4; ++j) { acc[ai][bj][m][0][j] *= a0[j] * __builtin_amdgcn_rcpf(b0[j]); acc[ai][bj][m][1][j] *= a1[j] * __builtin_amdgcn_rcpf(b1[j]); }
                    asm volatile("" : "+v"(acc[ai][bj][m][0]), "+v"(acc[ai][bj][m][1]) :: "memory"); }
    }
    __device__ __forceinline__ void operator()(const f32x4 (&acc)[2][2][4][2], const Unit& u, int wr, int wc, int fr, int fq) const {
        const int row0 = u.pm * BM + wr * 64 + fr, col0 = u.pn * BM + wc * 32 + 8 * fq;
#pragma unroll
        for (int ai = 0; ai < 2; ++ai)
#pragma unroll
            for (int m = 0; m < 4; ++m)
#pragma unroll
                for (int bj = 0; bj < 2; ++bj) { const size_t o = (size_t)(row0 + ai * HALF + m * 16) * 1024 + col0 + bj * HALF;
                    const u32x4 gb = *(const u32x4*)(GB + o);
                    const f32x4 v0 = acc[ai][bj][m][0] * bfx4((u32x2){gb.x, gb.y}), v1 = acc[ai][bj][m][1] * bfx4((u32x2){gb.z, gb.w});
                    u32x4 w; w.x = cvt_pk_bf16(v0[0], v0[1]); w.y = cvt_pk_bf16(v0[2], v0[3]); w.z = cvt_pk_bf16(v1[0], v1[1]); w.w = cvt_pk_bf16(v1[2], v1[3]);
                    *(u32x4*)(MIX + o) = w; asm volatile("" ::: "memory"); }
    }
};
struct EpiWo {
    static constexpr bool PERM = false, AFTER_DRAIN = false; static constexpr int MID_T = 0;
    const float* x; float* X1; bf16_t* APLE; float* ssp;
    __device__ __forceinline__ void operator()(const f32x4 (&acc)[2][2][4][2], const Unit& u, int wr, int wc, int fr, int fq) const {
        const int row0 = u.pm * BM + wr * 64 + fr, col0 = u.pn * BM + wc * 32 + 4 * fq;
#pragma unroll
        for (int ai = 0; ai < 2; ++ai)
#pragma unroll
            for (int m = 0; m < 4; ++m) { const int row = row0 + ai * HALF + m * 16; float ss = 0.f;
#pragma unroll
                for (int bj = 0; bj < 2; ++bj)
#pragma unroll
                    for (int n = 0; n < 2; ++n) { const size_t o = (size_t)row * 1024 + col0 + bj * HALF + n * 16;
                        const f32x4 v = *(const f32x4*)(x + o) + acc[ai][bj][m][n];
                        *(f32x4*)(X1 + o) = v; ss += (v[0] * v[0] + v[1] * v[1]) + (v[2] * v[2] + v[3] * v[3]);
                        u32x2 w; w.x = cvt_pk_bf16(v[0], v[1]); w.y = cvt_pk_bf16(v[2], v[3]);
                        *(u32x2*)(APLE + (size_t)row * 1280 + 256 + col0 + bj * HALF + n * 16) = w; }
                ss += __shfl_xor(ss, 16); ss += __shfl_xor(ss, 32);
                if (fq == 0) ssp[(size_t)row * 16 + u.pn * 4 + wc] = ss; }
    }
};
struct EpiRouter {
    static constexpr bool PERM = false, AFTER_DRAIN = true; static constexpr int MID_T = 0;
    const float* ssp1; const float* brg; const float* bre; unsigned* cnt; int* tok_e; float* tok_w; int* tok_pos; float* r1; int* ltok; float* lw; float* lr;
    __device__ __forceinline__ void fused(f32x4 (&acc)[2][2][4][2], const Unit& u, int wr, int wc, int fr, int fq, PG8_LAS unsigned char* lds, int wid, int lane) const {
        PG8_LAS float* L = (PG8_LAS float*)lds;
        PG8_LAS int* hist = (PG8_LAS int*)(lds + 40960);
        const int tid = wid * 64 + lane;
        if (tid < 64) hist[tid] = 0;
        if (wc == 0) {
#pragma unroll
            for (int ai = 0; ai < 2; ++ai)
#pragma unroll
                for (int m = 0; m < 4; ++m)
#pragma unroll
                    for (int n = 0; n < 2; ++n) *(PG8_LAS f32x4*)(L + (ai * HALF + wr * 64 + m * 16 + fr) * 40 + 16 * n + 4 * fq) = acc[ai][0][m][n];
        } else if (wc == 1 && fq == 0) {
#pragma unroll
            for (int ai = 0; ai < 2; ++ai)
#pragma unroll
                for (int m = 0; m < 4; ++m) *(PG8_LAS f32x4*)(L + (ai * HALF + wr * 64 + m * 16 + fr) * 40 + 32) = acc[ai][0][m][0];
        }
        asm volatile("s_waitcnt lgkmcnt(0)" ::: "memory"); __builtin_amdgcn_s_barrier(); asm volatile("" ::: "memory");
        int ea = 0, eb = 0, la = 0, lb = 0; float wa_ = 0.f, wb_ = 0.f, r = 0.f; const int t = u.pm * BM + tid;
        if (tid < 256) {
            float ss = 0.f;
#pragma unroll
            for (int i = 0; i < 16; i += 4) { const f32x4 pv = *(const f32x4*)(ssp1 + (size_t)t * 16 + i); ss += (pv[0] + pv[1]) + (pv[2] + pv[3]); }
            r = rsqrtf(ss * (1.f / 1024.f) + 1e-6f);
            float lg[40];
#pragma unroll
            for (int i = 0; i < 36; i += 4) { const f32x4 v = *(const PG8_LAS f32x4*)(L + tid * 40 + i); lg[i] = v[0]; lg[i + 1] = v[1]; lg[i + 2] = v[2]; lg[i + 3] = v[3]; }
            float gl[4]; int grp = 0;
#pragma unroll
            for (int i = 0; i < 4; ++i) gl[i] = lg[i] * r + brg[i];
            float gm = gl[0];
#pragma unroll
            for (int i = 1; i < 4; ++i) if (gl[i] > gm) { gm = gl[i]; grp = i; }
            float den = 0.f;
#pragma unroll
            for (int i = 0; i < 4; ++i) den += __expf(gl[i] - gm);
            const float pg = 1.f / den;
            float el[8];
#pragma unroll
            for (int i = 0; i < 8; ++i) { float v = 0.f;
#pragma unroll
                for (int g2 = 0; g2 < 4; ++g2) v = (grp == g2) ? lg[4 + g2 * 8 + i] * r + bre[g2 * 8 + i] : v;
                el[i] = v; }
            int i0 = 0; float v0 = el[0];
#pragma unroll
            for (int i = 1; i < 8; ++i) if (el[i] > v0) { v0 = el[i]; i0 = i; }
            int i1 = -1; float v1 = -3.0e38f;
#pragma unroll
            for (int i = 0; i < 8; ++i) if (i != i0 && el[i] > v1) { v1 = el[i]; i1 = i; }
            const float e1 = __expf(v1 - v0); const float s0 = 1.f / (1.f + e1), s1 = e1 / (1.f + e1);
            ea = grp * 8 + i0; eb = grp * 8 + i1; wa_ = s0 * pg; wb_ = s1 * pg;
            la = __hip_atomic_fetch_add(&hist[ea], 1, __ATOMIC_RELAXED, __HIP_MEMORY_SCOPE_WORKGROUP); lb = __hip_atomic_fetch_add(&hist[eb], 1, __ATOMIC_RELAXED, __HIP_MEMORY_SCOPE_WORKGROUP);
        }
        asm volatile("s_waitcnt lgkmcnt(0)" ::: "memory"); __builtin_amdgcn_s_barrier(); asm volatile("" ::: "memory");
        if (tid < 32) { const int h = hist[tid]; hist[32 + tid] = h ? (int)atomicAdd(cnt + tid, (unsigned)h) : 0; }
        asm volatile("s_waitcnt vmcnt(0) lgkmcnt(0)" ::: "memory"); __builtin_amdgcn_s_barrier(); asm volatile("" ::: "memory");
        if (tid < 256) {
            const int pa = hist[32 + ea] + la, pb = hist[32 + eb] + lb;
            tok_e[t * 2] = ea; tok_e[t * 2 + 1] = eb; tok_w[t * 2] = wa_; tok_w[t * 2 + 1] = wb_; tok_pos[t * 2] = pa; tok_pos[t * 2 + 1] = pb; r1[t] = r;
            ltok[(size_t)ea * 32768 + pa] = t; lw[(size_t)ea * 32768 + pa] = wa_; lr[(size_t)ea * 32768 + pa] = r;
            ltok[(size_t)eb * 32768 + pb] = t; lw[(size_t)eb * 32768 + pb] = wb_; lr[(size_t)eb * 32768 + pb] = r;
        }
    }
};
template <bool GATHER_> struct MoeOrder {
    static constexpr bool GATHER = GATHER_;
    const PG8_LAS int* tab; int nwg, G, c; const char* A; const char* Bt; size_t bexp, btile; int lda; const int* ltok;
    __device__ __forceinline__ bool next(int i, Unit& u) const {
        const long L = (long)i * G + c; if (L >= nwg) return false;
        int wgid = (int)L; { const int q = nwg / NXCD, r = nwg % NXCD, xcd = wgid % NXCD, off = wgid / NXCD; wgid = (xcd < r ? xcd * (q + 1) : r * (q + 1) + (xcd - r) * q) + off; }
        int e = 0;
        for (int k = 1; k < 32; ++k) e += (__builtin_amdgcn_readfirstlane(tab[k]) <= wgid) ? 1 : 0;
        const int rem = wgid - __builtin_amdgcn_readfirstlane(tab[e]);
        u.pn = rem & 3; u.pm = rem >> 2; u.e = e; u.nrow = __builtin_amdgcn_readfirstlane(tab[80 + e]) - 256 * u.pm; u.slot0 = __builtin_amdgcn_readfirstlane(tab[40 + e]) + 256 * u.pm; return true;
    }
    __device__ __forceinline__ void ptrs(const Unit& u, const char*& cA, const char*& cB) const {
        cA = GATHER ? A : A + (size_t)u.slot0 * lda * 2; cB = Bt + (size_t)u.e * bexp + (size_t)u.pn * btile; }
    __device__ __forceinline__ void rows(const Unit& u, const int (&Rr)[2], const int (&Cc)[2], unsigned (&off)[2][2]) const {
#pragma unroll
        for (int h = 0; h < 2; ++h)
#pragma unroll
            for (int i = 0; i < 2; ++i) { const int r = h * HALF + Rr[i]; const int tok = (r < u.nrow) ? ltok[(size_t)u.e * 32768 + 256 * u.pm + r] : 0; off[h][i] = (unsigned)(tok * lda + Cc[i]) * 2u; }
    }
};
struct EpiMoeUp {
    static constexpr bool PERM = true, AFTER_DRAIN = false; static constexpr int MID_T = 0;
    const float* lr; bf16_t* HMID;
    __device__ __forceinline__ void operator()(const f32x4 (&acc)[2][2][4][2], const Unit& u, int wr, int wc, int fr, int fq) const {
        const int cc = u.pn * 128 + wc * 32 + 8 * fq;
#pragma unroll
        for (int ai = 0; ai < 2; ++ai)
#pragma unroll
            for (int m = 0; m < 4; ++m) { const int row = ai * HALF + wr * 64 + m * 16 + fr;
                if (row < u.nrow) { const float r = lr[(size_t)u.e * 32768 + 256 * u.pm + row];
                    f32x4 v[2];
#pragma unroll
                    for (int n = 0; n < 2; ++n)
#pragma unroll
                        for (int j = 0; j < 4; ++j) { const float g = acc[ai][0][m][n][j] * r, up = acc[ai][1][m][n][j] * r; v[n][j] = g * fsig(g) * up; }
                    u32x4 w; w.x = cvt_pk_bf16(v[0][0], v[0][1]); w.y = cvt_pk_bf16(v[0][2], v[0][3]); w.z = cvt_pk_bf16(v[1][0], v[1][1]); w.w = cvt_pk_bf16(v[1][2], v[1][3]);
                    *(u32x4*)(HMID + (size_t)(u.slot0 + row) * 512 + cc) = w; } }
    }
};
struct EpiMoeDown {
    static constexpr bool PERM = true, AFTER_DRAIN = false; static constexpr int MID_T = 0;
    const float* lw; bf16_t* YB;
    __device__ __forceinline__ void operator()(const f32x4 (&acc)[2][2][4][2], const Unit& u, int wr, int wc, int fr, int fq) const {
        const int cc = u.pn * 256 + wc * 32 + 8 * fq;
#pragma unroll
        for (int ai = 0; ai < 2; ++ai)
#pragma unroll
            for (int m = 0; m < 4; ++m) { const int row = ai * HALF + wr * 64 + m * 16 + fr;
                if (row < u.nrow) { const float gw = lw[(size_t)u.e * 32768 + 256 * u.pm + row];
#pragma unroll
                    for (int bj = 0; bj < 2; ++bj) { const f32x4 v0 = acc[ai][bj][m][0] * gw, v1 = acc[ai][bj][m][1] * gw;
                        u32x4 w; w.x = cvt_pk_bf16(v0[0], v0[1]); w.y = cvt_pk_bf16(v0[2], v0[3]); w.z = cvt_pk_bf16(v1[0], v1[1]); w.w = cvt_pk_bf16(v1[2], v1[3]);
                        *(u32x4*)(YB + (size_t)(u.slot0 + row) * 1024 + cc + bj * HALF) = w; } } }
    }
};
struct EpiPle {
    static constexpr bool PERM = false, AFTER_DRAIN = false; static constexpr int MID_T = 4;
    const float* X2; const float* r2; float* X3; float* ssp; u32x2* scr;
    __device__ __forceinline__ void mid(f32x4 (&acc)[2][2][4][2], const Unit&, int, int, int, int) const {
        int tid = threadIdx.x;
        asm volatile("" : "+v"(tid));
#pragma unroll
        for (int ai = 0; ai < 2; ++ai)
#pragma unroll
            for (int bj = 0; bj < 2; ++bj)
#pragma unroll
                for (int m = 0; m < 4; ++m)
#pragma unroll
                    for (int n = 0; n < 2; ++n) { const f32x4 v = acc[ai][bj][m][n]; u32x2 w; w.x = cvt_pk_bf16(v[0], v[1]); w.y = cvt_pk_bf16(v[2], v[3]);
                        scr[(((ai * 2 + bj) * 4 + m) * 2 + n) * 512 + tid] = w; acc[ai][bj][m][n] = (f32x4){0.f, 0.f, 0.f, 0.f}; asm volatile("" ::: "memory"); }
    }
    __device__ __forceinline__ void operator()(const f32x4 (&acc)[2][2][4][2], const Unit& u, int wr, int wc, int fr, int fq) const {
        int tid = threadIdx.x; int row0 = u.pm * BM + wr * 64 + fr, col0 = u.pn * BM + wc * 32 + 4 * fq;
        asm volatile("" : "+v"(tid), "+v"(row0), "+v"(col0));
#pragma unroll
        for (int ai = 0; ai < 2; ++ai)
#pragma unroll
            for (int m = 0; m < 4; ++m) { const int row = row0 + ai * HALF + m * 16; const float rr = r2[row]; float ss = 0.f;
#pragma unroll
                for (int bj = 0; bj < 2; ++bj)
#pragma unroll
                    for (int n = 0; n < 2; ++n) { const size_t o = (size_t)row * 1024 + col0 + bj * HALF + n * 16;
                        const f32x4 pr = bfx4(scr[(((ai * 2 + bj) * 4 + m) * 2 + n) * 512 + tid]); const f32x4 a = acc[ai][bj][m][n] * rr;
                        const f32x4 v = *(const f32x4*)(X2 + o) + sig4(a) * pr;
                        *(f32x4*)(X3 + o) = v; ss += (v[0] * v[0] + v[1] * v[1]) + (v[2] * v[2] + v[3] * v[3]); }
                ss += __shfl_xor(ss, 16); ss += __shfl_xor(ss, 32);
                if (fq == 0) ssp[(size_t)row * 16 + u.pn * 4 + wc] = ss; asm volatile("" ::: "memory"); }
    }
};
}

#define GAS __attribute__((address_space(1)))
#define LAS __attribute__((address_space(3)))
typedef unsigned v4u __attribute__((ext_vector_type(4)));
typedef GAS unsigned gu32;
constexpr int NWAVES = 8;
constexpr int RING_BYTES = 131072, LDSCTL_OFF = RING_BYTES + 4096, MISC_OFF = LDSCTL_OFF + 320, LDS_BYTES = 147456;
constexpr size_t WS_WIN = 12 * MiB, WS_WAB = 26 * MiB, WS_WO = 30 * MiB, WS_WPLE = 32 * MiB, WS_WR = 35 * MiB, WS_WGU = 36 * MiB, WS_WD = 100 * MiB;
constexpr size_t WS_LR = 132 * MiB;
constexpr size_t WS_SCR = 464 * MiB;
constexpr size_t WS_END2 = 496 * MiB;
constexpr int CW_BAR = 4096;
#define LDS_WAIT() asm volatile("s_waitcnt lgkmcnt(0)" ::: "memory")
#define VM_WAIT() asm volatile("s_waitcnt vmcnt(0)" ::: "memory")

#define XB_TMO      128
#define XB_XCNT(j)  (256  + 64 * (j))
#define XB_XSUB(j)  (1280 + 64 * (j))
#define XB_XGEN(j)  (2304 + 64 * (j))
#define XB_TOP      3328
#define XB_TOPGEN   3392
#define XCD_BAR_WORDS 3456
#define XB_SPIN_CAP (1u << 18)
__device__ __forceinline__ unsigned xb_ld(unsigned* p)              { return __hip_atomic_load(p, __ATOMIC_RELAXED, __HIP_MEMORY_SCOPE_AGENT); }
__device__ __forceinline__ unsigned xb_add(unsigned* p, unsigned v) { return __hip_atomic_fetch_add(p, v, __ATOMIC_RELAXED, __HIP_MEMORY_SCOPE_AGENT); }
__device__ __forceinline__ unsigned xb_xcc_id() { return (unsigned)__builtin_amdgcn_s_getreg((3 << 11) | 20) & 0xFu; }
#define XB_SPIN(cond, bar) do { unsigned _sp = 0; while (cond) { __builtin_amdgcn_s_sleep(1); \
    if ((++_sp & 255u) == 0u) { if (xb_ld(&(bar)[XB_TMO])) break; if (_sp > XB_SPIN_CAP) { atomicAdd(&(bar)[XB_TMO], 1u); break; } } } } while (0)
struct XcdBarrier { unsigned* bar; unsigned x; volatile LAS unsigned* st; };
__device__ __forceinline__ XcdBarrier xcd_barrier_post(unsigned* bar, volatile LAS unsigned* st) {
    XcdBarrier b; b.bar = bar; b.x = xb_xcc_id(); b.st = st;
    if (threadIdx.x == 0) (void)xb_add(&bar[XB_XCNT(b.x)], 1u);
    return b;
}
__device__ __forceinline__ void xcd_barrier_complete(unsigned* bar, unsigned x, unsigned& nloc, unsigned& nx) {
    const unsigned G = gridDim.x * gridDim.y * gridDim.z;
    unsigned sum, cnt, mine, sp = 0u;
    for (;;) {
        sum = 0u; cnt = 0u; mine = 0u;
#pragma unroll
        for (unsigned j = 0; j < 16; ++j) { const unsigned c = xb_ld(&bar[XB_XCNT(j)]); sum += c; cnt += (c > 0u) ? 1u : 0u; mine = (j == x) ? c : mine; }
        if (sum == G) break;
        __builtin_amdgcn_s_sleep(1);
        if ((++sp & 255u) == 0u) { if (xb_ld(&bar[XB_TMO])) break; if (sp > XB_SPIN_CAP) { atomicAdd(&bar[XB_TMO], 1u); break; } }
    }
    nloc = mine > 0u ? mine : 1u; nx = cnt > 0u ? cnt : 1u;
}
__device__ __forceinline__ void xcd_barrier(const XcdBarrier& b) {
    asm volatile("s_waitcnt vmcnt(0)" ::: "memory");
    __syncthreads();
    if (threadIdx.x == 0) {
        unsigned* bar = b.bar;
        __builtin_amdgcn_s_waitcnt(0);
        unsigned nloc = b.st[0], nx = b.st[1];
        if (nloc == 0u) { xcd_barrier_complete(bar, b.x, nloc, nx); b.st[0] = nloc; b.st[1] = nx; }
        const unsigned old = xb_add(&bar[XB_XSUB(b.x)], 1u);
        const unsigned gen = old / nloc;
        if (old + 1u == (gen + 1u) * nloc) {
            __builtin_amdgcn_fence(__ATOMIC_RELEASE, "agent");
            asm volatile("s_waitcnt vmcnt(0)" ::: "memory");
            const unsigned og = xb_add(&bar[XB_TOP], 1u);
            const unsigned tg = og / nx;
            if (og + 1u == (tg + 1u) * nx) xb_add(&bar[XB_TOPGEN], 1u);
            else XB_SPIN(xb_ld(&bar[XB_TOPGEN]) == tg, bar);
            __builtin_amdgcn_fence(__ATOMIC_ACQUIRE, "agent");
            xb_add(&bar[XB_XGEN(b.x)], 1u);
            asm volatile("s_waitcnt vmcnt(0)" ::: "memory");
        } else {
            XB_SPIN(xb_ld(&bar[XB_XGEN(b.x)]) == gen, bar);
            __builtin_amdgcn_fence(__ATOMIC_ACQUIRE, "agent");
            asm volatile("s_waitcnt vmcnt(0)" ::: "memory");
        }
    }
    __syncthreads();
}

__device__ __forceinline__ unsigned pk2(float lo, float hi) { return f2bf(lo) | (f2bf(hi) << 16); }
__device__ __forceinline__ void tr_item(const float* __restrict__ W, int ldn, int k0, int n0, bf16* dst, int ldb, int drow0, int dk0, const float* __restrict__ scale, LAS float* scr, int lane) {
    const int lr_ = lane >> 4, lc = (lane & 15) * 4;
    float4 v[16];
#pragma unroll
    for (int i = 0; i < 16; ++i) v[i] = *(const float4*)(W + (size_t)(k0 + 4 * i + lr_) * ldn + n0 + lc);
#pragma unroll
    for (int i = 0; i < 16; ++i) { const int kk = 4 * i + lr_; const float sc = scale ? scale[k0 + kk] : 1.f; LAS float* d = scr + kk * 65 + lc;
        d[0] = v[i].x * sc; d[1] = v[i].y * sc; d[2] = v[i].z * sc; d[3] = v[i].w * sc; }
    LDS_WAIT(); asm volatile("" ::: "memory");
    const int c = lane & 7;
#pragma unroll
    for (int j = 0; j < 8; ++j) { const int n = (lane >> 3) + 8 * j; const LAS float* s_ = scr + (8 * c) * 65 + n;
        v4u o; o.x = pk2(s_[0 * 65], s_[1 * 65]); o.y = pk2(s_[2 * 65], s_[3 * 65]); o.z = pk2(s_[4 * 65], s_[5 * 65]); o.w = pk2(s_[6 * 65], s_[7 * 65]);
        *(GAS v4u*)(dst + (size_t)(drow0 + n) * ldb + dk0 + k0 + 8 * c) = o; }
    LDS_WAIT(); asm volatile("" ::: "memory");
}
__device__ __forceinline__ int map_in(int n0) {
    const int q = n0 >> 7, s = q >> 3, i = q & 7, off = n0 & 127;
    if (s == 0) return 4096 + 128 * i + off;
    if (s == 1) return 256 * i + off;
    if (s == 2) return 256 * i + 128 + off;
    if (s == 3) return 256 * (8 + i) + off;
    if (s == 4) return 256 * (8 + i) + 128 + off;
    if (s == 5) return 5120 + 128 * i + off;
    return 6144 + 128 * i + off;
}

struct Args { const float* in[25]; float* out; unsigned char* ws; int ph_lo, ph_hi; };

__global__ void __launch_bounds__(NWAVES * 64, 2) mega(Args args) {
    extern __shared__ __attribute__((aligned(16))) unsigned char lds_raw[];
    LAS unsigned char* lds = (LAS unsigned char*)lds_raw;
    volatile LAS unsigned* MISC = (volatile LAS unsigned*)(lds + MISC_OFF);
    const int tid = threadIdx.x, lane = tid & 63, wave = __builtin_amdgcn_readfirstlane(tid >> 6);
    const int G = gridDim.x; const int bx = blockIdx.x; const int vcu = (G % 8 == 0) ? (bx % 8) * (G / 8) + bx / 8 : bx;
    unsigned char* ws = args.ws;
    gu32* ctl = (gu32*)(ws + WS_CTL);
    for (int u = tid; u < (LDS_BYTES - LDSCTL_OFF) / 4; u += NWAVES * 64) ((LAS unsigned*)(lds + LDSCTL_OFF))[u] = 0u;
    __syncthreads();
    XcdBarrier bar = xcd_barrier_post((unsigned*)(ctl + CW_BAR), MISC + 8);
    const int lo = args.ph_lo, hi = args.ph_hi;
#ifndef PH_MASK
#define PH_MASK 0x7ff
#endif
#define IN(k) (((PH_MASK >> (k)) & 1) && lo <= (k) && (k) < hi)
#define BOTH(k) (IN(k) && (IN((k) + 1) || rep_ + 1 < NREP(k)))
#ifndef REP_MASK
#define REP_MASK 0
#endif
#define NREP(k) (((REP_MASK >> (k)) & 1) ? 2 : 1)
#define PHASE(k) for (int rep_ = 0; rep_ < (IN(k) ? NREP(k) : 0); ++rep_)
    const float* x = args.in[0];
    bf16* H = (bf16*)args.out;
    bf16* WinT = (bf16*)(ws + WS_WIN); bf16* WabT = (bf16*)(ws + WS_WAB); bf16* WoT = (bf16*)(ws + WS_WO); bf16* WpleT = (bf16*)(ws + WS_WPLE); bf16* WrT = (bf16*)(ws + WS_WR);
    bf16* WguT = (bf16*)(ws + WS_WGU); bf16* WdT = (bf16*)(ws + WS_WD);
    bf16* UA = (bf16*)(ws + WS_RA); bf16* UB = (bf16*)(ws + WS_RB); bf16* AB = (bf16*)(ws + WS_RC); bf16* GA = (bf16*)(ws + WS_RD); bf16* GB = (bf16*)(ws + WS_RE);

    PHASE(0) {
        LAS float* scr = (LAS float*)(lds + wave * 16640);
        const int gw = vcu * NWAVES + wave, NGW = G * NWAVES;
        constexpr int I_IN = 16 * 112, I_SQ = 16 * 16, I_PP = 4 * 16, I_EG = 32 * 16 * 8, I_ED = 32 * 8 * 16;
        constexpr int NITEMS = I_IN + 4 * I_SQ + I_PP + 2 * I_EG + I_ED;
        for (int it = gw; it < NITEMS; it += NGW) {
            int r = it;
            if (r < 2 * I_EG) { const int up = r >= I_EG; if (up) r -= I_EG; const int e = r / 128, q = r % 128, kb = q / 8, nb = q % 8, n0 = 64 * nb;
                tr_item((up ? args.in[19] : args.in[18]) + (size_t)e * D * DE, DE, 64 * kb, n0, WguT + (size_t)e * 1024 * 1024, 1024, 256 * (n0 >> 7) + (up ? 128 : 0) + (n0 & 127), 0, args.in[13], scr, lane); continue; } r -= 2 * I_EG;
            if (r < I_ED) { const int e = r / 128, q = r % 128, kb = q / 16, nb = q % 16; tr_item(args.in[20] + (size_t)e * DE * D, D, 64 * kb, 64 * nb, WdT + (size_t)e * 1024 * 512, 512, 64 * nb, 0, nullptr, scr, lane); continue; } r -= I_ED;
            if (r < I_IN) { const int kb = r / 112, nb = r % 112; tr_item(args.in[3], INC, 64 * kb, 64 * nb, WinT, 1024, map_in(64 * nb), 0, nullptr, scr, lane); continue; } r -= I_IN;
            if (r < I_SQ) { tr_item(args.in[5], D, 64 * (r / 16), 64 * (r % 16), WabT, 2048, 64 * (r % 16), 0, nullptr, scr, lane); continue; } r -= I_SQ;
            if (r < I_SQ) { tr_item(args.in[10], D, 64 * (r / 16), 64 * (r % 16), WabT, 2048, 64 * (r % 16), 1024, nullptr, scr, lane); continue; } r -= I_SQ;
            if (r < I_SQ) { tr_item(args.in[12], D, 64 * (r / 16), 64 * (r % 16), WoT, 1024, 64 * (r % 16), 0, nullptr, scr, lane); continue; } r -= I_SQ;
            if (r < I_SQ) { tr_item(args.in[22], D, 64 * (r / 16), 64 * (r % 16), WpleT, 1280, 64 * (r % 16), 256, args.in[21], scr, lane); continue; } r -= I_SQ;
            tr_item(args.in[23], D, 64 * (r / 16), 64 * (r % 16), WpleT, 1280, 64 * (r % 16), 0, nullptr, scr, lane);
        }
        for (int i = vcu * 512 + tid; i < 256 * 1024; i += G * 512) { const int rr = i >> 10, k = i & 1023; float v = 0.f;
            if (rr < 4) v = args.in[14][k * 4 + rr] * args.in[13][k]; else if (rr < 36) v = args.in[16][k * 32 + rr - 4] * args.in[13][k];
            WrT[i] = (bf16)f2bf(v); }
        const float* g = args.in[2];
        for (int row = 2 * gw; row < T; row += 2 * NGW) {
            const float4* xr = (const float4*)(x + (size_t)row * D);
            float4 v[2][4]; float s0 = 0.f, s1 = 0.f;
#pragma unroll
            for (int j = 0; j < 4; ++j) { v[0][j] = xr[lane + 64 * j]; v[1][j] = xr[256 + lane + 64 * j]; }
#pragma unroll
            for (int j = 0; j < 4; ++j) { s0 += v[0][j].x * v[0][j].x + v[0][j].y * v[0][j].y + v[0][j].z * v[0][j].z + v[0][j].w * v[0][j].w;
                                          s1 += v[1][j].x * v[1][j].x + v[1][j].y * v[1][j].y + v[1][j].z * v[1][j].z + v[1][j].w * v[1][j].w; }
            const float r0 = rsqrtf(wave_sum(s0) * (1.f / D) + EPS), r1_ = rsqrtf(wave_sum(s1) * (1.f / D) + EPS);
#pragma unroll
            for (int j = 0; j < 4; ++j) { const int c = 4 * (lane + 64 * j); const float4 gg = *(const float4*)(g + c);
                uint2 o; o.x = pk2(v[0][j].x * r0 * gg.x, v[0][j].y * r0 * gg.y); o.y = pk2(v[0][j].z * r0 * gg.z, v[0][j].w * r0 * gg.w);
                *(uint2*)(H + (size_t)row * D + c) = o;
                o.x = pk2(v[1][j].x * r1_ * gg.x, v[1][j].y * r1_ * gg.y); o.y = pk2(v[1][j].z * r1_ * gg.z, v[1][j].w * r1_ * gg.w);
                *(uint2*)(H + (size_t)(row + 1) * D + c) = o; }
        }
        if (BOTH(0)) xcd_barrier(bar);
    }
    PHASE(1) {
        pg8::Gemm g{1024, 1024, 1024}; pg8::StaticOrder S; S.init(T, INC, G, bx, H, 1024, WinT, 1024);
        pg8::EpiInProj E{UA, (size_t)(WS_RB - WS_RA) / 2, args.in[11]};
        pg8::gemm_phase<pg8::EpiInProj, pg8::StaticOrder, true>(lds, g, S, E);
        if (BOTH(1)) xcd_barrier(bar);
    }

    bf16* ZZ = (bf16*)args.out; bf16* MIX = (bf16*)(ws + WS_RC); float* X1 = (float*)(ws + WS_RA); bf16* APLE = (bf16*)args.out;
    bf16* HMID = (bf16*)(ws + WS_RC); bf16* YB = (bf16*)(ws + WS_RD); float* X3 = (float*)(ws + WS_RC);
    int* tok_e = (int*)(ws + WS_TOK); float* tok_w = (float*)(ws + WS_TOK + 256 * 1024); int* tok_pos = (int*)(ws + WS_TOK + 512 * 1024);
    float* r1 = (float*)(ws + WS_TOK + 768 * 1024); float* r2 = (float*)(ws + WS_TOK + 896 * 1024);
    float* ssp1 = (float*)(ws + WS_SSP1); float* ssp3 = (float*)(ws + WS_SSP3); int* ltok = (int*)(ws + WS_LTOK); float* lw = (float*)(ws + WS_LW); float* lr = (float*)(ws + WS_LR);
    unsigned* cnt = (unsigned*)(ctl + CW_CNT);
    LAS int* tab = (LAS int*)(lds + LDSCTL_OFF + 1024);
#define MOE_TABLES() do { if (tid == 0) { int us = 0, es = 0; for (int e = 0; e < NE; ++e) { const int c = (int)cnt[e]; tab[e] = us; tab[40 + e] = es; tab[80 + e] = c; us += 4 * ((c + 255) >> 8); es += c; } tab[32] = us; tab[72] = es; } \
        LDS_WAIT(); __syncthreads(); } while (0)

    PHASE(2) {
        typedef float f32x2 __attribute__((ext_vector_type(2)));
        const int c0_ = 2 * tid;
        const float* cwb = args.in[6]; const float* cwa = args.in[4];
        LAS float* red = (LAS float*)(lds + LDSCTL_OFF + 4096); LAS float* tot = (LAS float*)(lds + LDSCTL_OFF + 4096 + 2048);
        const int upw = (1024 + G - 1) / G;
        bool have_prev = false;
        for (int un = vcu * upw; un < (vcu + 1) * upw && un < 1024; ++un) {
            const int t0 = un * 32; const bool first = (t0 & (SEQ - 1)) == 0;
            int c0 = c0_; asm volatile("" : "+v"(c0));
            {
                const int rlo = (have_prev || first) ? 0 : -30;
                const int npieces = (32 - rlo) * 128;
                v4u pc[16];
#pragma unroll
                for (int i = 0; i < 16; ++i) { const int pidx = tid + 512 * i; if (pidx < npieces) { const int row = t0 + rlo + (pidx >> 7);
                        pc[i] = *(const v4u*)(UB + (size_t)row * 1024 + (pidx & 127) * 8); } }
#pragma unroll
                for (int i = 0; i < 16; ++i) { const int pidx = tid + 512 * i; if (pidx < npieces) { const int row = t0 + rlo + (pidx >> 7);
                        *(LAS v4u*)(lds + (row & 63) * 2048 + (pidx & 127) * 16) = pc[i]; } }
            }
            f32x2 wb[31];
#pragma unroll
            for (int k = 0; k < 31; ++k) wb[k] = *(const f32x2*)(cwb + k * 1024 + c0);
            const f32x2 bb = *(const f32x2*)(args.in[7] + c0);
            LDS_WAIT(); __syncthreads();
            f32x2 acc[32];
#pragma unroll
            for (int j = 0; j < 32; ++j) acc[j] = bb;
            const int sb = (t0 + 34) & 63;
#pragma unroll
            for (int si = 0; si < 62; ++si) {
                const bool dead = first && si < 30;
                const unsigned w = *(const LAS unsigned*)(lds + ((sb + si) & 63) * 2048 + tid * 4);
                f32x2 uv = (f32x2){__builtin_bit_cast(float, w << 16), __builtin_bit_cast(float, w & 0xffff0000u)};
                if (dead) uv = (f32x2){0.f, 0.f};
#pragma unroll
                for (int j = (si > 30 ? si - 30 : 0); j <= (si < 31 ? si : 31); ++j) acc[j] += wb[si - j] * uv;
                if ((si & 7) == 7) asm volatile("" ::: "memory");
            }
            float v1[32], v2[32];
#pragma unroll
            for (int j = 0; j < 32; ++j) { v1[j] = acc[j].x + acc[j].y; v2[j] = acc[j].x * acc[j].x + acc[j].y * acc[j].y; }
#define BFLY(v, NN, bit) _Pragma("unroll") for (int i = 0; i < (NN) / 2; ++i) { const bool up_ = (lane & (bit)) != 0; const float keep_ = up_ ? v[i + (NN) / 2] : v[i], send_ = up_ ? v[i] : v[i + (NN) / 2]; v[i] = keep_ + __shfl_xor(send_, (bit)); }
            BFLY(v1, 32, 16) BFLY(v1, 16, 8) BFLY(v1, 8, 4) BFLY(v1, 4, 2) BFLY(v1, 2, 1)
            BFLY(v2, 32, 16) BFLY(v2, 16, 8) BFLY(v2, 8, 4) BFLY(v2, 4, 2) BFLY(v2, 2, 1)
#undef BFLY
            v1[0] += __shfl_xor(v1[0], 32); v2[0] += __shfl_xor(v2[0], 32);
            red[wave * 64 + lane] = lane < 32 ? v1[0] : v2[0];
            LDS_WAIT(); __syncthreads();
            if (tid < 64) { float sm = 0.f;
#pragma unroll
                for (int w8 = 0; w8 < 8; ++w8) sm += red[w8 * 64 + tid];
                tot[tid] = sm; }
            LDS_WAIT(); __syncthreads();
            asm volatile("" : "+v"(c0));
            unsigned rua[34], rab[32];
#pragma unroll
            for (int j = 0; j < 34; ++j) rua[j] = *(const unsigned*)(UA + (size_t)((first && j < 2) ? t0 : t0 - 2 + j) * 1024 + c0);
#pragma unroll
            for (int j = 0; j < 32; ++j) rab[j] = *(const unsigned*)(AB + (size_t)(t0 + j) * 1024 + c0);
            const f32x2 lg = *(const f32x2*)(args.in[8] + c0), lb = *(const f32x2*)(args.in[9] + c0);
#pragma unroll
            for (int j = 0; j < 32; ++j) { const float mu = tot[j] * (1.f / 1024.f); const float var = tot[32 + j] * (1.f / 1024.f) - mu * mu; const float rstd = rsqrtf(var + EPS);
                const f32x2 y = (acc[j] - mu) * rstd * lg + lb;
                *(unsigned*)(ZZ + (size_t)(t0 + j) * 2048 + 1024 + c0) = pg8::cvt_pk_bf16(y.x * pg8::fsig(y.x), y.y * pg8::fsig(y.y)); }
            asm volatile("" : "+v"(c0));
            const f32x2 wa0 = *(const f32x2*)(cwa + c0), wa1 = *(const f32x2*)(cwa + 1024 + c0), wa2 = *(const f32x2*)(cwa + 2048 + c0);
#define BF2(w_) ((f32x2){__builtin_bit_cast(float, (w_) << 16), __builtin_bit_cast(float, (w_) & 0xffff0000u)})
            if (first) { rua[0] = 0u; rua[1] = 0u; }
#pragma unroll
            for (int j = 0; j < 32; ++j) { const f32x2 za = BF2(rab[j]) * (wa0 * BF2(rua[j]) + wa1 * BF2(rua[j + 1]) + wa2 * BF2(rua[j + 2]));
                *(unsigned*)(ZZ + (size_t)(t0 + j) * 2048 + c0) = pg8::cvt_pk_bf16(za.x, za.y); }
#undef BF2
            have_prev = true;
        }
        if (BOTH(2)) xcd_barrier(bar);
    }
    PHASE(3) {
        pg8::Gemm g{2048, 2048, 2048}; pg8::StaticOrder S; S.init(T, D, G, bx, ZZ, 2048, WabT, 2048);
        pg8::EpiMix E{GA, GB, MIX};
        pg8::gemm_phase<pg8::EpiMix, pg8::StaticOrder, true>(lds, g, S, E);
        if (BOTH(3)) xcd_barrier(bar);
    }
    PHASE(4) {
        pg8::Gemm g{1024, 1024, 1024}; pg8::StaticOrder S; S.init(T, D, G, bx, MIX, 1024, WoT, 1024);
        pg8::EpiWo E{x, X1, APLE, ssp1};
        pg8::gemm_phase<pg8::EpiWo, pg8::StaticOrder, true>(lds, g, S, E);
        if (BOTH(4)) xcd_barrier(bar);
    }
    PHASE(5) {
        pg8::Gemm g{1280, 1024, 1024}; pg8::StaticOrder S; S.init(T, 256, G, bx, APLE + 256, 1280, WrT, 1024);
        pg8::EpiRouter E{ssp1, args.in[15], args.in[17], cnt, tok_e, tok_w, tok_pos, r1, ltok, lw, lr};
        pg8::gemm_phase<pg8::EpiRouter, pg8::StaticOrder, false>(lds, g, S, E);
        const int nidle = G > 128 ? G - 128 : G, me = G > 128 ? bx - 128 : bx;
        if (me >= 0) { const float* p = args.in[1];
            for (size_t i = (size_t)me * 512 + tid; i < (size_t)T * 64; i += (size_t)nidle * 512) { const size_t t = i >> 6; const int c = (int)(i & 63) * 4; const float4 v = *(const float4*)(p + t * PLE + c);
                uint2 o; o.x = pk2(v.x, v.y); o.y = pk2(v.z, v.w); *(uint2*)(APLE + t * APITCH + c) = o; } }
        if (BOTH(5)) xcd_barrier(bar);
    }
    PHASE(6) {
        MOE_TABLES();
        pg8::Gemm g{1280, 1024, 1024};
        pg8::MoeOrder<true> S{tab, tab[32], G, bx, (const char*)(APLE + 256), (const char*)WguT, (size_t)1024 * 1024 * 2, (size_t)256 * 1024 * 2, 1280, ltok};
        pg8::EpiMoeUp E{lr, HMID};
        pg8::gemm_phase<pg8::EpiMoeUp, pg8::MoeOrder<true>, true>(lds, g, S, E);
        if (BOTH(6)) xcd_barrier(bar);
    }
    PHASE(7) {
        MOE_TABLES();
        pg8::Gemm g{512, 512, 512};
        pg8::MoeOrder<false> S{tab, tab[32], G, bx, (const char*)HMID, (const char*)WdT, (size_t)1024 * 512 * 2, (size_t)256 * 512 * 2, 512, ltok};
        pg8::EpiMoeDown E{lw, YB};
        pg8::gemm_phase<pg8::EpiMoeDown, pg8::MoeOrder<false>, true>(lds, g, S, E);
        if (BOTH(7)) xcd_barrier(bar);
    }
    PHASE(8) {
        MOE_TABLES();
        const int gw = vcu * NWAVES + wave, NGW = G * NWAVES;
        for (int t = gw; t < T; t += NGW) {
            const int sa = tab[40 + tok_e[t * 2]] + tok_pos[t * 2], sb = tab[40 + tok_e[t * 2 + 1]] + tok_pos[t * 2 + 1];
            float s = 0.f;
#pragma unroll
            for (int j = 0; j < 4; ++j) { const int c = 4 * (lane + 64 * j);
                float4 v = *(const float4*)(X1 + (size_t)t * D + c);
                const uint2 ya = *(const uint2*)(YB + (size_t)sa * D + c), yb = *(const uint2*)(YB + (size_t)sb * D + c);
                v.x += bf2f(ya.x & 0xffff) + bf2f(yb.x & 0xffff); v.y += bf2f(ya.x >> 16) + bf2f(yb.x >> 16);
                v.z += bf2f(ya.y & 0xffff) + bf2f(yb.y & 0xffff); v.w += bf2f(ya.y >> 16) + bf2f(yb.y >> 16);
                s += v.x * v.x + v.y * v.y + v.z * v.z + v.w * v.w;
                *(float4*)(X1 + (size_t)t * D + c) = v;
                uint2 o; o.x = pk2(v.x, v.y); o.y = pk2(v.z, v.w);
                *(uint2*)(APLE + (size_t)t * APITCH + 256 + c) = o; }
            s = wave_sum(s);
            if (lane == 0) r2[t] = rsqrtf(s * (1.f / D) + EPS);
        }
        if (BOTH(8)) xcd_barrier(bar);
    }
    PHASE(9) {
        pg8::Gemm g{1280, 1280, 1280}; pg8::StaticOrder S; S.init(T, D, G, bx, APLE, 1280, WpleT, 1280);
        pg8::EpiPle E{X1, r2, X3, ssp3, (pg8::u32x2*)(ws + WS_SCR + (size_t)bx * 131072)};
        pg8::gemm_phase<pg8::EpiPle, pg8::StaticOrder, true>(lds, g, S, E);
        if (BOTH(9)) xcd_barrier(bar);
    }
    PHASE(10) {
        const int gw = vcu * NWAVES + wave, NGW = G * NWAVES; const float* gfin = args.in[24];
        for (int row = gw; row < T; row += NGW) {
            float ss = lane < 16 ? ssp3[(size_t)row * 16 + lane] : 0.f; ss = wave_sum(ss);
            const float r = rsqrtf(ss * (1.f / D) + EPS);
#pragma unroll
            for (int j = 0; j < 4; ++j) { const int c = 4 * (lane + 64 * j); const float4 v = *(const float4*)(X3 + (size_t)row * D + c); const float4 gg = *(const float4*)(gfin + c);
                *(float4*)(args.out + (size_t)row * D + c) = make_float4(v.x * r * gg.x, v.y * r * gg.y, v.z * r * gg.z, v.w * r * gg.w); }
        }
    }
#undef MOE_TABLES
#undef IN
#undef BOTH
}

#ifndef OPT_UPTO
#define OPT_UPTO 11
#endif
extern "C" void kernel_launch(void* const* d_in, const int* in_sizes, int n_in, void* d_out, int out_size, void* d_ws, size_t ws_size, hipStream_t stream) {
    static int grid = 0;
    if (grid == 0) {
        if (n_in != 25 || in_sizes[0] != T * D || out_size != T * D || ws_size < WS_END2) { fprintf(stderr, "kernel_launch: unexpected shapes (n_in %d, in0 %d, out %d, ws %zu)\n", n_in, n_in > 0 ? in_sizes[0] : -1, out_size, ws_size); grid = -1; return; }
        int dev = 0, cus = 0, per_cu = 0;
        if (hipGetDevice(&dev) != hipSuccess || hipDeviceGetAttribute(&cus, hipDeviceAttributeMultiprocessorCount, dev) != hipSuccess) { fprintf(stderr, "kernel_launch: device query failed\n"); grid = -1; return; }
        if (hipFuncSetAttribute((const void*)mega, hipFuncAttributeMaxDynamicSharedMemorySize, LDS_BYTES) != hipSuccess) { fprintf(stderr, "kernel_launch: hipFuncSetAttribute failed\n"); grid = -1; return; }
        if (hipOccupancyMaxActiveBlocksPerMultiprocessor(&per_cu, (const void*)mega, NWAVES * 64, LDS_BYTES) != hipSuccess || per_cu < 1) { fprintf(stderr, "kernel_launch: occupancy query says %d blocks per CU\n", per_cu); (void)hipGetLastError(); grid = -1; return; }
        grid = cus;
    }
    if (grid < 0) return;
    const float* x = (const float*)d_in[0]; const float* p = (const float*)d_in[1];
    const float* conv_a_w = (const float*)d_in[4]; const float* w_out_a = (const float*)d_in[5]; const float* conv_b_w = (const float*)d_in[6]; const float* conv_b_b = (const float*)d_in[7];
    const float* ln_b_g = (const float*)d_in[8]; const float* ln_b_b = (const float*)d_in[9]; const float* w_out_b = (const float*)d_in[10];
    const float* w_o = (const float*)d_in[12]; const float* ffn_g = (const float*)d_in[13]; const float* w_rg = (const float*)d_in[14]; const float* b_rg = (const float*)d_in[15];
    const float* w_re = (const float*)d_in[16]; const float* b_re = (const float*)d_in[17]; const float* w_eg = (const float*)d_in[18]; const float* w_eu = (const float*)d_in[19];
    const float* w_ed = (const float*)d_in[20]; const float* ple_g = (const float*)d_in[21]; const float* w_pg = (const float*)d_in[22]; const float* w_pp = (const float*)d_in[23];
    const float* fin_g = (const float*)d_in[24];
    unsigned char* ws = (unsigned char*)d_ws; float* out = (float*)d_out;
    unsigned* ctl = (unsigned*)(ws + WS_CTL);
    int* tok_e = (int*)(ws + WS_TOK); float* tok_w = (float*)(ws + WS_TOK + 256 * 1024); int* tok_pos = (int*)(ws + WS_TOK + 512 * 1024);
    float* r1 = (float*)(ws + WS_TOK + 768 * 1024); float* r2 = (float*)(ws + WS_TOK + 896 * 1024);
    float* ssp1 = (float*)(ws + WS_SSP1); int* ltok = (int*)(ws + WS_LTOK); float* lw = (float*)(ws + WS_LW);
    bf16* UA = (bf16*)(ws + WS_RA); bf16* UB = (bf16*)(ws + WS_RB); bf16* AB = (bf16*)(ws + WS_RC); bf16* GA = (bf16*)(ws + WS_RD); bf16* GB = (bf16*)(ws + WS_RE);
    bf16* ZZ = (bf16*)d_out; bf16* MIX = (bf16*)(ws + WS_RC); float* X1 = (float*)(ws + WS_RA); bf16* APLE = (bf16*)d_out;
    bf16* HMID = (bf16*)(ws + WS_RC); bf16* YB = (bf16*)(ws + WS_RD); float* X3 = (float*)(ws + WS_RC);

    if (hipMemsetAsync(ws + WS_CTL, 0, 1 * MiB, stream) != hipSuccess) { fprintf(stderr, "kernel_launch: memset failed\n"); return; }
    Args a{};
    for (int i = 0; i < 25; ++i) a.in[i] = (const float*)d_in[i];
    a.out = out; a.ws = ws; a.ph_lo = 0; a.ph_hi = OPT_UPTO;
    void* kargs[] = {&a};
    const hipError_t le = hipLaunchCooperativeKernel((const void*)mega, dim3(grid), dim3(NWAVES * 64), kargs, LDS_BYTES, stream);
    if (le != hipSuccess) { fprintf(stderr, "kernel_launch: cooperative launch failed: %s (grid %d)\n", hipGetErrorString(le), grid); return; }
#if OPT_UPTO < 11
    if (OPT_UPTO <= 1) nv_inproj<<<dim3(T / 8, 4), 256, 0, stream>>>((const bf16*)d_out, (const float*)d_in[3], (const float*)d_in[11], UA, UB, AB, GA, GB);
    if (OPT_UPTO <= 2) nv_conv<<<T, 256, 0, stream>>>(UA, UB, AB, conv_a_w, conv_b_w, conv_b_b, ln_b_g, ln_b_b, ZZ);
    if (OPT_UPTO <= 3) nv_outab<<<dim3(T / 8, 4), 256, 0, stream>>>(ZZ, w_out_a, w_out_b, GA, GB, MIX);
    if (OPT_UPTO <= 4) { nv_wo<<<dim3(T / 8, 4), 256, 0, stream>>>(MIX, w_o, x, X1, APLE); nv_rowss<<<T / 4, 256, 0, stream>>>(X1, ssp1); }
    if (OPT_UPTO <= 5) { nv_router<<<T / 4, 256, 0, stream>>>(X1, ssp1, ffn_g, w_rg, b_rg, w_re, b_re, ctl + CW_CNT, tok_e, tok_w, tok_pos, r1, ltok, lw); nv_pcvt<<<T * PLE / 4 / 256, 256, 0, stream>>>(p, APLE); }
    if (OPT_UPTO <= 6) nv_moe_up<<<dim3(T / 8, NE), 256, 0, stream>>>(X1, r1, ffn_g, w_eg, w_eu, ctl + CW_CNT, ltok, HMID);
    if (OPT_UPTO <= 7) nv_moe_down<<<dim3(T / 8, NE), 256, 0, stream>>>(HMID, w_ed, ctl + CW_CNT, lw, YB);
    if (OPT_UPTO <= 8) nv_combine<<<T / 4, 256, 0, stream>>>(X1, YB, ctl + CW_CNT, tok_e, tok_pos, APLE, r2);
    if (OPT_UPTO <= 9) nv_ple<<<dim3(T / 8, 4), 256, 0, stream>>>(X1, r2, ple_g, w_pg, p, w_pp, X3);
    if (OPT_UPTO <= 10) nv_final<<<T / 4, 256, 0, stream>>>(X3, fin_g, out);
#endif
}
```

```cpp
#include <hip/hip_runtime.h>
#include <cstdio>
#include <cstdint>

typedef unsigned short bf16;
constexpr int T = 32768, D = 1024, SEQ = 2048, PLE = 256, NE = 32, NG = 4, EPG = 8, DE = 512, INC = 7168;
constexpr float EPS = 1e-6f;
constexpr size_t MiB = 1u << 20;
constexpr size_t WS_CTL = 0;
constexpr size_t WS_TOK = 1 * MiB;
constexpr size_t WS_SSP1 = 2 * MiB;
constexpr size_t WS_SSP3 = 4 * MiB;
constexpr size_t WS_LTOK = 6 * MiB;
constexpr size_t WS_LW = 136 * MiB;
constexpr size_t WS_RA = 144 * MiB, WS_RB = 208 * MiB, WS_RC = 272 * MiB, WS_RD = 336 * MiB, WS_RE = 400 * MiB;
constexpr size_t WS_END = 464 * MiB;
constexpr int APITCH = 1280;
constexpr int CW_CNT = 64;

__device__ __forceinline__ unsigned f2bf(float f) { unsigned u = __builtin_bit_cast(unsigned, f); return (u + 0x7fffu + ((u >> 16) & 1u)) >> 16; }
__device__ __forceinline__ float bf2f(unsigned short b) { return __builtin_bit_cast(float, (unsigned)b << 16); }
__device__ __forceinline__ float sigmoidf_(float v) { return 1.f / (1.f + __expf(-v)); }
__device__ __forceinline__ float siluf_(float v) { return v / (1.f + __expf(-v)); }
__device__ __forceinline__ float wave_sum(float v) {
#pragma unroll
    for (int o = 1; o < 64; o <<= 1) v += __shfl_xor(v, o);
    return v;
}

#define REP_MASK 0
#define OPT_UPTO 11
namespace pg8 {
#define PG8_LAS __attribute__((address_space(3)))
typedef unsigned short bf16_t;
typedef short bf16x8 __attribute__((ext_vector_type(8)));
typedef float f32x4 __attribute__((ext_vector_type(4)));
typedef unsigned u32x4 __attribute__((ext_vector_type(4)));
typedef unsigned u32x2 __attribute__((ext_vector_type(2)));
constexpr int BM = 256, BK = 64, HALF = 128, HTB = HALF * BK * 2, STAGE_BYTES = 8 * HTB, NXCD = 8, WGM = 8;
__host__ __device__ __forceinline__ int lds_byte(int r, int c) { const int st = (r >> 4) * 2 + (c >> 5), rr = r & 15, cc = c & 31, ob = rr * 64 + cc * 2; return st * 1024 + (ob ^ (((ob >> 9) & 1) << 5)); }
__host__ __device__ __forceinline__ void stage_rc(int b, int& R, int& C) { const int st = b / 1024, sb = b % 1024, swz = sb ^ (((sb >> 9) & 1) << 5); R = (st >> 1) * 16 + swz / 64; C = (st & 1) * 32 + (swz % 64) / 2; }
__host__ __device__ __forceinline__ int perm32(int rho) { const int n = rho >> 4, i = rho & 15; return 8 * (i >> 2) + 4 * n + (i & 3); }

struct Unit { int pm, pn, e, nrow, slot0; };
struct Gemm { int lda, ldb, K; };

__device__ __forceinline__ unsigned cvt_pk_bf16(float lo, float hi) { unsigned r; asm volatile("v_cvt_pk_bf16_f32 %0, %1, %2" : "=v"(r) : "v"(lo), "v"(hi)); return r; }
__device__ __forceinline__ float fsig(float v) { return __builtin_amdgcn_rcpf(1.f + __expf(-v)); }
__device__ __forceinline__ f32x4 sig4(f32x4 v) { return (f32x4){fsig(v[0]), fsig(v[1]), fsig(v[2]), fsig(v[3])}; }
__device__ __forceinline__ f32x4 bfx4(u32x2 w) { return (f32x4){__builtin_bit_cast(float, w.x << 16), __builtin_bit_cast(float, w.x & 0xffff0000u), __builtin_bit_cast(float, w.y << 16), __builtin_bit_cast(float, w.y & 0xffff0000u)}; }

struct StaticOrder {
    static constexpr bool GATHER = false;
    int nM, nN, nwg, G, c; const char* A; const char* Bt; size_t atile, btile;
    __device__ __forceinline__ void init(int M, int N, int G_, int c_, const void* A_, int lda, const void* Bt_, int ldb) { nM = M / BM; nN = N / BM; nwg = nM * nN; G = G_; c = c_; A = (const char*)A_; Bt = (const char*)Bt_; atile = (size_t)BM * lda * 2; btile = (size_t)BM * ldb * 2; }
    __device__ __forceinline__ bool next(int i, Unit& u) const {
        const long L = (long)i * G + c; if (L >= nwg) return false;
        int wgid = (int)L; { const int q = nwg / NXCD, r = nwg % NXCD, xcd = wgid % NXCD, off = wgid / NXCD; wgid = (xcd < r ? xcd * (q + 1) : r * (q + 1) + (xcd - r) * q) + off; }
        const int nig = WGM * nN, gid = wgid / nig, fm = gid * WGM, gsz = (nM - fm) < WGM ? (nM - fm) : WGM;
        u.pm = fm + ((wgid % nig) % gsz); u.pn = (wgid % nig) / gsz; u.e = 0; u.nrow = 256; u.slot0 = 0; return true;
    }
    __device__ __forceinline__ void ptrs(const Unit& u, const char*& cA, const char*& cB) const { cA = A + (size_t)u.pm * atile; cB = Bt + (size_t)u.pn * btile; }
    __device__ __forceinline__ void rows(const Unit&, const int (&)[2], const int (&)[2], unsigned (&)[2][2]) const {}
};

template <class Epi, class Sched, bool ALIGN_EPI>
__device__ __forceinline__ void gemm_phase(PG8_LAS unsigned char* lds, const Gemm g, const Sched& S, const Epi& E) {
    const int tid = threadIdx.x, wid = __builtin_amdgcn_readfirstlane(tid >> 6), lane = tid & 63, wr = wid >> 2, wc = wid & 3, fr = lane & 15, fq = lane >> 4;
    const int K = g.K, nt = K / BK;
    int Rr[2], Cc[2]; unsigned vA[2][2], vN[2][2], voffB[2];
#pragma unroll
    for (int i = 0; i < 2; ++i) { int R, C; stage_rc(tid * 16 + i * 8192, R, C); Rr[i] = R; Cc[i] = C; const int Rb = Epi::PERM ? ((R & ~31) + perm32(R & 31)) : R;
        voffB[i] = (unsigned)(Rb * g.ldb + C) * 2u; vA[0][i] = (unsigned)(R * g.lda + C) * 2u; vA[1][i] = (unsigned)((R + HALF) * g.lda + C) * 2u; vN[0][i] = vA[0][i]; vN[1][i] = vA[1][i]; }
    const size_t kstep = (size_t)(BK * 2);
    const size_t hstepB = (size_t)HALF * g.ldb * 2;
    const unsigned ldsw = (unsigned)wid * 1024u;
    const int aoff = lds_byte(wr * 64 + fr, fq * 8), boff = lds_byte(wc * 32 + fr, fq * 8);
#define PG8_SA(b, h) (((b) * 2 + (h)) * HTB)
#define PG8_SB(b, h) ((4 + (b) * 2 + (h)) * HTB)
#define PG8_STAGE(bufoff, gbase, voff) do { _Pragma("unroll") for (int _i = 0; _i < 2; ++_i) \
        __builtin_amdgcn_global_load_lds((const unsigned*)((const char*)(gbase) + (voff)[_i]), (PG8_LAS unsigned*)(lds + (bufoff) + ldsw + _i * 8192), 16, 0, 0); } while (0)
#define PG8_LDA(dst, b, h) do { _Pragma("unroll") for (int m = 0; m < 4; ++m) _Pragma("unroll") for (int k = 0; k < 2; ++k) dst[m][k] = *(const PG8_LAS bf16x8*)(lds + PG8_SA(b, h) + aoff + m * 2048 + k * 1024); } while (0)
#define PG8_LDB(dst, b, h) do { _Pragma("unroll") for (int n = 0; n < 2; ++n) _Pragma("unroll") for (int k = 0; k < 2; ++k) dst[n][k] = *(const PG8_LAS bf16x8*)(lds + PG8_SB(b, h) + boff + n * 2048 + k * 1024); } while (0)
#define PG8_MMA(ai, bj, At, Bt) do { __builtin_amdgcn_s_setprio(1); _Pragma("unroll") for (int m = 0; m < 4; ++m) _Pragma("unroll") for (int n = 0; n < 2; ++n) _Pragma("unroll") for (int k = 0; k < 2; ++k) \
        acc[ai][bj][m][n] = __builtin_amdgcn_mfma_f32_16x16x32_bf16(Bt[n][k], At[m][k], acc[ai][bj][m][n], 0, 0, 0); __builtin_amdgcn_s_setprio(0); } while (0)
#define PG8_WAIT_V(n) asm volatile("s_waitcnt vmcnt(" #n ")" ::: "memory")
#define PG8_WAIT_L(n) asm volatile("s_waitcnt lgkmcnt(" #n ")" ::: "memory")
#define PG8_BAR __builtin_amdgcn_s_barrier()
#define PG8_SCHED __builtin_amdgcn_sched_barrier(0)
    Unit cur, nxt; int ui = 0;
    if (!S.next(0, cur)) return;
    f32x4 acc[2][2][4][2];
#pragma unroll
    for (int a = 0; a < 2; ++a)
#pragma unroll
        for (int b = 0; b < 2; ++b)
#pragma unroll
            for (int m = 0; m < 4; ++m)
#pragma unroll
                for (int n = 0; n < 2; ++n) acc[a][b][m][n] = (f32x4){0.f, 0.f, 0.f, 0.f};
    bf16x8 At[4][2], B0[2][2], B1[2][2];
    const char* cA; const char* cB; S.ptrs(cur, cA, cB);
    if constexpr (Sched::GATHER) S.rows(cur, Rr, Cc, vA);
    PG8_STAGE(PG8_SB(0, 0), cB, voffB); PG8_STAGE(PG8_SB(0, 1), cB + hstepB, voffB); PG8_STAGE(PG8_SA(0, 0), cA, vA[0]); PG8_STAGE(PG8_SA(0, 1), cA, vA[1]);
    if (wr == 1) PG8_BAR;
    PG8_WAIT_V(2); PG8_BAR;
    PG8_STAGE(PG8_SB(1, 0), cB + kstep, voffB); PG8_STAGE(PG8_SA(1, 0), cA + kstep, vA[0]); PG8_STAGE(PG8_SB(1, 1), cB + hstepB + kstep, voffB);
    PG8_WAIT_V(6); PG8_BAR;
    for (;;) {
        const bool has_next = S.next(ui + 1, nxt);
        const char* nA = cA; const char* nB = cB;
        if (has_next) { S.ptrs(nxt, nA, nB); if constexpr (Sched::GATHER) S.rows(nxt, Rr, Cc, vN); }
        else { if constexpr (Sched::GATHER) {
#pragma unroll
            for (int h = 0; h < 2; ++h)
#pragma unroll
                for (int i = 0; i < 2; ++i) vN[h][i] = vA[h][i]; } }
        for (int t = 0; t < nt; t += 2) {
            const bool last = (t == nt - 2);
            if constexpr (Epi::MID_T > 0) { if (t == Epi::MID_T) E.mid(acc, cur, wr, wc, fr, fq); }
            const char* a1 = cA + (size_t)(t + 1) * kstep;
            const char* a2 = last ? nA : cA + (size_t)(t + 2) * kstep; const char* b2 = last ? nB : cB + (size_t)(t + 2) * kstep;
            const char* a3 = a2 + kstep; const char* b3 = b2 + kstep;
            PG8_LDB(B0, 0, 0); PG8_LDB(B1, 0, 1); PG8_SCHED; PG8_LDA(At, 0, 0); PG8_STAGE(PG8_SA(1, 1), a1, vA[1]);
            PG8_WAIT_V(8); PG8_WAIT_L(0); PG8_BAR; PG8_MMA(0, 0, At, B0); PG8_MMA(0, 1, At, B1); PG8_BAR; PG8_SCHED;
            if constexpr (Sched::GATHER) { if (last) {
#pragma unroll
                for (int h = 0; h < 2; ++h)
#pragma unroll
                    for (int i = 0; i < 2; ++i) vA[h][i] = vN[h][i]; } }
            PG8_LDA(At, 0, 1); PG8_STAGE(PG8_SB(0, 0), b2, voffB); PG8_STAGE(PG8_SB(0, 1), b2 + hstepB, voffB); PG8_STAGE(PG8_SA(0, 0), a2, vA[0]);
            PG8_WAIT_V(8); PG8_WAIT_L(0); PG8_BAR; PG8_MMA(1, 0, At, B0); PG8_MMA(1, 1, At, B1); PG8_BAR; PG8_SCHED;
            PG8_LDB(B0, 1, 0); PG8_LDB(B1, 1, 1); PG8_SCHED; PG8_LDA(At, 1, 0); PG8_STAGE(PG8_SA(0, 1), a2, vA[1]);
            PG8_WAIT_V(8); PG8_WAIT_L(0); PG8_BAR; PG8_MMA(0, 0, At, B0); PG8_MMA(0, 1, At, B1); PG8_BAR; PG8_SCHED;
            PG8_LDA(At, 1, 1); PG8_STAGE(PG8_SB(1, 0), b3, voffB); PG8_STAGE(PG8_SB(1, 1), b3 + hstepB, voffB); PG8_STAGE(PG8_SA(1, 0), a3, vA[0]);
            PG8_WAIT_V(8); PG8_WAIT_L(0); PG8_BAR; PG8_MMA(1, 0, At, B0); PG8_MMA(1, 1, At, B1); PG8_BAR; PG8_SCHED;
        }
        if constexpr (ALIGN_EPI) { if (wr == 0) PG8_BAR; }
        if constexpr (!Epi::AFTER_DRAIN) { E(acc, cur, wr, wc, fr, fq); }
        if (!has_next) break;
#pragma unroll
        for (int a = 0; a < 2; ++a)
#pragma unroll
            for (int b = 0; b < 2; ++b)
#pragma unroll
                for (int m = 0; m < 4; ++m)
#pragma unroll
                    for (int n = 0; n < 2; ++n) acc[a][b][m][n] = (f32x4){0.f, 0.f, 0.f, 0.f};
        cur = nxt; cA = nA; cB = nB; ++ui;
        if constexpr (ALIGN_EPI) { if (wr == 1) PG8_BAR; }
    }
    PG8_WAIT_V(0);
    if constexpr (!ALIGN_EPI) { if (wr == 0) PG8_BAR; }
    PG8_BAR;
    if constexpr (Epi::AFTER_DRAIN) { E.fused(acc, cur, wr, wc, fr, fq, lds, wid, lane); }
#undef PG8_SA
#undef PG8_SB
#undef PG8_STAGE
#undef PG8_LDA
#undef PG8_LDB
#undef PG8_MMA
#undef PG8_WAIT_V
#undef PG8_WAIT_L
#undef PG8_BAR
#undef PG8_SCHED
}

struct EpiInProj {
    static constexpr bool PERM = true, AFTER_DRAIN = false; static constexpr int MID_T = 0;
    bf16_t* R0; size_t rs; const float* b_gate;
    __device__ __forceinline__ void operator()(const f32x4 (&acc)[2][2][4][2], const Unit& u, int wr, int wc, int fr, int fq) const {
        const int row0 = u.pm * BM + wr * 64 + fr, cc = wc * 32 + 8 * fq;
        if (u.pn < 16) {
            const bool sg = u.pn >= 8; bf16_t* O = R0 + (size_t)(sg ? 1 : 0) * rs + (u.pn & 7) * 128 + cc;
#pragma unroll
            for (int ai = 0; ai < 2; ++ai)
#pragma unroll
                for (int m = 0; m < 4; ++m) {
                    f32x4 b0 = acc[ai][1][m][0], b1 = acc[ai][1][m][1];
                    if (sg) { b0 = sig4(b0); b1 = sig4(b1); }
                    const f32x4 v0 = acc[ai][0][m][0] * b0, v1 = acc[ai][0][m][1] * b1;
                    u32x4 w; w.x = cvt_pk_bf16(v0[0], v0[1]); w.y = cvt_pk_bf16(v0[2], v0[3]); w.z = cvt_pk_bf16(v1[0], v1[1]); w.w = cvt_pk_bf16(v1[2], v1[3]);
                    *(u32x4*)(O + (size_t)(row0 + ai * HALF + m * 16) * 1024) = w; }
        } else {
            const int sec = (u.pn - 16) >> 2, ct = ((u.pn - 16) & 3) * 256 + cc;
            bf16_t* O = R0 + (size_t)(2 + sec) * rs + ct;
            f32x4 bv[2][2];
#pragma unroll
            for (int bj = 0; bj < 2; ++bj)
#pragma unroll
                for (int n = 0; n < 2; ++n) bv[bj][n] = sec ? *(const f32x4*)(b_gate + (sec - 1) * 1024 + ct + bj * HALF + 4 * n) : (f32x4){0.f, 0.f, 0.f, 0.f};
#pragma unroll
            for (int ai = 0; ai < 2; ++ai)
#pragma unroll
                for (int m = 0; m < 4; ++m)
#pragma unroll
                    for (int bj = 0; bj < 2; ++bj) {
                        f32x4 v0 = acc[ai][bj][m][0] + bv[bj][0], v1 = acc[ai][bj][m][1] + bv[bj][1];
                        if (sec) { v0 = sig4(v0); v1 = sig4(v1); }
                        u32x4 w; w.x = cvt_pk_bf16(v0[0], v0[1]); w.y = cvt_pk_bf16(v0[2], v0[3]); w.z = cvt_pk_bf16(v1[0], v1[1]); w.w = cvt_pk_bf16(v1[2], v1[3]);
                        *(u32x4*)(O + (size_t)(row0 + ai * HALF + m * 16) * 1024 + bj * HALF) = w; }
        }
    }
};

struct EpiMix {
    static constexpr bool PERM = true, AFTER_DRAIN = false; static constexpr int MID_T = 16;
    const bf16_t *GA, *GB; bf16_t* MIX;
    __device__ __forceinline__ void mid(f32x4 (&acc)[2][2][4][2], const Unit& u, int wr, int wc, int fr, int fq) const {
        int row0 = u.pm * BM + wr * 64 + fr, col0 = u.pn * BM + wc * 32 + 8 * fq;
        asm volatile("" : "+v"(row0), "+v"(col0));
#pragma unroll
        for (int ai = 0; ai < 2; ++ai)
#pragma unroll
            for (int m = 0; m < 4; ++m)
#pragma unroll
                for (int bj = 0; bj < 2; ++bj) { const size_t o = (size_t)(row0 + ai * HALF + m * 16) * 1024 + col0 + bj * HALF;
                    const u32x4 ga = *(const u32x4*)(GA + o), gb = *(const u32x4*)(GB + o);
                    const f32x4 a0 = bfx4((u32x2){ga.x, ga.y}), a1 = bfx4((u32x2){ga.z, ga.w}), b0 = bfx4((u32x2){gb.x, gb.y}), b1 = bfx4((u32x2){gb.z, gb.w});
#pragma unroll
                    for (int j = 0; j < 4; ++j) { acc[ai][bj][m][0][j] *= a0[j] * __builtin_amdgcn_rcpf(b0[j]); acc[ai][bj][m][1][j] *= a1[j] * __builtin_amdgcn_rcpf(b1[j]); }
                    asm volatile("" : "+v"(acc[ai][bj][m][0]), "+v"(acc[ai][bj][m][1]) :: "memory"); }
    }
    __device__ __forceinline__ void operator()(const f32x4 (&acc)[2][2][4][2], const Unit& u, int wr, int wc, int fr, int fq) const {
        const int row0 = u.pm * BM + wr * 64 + fr, col0 = u.pn * BM + wc * 32 + 8 * fq;
#pragma unroll
        for (int ai = 0; ai < 2; ++ai)
#pragma unroll
            for (int m = 0; m < 4; ++m)
#pragma unroll
                for (int bj = 0; bj < 2; ++bj) { const size_t o = (size_t)(row0 + ai * HALF + m * 16) * 1024 + col0 + bj * HALF;
                    const u32x4 gb = *(const u32x4*)(GB + o);
                    const f32x4 v0 = acc[ai][bj][m][0] * bfx4((u32x2){gb.x, gb.y}), v1 = acc[ai][bj][m][1] * bfx4((u32x2){gb.z, gb.w});
                    u32x4 w; w.x = cvt_pk_bf16(v0[0], v0[1]); w.y = cvt_pk_bf16(v0[2], v0[3]); w.z = cvt_pk_bf16(v1[0], v1[1]); w.w = cvt_pk_bf16(v1[2], v1[3]);
                    *(u32x4*)(MIX + o) = w; asm volatile("" ::: "memory"); }
    }
};
struct EpiWo {
    static constexpr bool PERM = false, AFTER_DRAIN = false; static constexpr int MID_T = 0;
    const float* x; bf16_t* APLE; float* ssp;
    __device__ __forceinline__ void operator()(const f32x4 (&acc)[2][2][4][2], const Unit& u, int wr, int wc, int fr, int fq) const {
        const int row0 = u.pm * BM + wr * 64 + fr, col0 = u.pn * BM + wc * 32 + 4 * fq;
#pragma unroll
        for (int ai = 0; ai < 2; ++ai)
#pragma unroll
            for (int m = 0; m < 4; ++m) { const int row = row0 + ai * HALF + m * 16; float ss = 0.f;
#pragma unroll
                for (int bj = 0; bj < 2; ++bj)
#pragma unroll
                    for (int n = 0; n < 2; ++n) { const size_t o = (size_t)row * 1024 + col0 + bj * HALF + n * 16;
                        const f32x4 v = *(const f32x4*)(x + o) + acc[ai][bj][m][n];
                        ss += (v[0] * v[0] + v[1] * v[1]) + (v[2] * v[2] + v[3] * v[3]);
                        u32x2 w; w.x = cvt_pk_bf16(v[0], v[1]); w.y = cvt_pk_bf16(v[2], v[3]);
                        *(u32x2*)(APLE + (size_t)row * 1280 + 256 + col0 + bj * HALF + n * 16) = w; }
                ss += __shfl_xor(ss, 16); ss += __shfl_xor(ss, 32);
                if (fq == 0) ssp[(size_t)row * 16 + u.pn * 4 + wc] = ss; }
    }
};
struct EpiRouter {
    static constexpr bool PERM = false, AFTER_DRAIN = true; static constexpr int MID_T = 0;
    const float* ssp1; const float* brg; const float* bre; unsigned* cnt; int* tok_e; float* tok_w; int* tok_pos; float* r1; int* ltok; float* lw; float* lr;
    __device__ __forceinline__ void fused(f32x4 (&acc)[2][2][4][2], const Unit& u, int wr, int wc, int fr, int fq, PG8_LAS unsigned char* lds, int wid, int lane) const {
        PG8_LAS float* L = (PG8_LAS float*)lds;
        PG8_LAS int* hist = (PG8_LAS int*)(lds + 40960);
        const int tid = wid * 64 + lane;
        if (tid < 64) hist[tid] = 0;
        if (wc == 0) {
#pragma unroll
            for (int ai = 0; ai < 2; ++ai)
#pragma unroll
                for (int m = 0; m < 4; ++m)
#pragma unroll
                    for (int n = 0; n < 2; ++n) *(PG8_LAS f32x4*)(L + (ai * HALF + wr * 64 + m * 16 + fr) * 40 + 16 * n + 4 * fq) = acc[ai][0][m][n];
        } else if (wc == 1 && fq == 0) {
#pragma unroll
            for (int ai = 0; ai < 2; ++ai)
#pragma unroll
                for (int m = 0; m < 4; ++m) *(PG8_LAS f32x4*)(L + (ai * HALF + wr * 64 + m * 16 + fr) * 40 + 32) = acc[ai][0][m][0];
        }
        asm volatile("s_waitcnt lgkmcnt(0)" ::: "memory"); __builtin_amdgcn_s_barrier(); asm volatile("" ::: "memory");
        int ea = 0, eb = 0, la = 0, lb = 0; float wa_ = 0.f, wb_ = 0.f, r = 0.f; const int t = u.pm * BM + tid;
        if (tid < 256) {
            float ss = 0.f;
#pragma unroll
            for (int i = 0; i < 16; i += 4) { const f32x4 pv = *(const f32x4*)(ssp1 + (size_t)t * 16 + i); ss += (pv[0] + pv[1]) + (pv[2] + pv[3]); }
            r = rsqrtf(ss * (1.f / 1024.f) + 1e-6f);
            float lg[40];
#pragma unroll
            for (int i = 0; i < 36; i += 4) { const f32x4 v = *(const PG8_LAS f32x4*)(L + tid * 40 + i); lg[i] = v[0]; lg[i + 1] = v[1]; lg[i + 2] = v[2]; lg[i + 3] = v[3]; }
            float gl[4]; int grp = 0;
#pragma unroll
            for (int i = 0; i < 4; ++i) gl[i] = lg[i] * r + brg[i];
            float gm = gl[0];
#pragma unroll
            for (int i = 1; i < 4; ++i) if (gl[i] > gm) { gm = gl[i]; grp = i; }
            float den = 0.f;
#pragma unroll
            for (int i = 0; i < 4; ++i) den += __expf(gl[i] - gm);
            const float pg = 1.f / den;
            float el[8];
#pragma unroll
            for (int i = 0; i < 8; ++i) { float v = 0.f;
#pragma unroll
                for (int g2 = 0; g2 < 4; ++g2) v = (grp == g2) ? lg[4 + g2 * 8 + i] * r + bre[g2 * 8 + i] : v;
                el[i] = v; }
            int i0 = 0; float v0 = el[0];
#pragma unroll
            for (int i = 1; i < 8; ++i) if (el[i] > v0) { v0 = el[i]; i0 = i; }
            int i1 = -1; float v1 = -3.0e38f;
#pragma unroll
            for (int i = 0; i < 8; ++i) if (i != i0 && el[i] > v1) { v1 = el[i]; i1 = i; }
            const float e1 = __expf(v1 - v0); const float s0 = 1.f / (1.f + e1), s1 = e1 / (1.f + e1);
            ea = grp * 8 + i0; eb = grp * 8 + i1; wa_ = s0 * pg; wb_ = s1 * pg;
            la = __hip_atomic_fetch_add(&hist[ea], 1, __ATOMIC_RELAXED, __HIP_MEMORY_SCOPE_WORKGROUP); lb = __hip_atomic_fetch_add(&hist[eb], 1, __ATOMIC_RELAXED, __HIP_MEMORY_SCOPE_WORKGROUP);
        }
        asm volatile("s_waitcnt lgkmcnt(0)" ::: "memory"); __builtin_amdgcn_s_barrier(); asm volatile("" ::: "memory");
        if (tid < 32) { const int h = hist[tid]; hist[32 + tid] = h ? (int)atomicAdd(cnt + tid, (unsigned)h) : 0; }
        asm volatile("s_waitcnt vmcnt(0) lgkmcnt(0)" ::: "memory"); __builtin_amdgcn_s_barrier(); asm volatile("" ::: "memory");
        if (tid < 256) {
            const int pa = hist[32 + ea] + la, pb = hist[32 + eb] + lb;
            tok_e[t * 2] = ea; tok_e[t * 2 + 1] = eb; tok_w[t * 2] = wa_; tok_w[t * 2 + 1] = wb_; tok_pos[t * 2] = pa; tok_pos[t * 2 + 1] = pb; r1[t] = r;
            ltok[(size_t)ea * 32768 + pa] = t; lw[(size_t)ea * 32768 + pa] = wa_; lr[(size_t)ea * 32768 + pa] = r;
            ltok[(size_t)eb * 32768 + pb] = t; lw[(size_t)eb * 32768 + pb] = wb_; lr[(size_t)eb * 32768 + pb] = r;
        }
    }
};
template <bool GATHER_> struct MoeOrder {
    static constexpr bool GATHER = GATHER_;
    const PG8_LAS int* tab; int nwg, G, c; const char* A; const char* Bt; size_t bexp, btile; int lda; const int* ltok;
    __device__ __forceinline__ bool next(int i, Unit& u) const {
        const long L = (long)i * G + c; if (L >= nwg) return false;
        int wgid = (int)L; { const int q = nwg / NXCD, r = nwg % NXCD, xcd = wgid % NXCD, off = wgid / NXCD; wgid = (xcd < r ? xcd * (q + 1) : r * (q + 1) + (xcd - r) * q) + off; }
        int e = 0;
        for (int k = 1; k < 32; ++k) e += (__builtin_amdgcn_readfirstlane(tab[k]) <= wgid) ? 1 : 0;
        const int rem = wgid - __builtin_amdgcn_readfirstlane(tab[e]);
        u.pn = rem & 3; u.pm = rem >> 2; u.e = e; u.nrow = __builtin_amdgcn_readfirstlane(tab[80 + e]) - 256 * u.pm; u.slot0 = __builtin_amdgcn_readfirstlane(tab[40 + e]) + 256 * u.pm; return true;
    }
    __device__ __forceinline__ void ptrs(const Unit& u, const char*& cA, const char*& cB) const {
        cA = GATHER ? A : A + (size_t)u.slot0 * lda * 2; cB = Bt + (size_t)u.e * bexp + (size_t)u.pn * btile; }
    __device__ __forceinline__ void rows(const Unit& u, const int (&Rr)[2], const int (&Cc)[2], unsigned (&off)[2][2]) const {
#pragma unroll
        for (int h = 0; h < 2; ++h)
#pragma unroll
            for (int i = 0; i < 2; ++i) { const int r = h * HALF + Rr[i]; const int tok = (r < u.nrow) ? ltok[(size_t)u.e * 32768 + 256 * u.pm + r] : 0; off[h][i] = (unsigned)(tok * lda + Cc[i]) * 2u; }
    }
};
struct EpiMoeUp {
    static constexpr bool PERM = true, AFTER_DRAIN = false; static constexpr int MID_T = 0;
    const float* lr; bf16_t* HMID;
    __device__ __forceinline__ void operator()(const f32x4 (&acc)[2][2][4][2], const Unit& u, int wr, int wc, int fr, int fq) const {
        const int cc = u.pn * 128 + wc * 32 + 8 * fq;
#pragma unroll
        for (int ai = 0; ai < 2; ++ai)
#pragma unroll
            for (int m = 0; m < 4; ++m) { const int row = ai * HALF + wr * 64 + m * 16 + fr;
                if (row < u.nrow) { const float r = lr[(size_t)u.e * 32768 + 256 * u.pm + row];
                    f32x4 v[2];
#pragma unroll
                    for (int n = 0; n < 2; ++n)
#pragma unroll
                        for (int j = 0; j < 4; ++j) { const float g = acc[ai][0][m][n][j] * r, up = acc[ai][1][m][n][j] * r; v[n][j] = g * fsig(g) * up; }
                    u32x4 w; w.x = cvt_pk_bf16(v[0][0], v[0][1]); w.y = cvt_pk_bf16(v[0][2], v[0][3]); w.z = cvt_pk_bf16(v[1][0], v[1][1]); w.w = cvt_pk_bf16(v[1][2], v[1][3]);
                    *(u32x4*)(HMID + (size_t)(u.slot0 + row) * 512 + cc) = w; } }
    }
};
struct EpiMoeDown {
    static constexpr bool PERM = true, AFTER_DRAIN = false; static constexpr int MID_T = 0;
    const float* lw; bf16_t* YB;
    __device__ __forceinline__ void operator()(const f32x4 (&acc)[2][2][4][2], const Unit& u, int wr, int wc, int fr, int fq) const {
        const int cc = u.pn * 256 + wc * 32 + 8 * fq;
#pragma unroll
        for (int ai = 0; ai < 2; ++ai)
#pragma unroll
            for (int m = 0; m < 4; ++m) { const int row = ai * HALF + wr * 64 + m * 16 + fr;
                if (row < u.nrow) { const float gw = lw[(size_t)u.e * 32768 + 256 * u.pm + row];
#pragma unroll
                    for (int bj = 0; bj < 2; ++bj) { const f32x4 v0 = acc[ai][bj][m][0] * gw, v1 = acc[ai][bj][m][1] * gw;
                        u32x4 w; w.x = cvt_pk_bf16(v0[0], v0[1]); w.y = cvt_pk_bf16(v0[2], v0[3]); w.z = cvt_pk_bf16(v1[0], v1[1]); w.w = cvt_pk_bf16(v1[2], v1[3]);
                        *(u32x4*)(YB + (size_t)(u.slot0 + row) * 1024 + cc + bj * HALF) = w; } } }
    }
};
struct EpiPle {
    static constexpr bool PERM = false, AFTER_DRAIN = false; static constexpr int MID_T = 4;
    const bf16_t* APLE; const float* r2; bf16_t* X3; float* ssp; u32x2* scr;
    __device__ __forceinline__ void mid(f32x4 (&acc)[2][2][4][2], const Unit&, int, int, int, int) const {
        int tid = threadIdx.x;
        asm volatile("" : "+v"(tid));
#pragma unroll
        for (int ai = 0; ai < 2; ++ai)
#pragma unroll
            for (int bj = 0; bj < 2; ++bj)
#pragma unroll
                for (int m = 0; m < 4; ++m)
#pragma unroll
                    for (int n = 0; n < 2; ++n) { const f32x4 v = acc[ai][bj][m][n]; u32x2 w; w.x = cvt_pk_bf16(v[0], v[1]); w.y = cvt_pk_bf16(v[2], v[3]);
                        scr[(((ai * 2 + bj) * 4 + m) * 2 + n) * 512 + tid] = w; acc[ai][bj][m][n] = (f32x4){0.f, 0.f, 0.f, 0.f}; asm volatile("" ::: "memory"); }
    }
    __device__ __forceinline__ void operator()(const f32x4 (&acc)[2][2][4][2], const Unit& u, int wr, int wc, int fr, int fq) const {
        int tid = threadIdx.x; int row0 = u.pm * BM + wr * 64 + fr, col0 = u.pn * BM + wc * 32 + 4 * fq;
        asm volatile("" : "+v"(tid), "+v"(row0), "+v"(col0));
#pragma unroll
        for (int ai = 0; ai < 2; ++ai)
#pragma unroll
            for (int m = 0; m < 4; ++m) { const int row = row0 + ai * HALF + m * 16; const float rr = r2[row]; float ss = 0.f;
#pragma unroll
                for (int bj = 0; bj < 2; ++bj)
#pragma unroll
                    for (int n = 0; n < 2; ++n) { const size_t o = (size_t)row * 1024 + col0 + bj * HALF + n * 16;
                        const f32x4 pr = bfx4(scr[(((ai * 2 + bj) * 4 + m) * 2 + n) * 512 + tid]); const f32x4 a = acc[ai][bj][m][n] * rr;
                        const f32x4 v = bfx4(*(const u32x2*)(APLE + (size_t)row * 1280 + 256 + col0 + bj * HALF + n * 16)) + sig4(a) * pr;
                        u32x2 w; w.x = cvt_pk_bf16(v[0], v[1]); w.y = cvt_pk_bf16(v[2], v[3]);
                        *(u32x2*)(X3 + o) = w; ss += (v[0] * v[0] + v[1] * v[1]) + (v[2] * v[2] + v[3] * v[3]); }
                ss += __shfl_xor(ss, 16); ss += __shfl_xor(ss, 32);
                if (fq == 0) ssp[(size_t)row * 16 + u.pn * 4 + wc] = ss; asm volatile("" ::: "memory"); }
    }
};
}

#define GAS __attribute__((address_space(1)))
#define LAS __attribute__((address_space(3)))
typedef unsigned v4u __attribute__((ext_vector_type(4)));
typedef GAS unsigned gu32;
constexpr int NWAVES = 8;
constexpr int RING_BYTES = 131072, LDSCTL_OFF = RING_BYTES + 4096, MISC_OFF = LDSCTL_OFF + 320, LDS_BYTES = 147456;
constexpr size_t WS_WIN = 12 * MiB, WS_WAB = 26 * MiB, WS_WO = 30 * MiB, WS_WPLE = 32 * MiB, WS_WR = 35 * MiB, WS_WGU = 36 * MiB, WS_WD = 100 * MiB;
constexpr size_t WS_LR = 132 * MiB;
constexpr size_t WS_SCR = 464 * MiB;
constexpr size_t WS_END2 = 496 * MiB;
constexpr int CW_BAR = 4096;
#define LDS_WAIT() asm volatile("s_waitcnt lgkmcnt(0)" ::: "memory")
#define VM_WAIT() asm volatile("s_waitcnt vmcnt(0)" ::: "memory")

#define XB_TMO      128
#define XB_XCNT(j)  (256  + 64 * (j))
#define XB_XSUB(j)  (1280 + 64 * (j))
#define XB_XGEN(j)  (2304 + 64 * (j))
#define XB_TOP      3328
#define XB_TOPGEN   3392
#define XCD_BAR_WORDS 3456
#define XB_SPIN_CAP (1u << 18)
__device__ __forceinline__ unsigned xb_ld(unsigned* p)              { return __hip_atomic_load(p, __ATOMIC_RELAXED, __HIP_MEMORY_SCOPE_AGENT); }
__device__ __forceinline__ unsigned xb_add(unsigned* p, unsigned v) { return __hip_atomic_fetch_add(p, v, __ATOMIC_RELAXED, __HIP_MEMORY_SCOPE_AGENT); }
__device__ __forceinline__ unsigned xb_xcc_id() { return (unsigned)__builtin_amdgcn_s_getreg((3 << 11) | 20) & 0xFu; }
#define XB_SPIN(cond, bar) do { unsigned _sp = 0; while (cond) { __builtin_amdgcn_s_sleep(1); \
    if ((++_sp & 255u) == 0u) { if (xb_ld(&(bar)[XB_TMO])) break; if (_sp > XB_SPIN_CAP) { atomicAdd(&(bar)[XB_TMO], 1u); break; } } } } while (0)
struct XcdBarrier { unsigned* bar; unsigned x; volatile LAS unsigned* st; };
__device__ __forceinline__ XcdBarrier xcd_barrier_post(unsigned* bar, volatile LAS unsigned* st) {
    XcdBarrier b; b.bar = bar; b.x = xb_xcc_id(); b.st = st;
    if (threadIdx.x == 0) (void)xb_add(&bar[XB_XCNT(b.x)], 1u);
    return b;
}
__device__ __forceinline__ void xcd_barrier_complete(unsigned* bar, unsigned x, unsigned& nloc, unsigned& nx) {
    const unsigned G = gridDim.x * gridDim.y * gridDim.z;
    unsigned sum, cnt, mine, sp = 0u;
    for (;;) {
        sum = 0u; cnt = 0u; mine = 0u;
#pragma unroll
        for (unsigned j = 0; j < 16; ++j) { const unsigned c = xb_ld(&bar[XB_XCNT(j)]); sum += c; cnt += (c > 0u) ? 1u : 0u; mine = (j == x) ? c : mine; }
        if (sum == G) break;
        __builtin_amdgcn_s_sleep(1);
        if ((++sp & 255u) == 0u) { if (xb_ld(&bar[XB_TMO])) break; if (sp > XB_SPIN_CAP) { atomicAdd(&bar[XB_TMO], 1u); break; } }
    }
    nloc = mine > 0u ? mine : 1u; nx = cnt > 0u ? cnt : 1u;
}
__device__ __forceinline__ void xcd_barrier(const XcdBarrier& b) {
    asm volatile("s_waitcnt vmcnt(0)" ::: "memory");
    __syncthreads();
    if (threadIdx.x == 0) {
        unsigned* bar = b.bar;
        __builtin_amdgcn_s_waitcnt(0);
        unsigned nloc = b.st[0], nx = b.st[1];
        if (nloc == 0u) { xcd_barrier_complete(bar, b.x, nloc, nx); b.st[0] = nloc; b.st[1] = nx; }
        const unsigned old = xb_add(&bar[XB_XSUB(b.x)], 1u);
        const unsigned gen = old / nloc;
        if (old + 1u == (gen + 1u) * nloc) {
            __builtin_amdgcn_fence(__ATOMIC_RELEASE, "agent");
            asm volatile("s_waitcnt vmcnt(0)" ::: "memory");
            const unsigned og = xb_add(&bar[XB_TOP], 1u);
            const unsigned tg = og / nx;
            if (og + 1u == (tg + 1u) * nx) xb_add(&bar[XB_TOPGEN], 1u);
            else XB_SPIN(xb_ld(&bar[XB_TOPGEN]) == tg, bar);
            __builtin_amdgcn_fence(__ATOMIC_ACQUIRE, "agent");
            xb_add(&bar[XB_XGEN(b.x)], 1u);
            asm volatile("s_waitcnt vmcnt(0)" ::: "memory");
        } else {
            XB_SPIN(xb_ld(&bar[XB_XGEN(b.x)]) == gen, bar);
            __builtin_amdgcn_fence(__ATOMIC_ACQUIRE, "agent");
            asm volatile("s_waitcnt vmcnt(0)" ::: "memory");
        }
    }
    __syncthreads();
}

__device__ __forceinline__ unsigned pk2(float lo, float hi) { return f2bf(lo) | (f2bf(hi) << 16); }
__device__ __forceinline__ void tr_item(const float* __restrict__ W, int ldn, int k0, int n0, bf16* dst, int ldb, int drow0, int dk0, const float* __restrict__ scale, LAS float* scr, int lane) {
    const int lr_ = lane >> 4, lc = (lane & 15) * 4;
    float4 v[16];
#pragma unroll
    for (int i = 0; i < 16; ++i) v[i] = *(const float4*)(W + (size_t)(k0 + 4 * i + lr_) * ldn + n0 + lc);
#pragma unroll
    for (int i = 0; i < 16; ++i) { const int kk = 4 * i + lr_; const float sc = scale ? scale[k0 + kk] : 1.f; LAS float* d = scr + kk * 65 + lc;
        d[0] = v[i].x * sc; d[1] = v[i].y * sc; d[2] = v[i].z * sc; d[3] = v[i].w * sc; }
    LDS_WAIT(); asm volatile("" ::: "memory");
    const int c = lane & 7;
#pragma unroll
    for (int j = 0; j < 8; ++j) { const int n = (lane >> 3) + 8 * j; const LAS float* s_ = scr + (8 * c) * 65 + n;
        v4u o; o.x = pk2(s_[0 * 65], s_[1 * 65]); o.y = pk2(s_[2 * 65], s_[3 * 65]); o.z = pk2(s_[4 * 65], s_[5 * 65]); o.w = pk2(s_[6 * 65], s_[7 * 65]);
        *(GAS v4u*)(dst + (size_t)(drow0 + n) * ldb + dk0 + k0 + 8 * c) = o; }
    LDS_WAIT(); asm volatile("" ::: "memory");
}
__device__ __forceinline__ int map_in(int n0) {
    const int q = n0 >> 7, s = q >> 3, i = q & 7, off = n0 & 127;
    if (s == 0) return 4096 + 128 * i + off;
    if (s == 1) return 256 * i + off;
    if (s == 2) return 256 * i + 128 + off;
    if (s == 3) return 256 * (8 + i) + off;
    if (s == 4) return 256 * (8 + i) + 128 + off;
    if (s == 5) return 5120 + 128 * i + off;
    return 6144 + 128 * i + off;
}

struct Args { const float* in[25]; float* out; unsigned char* ws; int ph_lo, ph_hi; };

__global__ void __launch_bounds__(NWAVES * 64, 2) mega(Args args) {
    extern __shared__ __attribute__((aligned(16))) unsigned char lds_raw[];
    LAS unsigned char* lds = (LAS unsigned char*)lds_raw;
    volatile LAS unsigned* MISC = (volatile LAS unsigned*)(lds + MISC_OFF);
    const int tid = threadIdx.x, lane = tid & 63, wave = __builtin_amdgcn_readfirstlane(tid >> 6);
    const int G = gridDim.x; const int bx = blockIdx.x; const int vcu = (G % 8 == 0) ? (bx % 8) * (G / 8) + bx / 8 : bx;
    unsigned char* ws = args.ws;
    gu32* ctl = (gu32*)(ws + WS_CTL);
    for (int u = tid; u < (LDS_BYTES - LDSCTL_OFF) / 4; u += NWAVES * 64) ((LAS unsigned*)(lds + LDSCTL_OFF))[u] = 0u;
    __syncthreads();
    XcdBarrier bar = xcd_barrier_post((unsigned*)(ctl + CW_BAR), MISC + 8);
    const int lo = args.ph_lo, hi = args.ph_hi;
#ifndef PH_MASK
#define PH_MASK 0x7ff
#endif
#define IN(k) (((PH_MASK >> (k)) & 1) && lo <= (k) && (k) < hi)
#define BOTH(k) (IN(k) && (IN((k) + 1) || rep_ + 1 < NREP(k)))
#ifndef REP_MASK
#define REP_MASK 0
#endif
#define NREP(k) (((REP_MASK >> (k)) & 1) ? 2 : 1)
#define PHASE(k) if (IN(k)) _Pragma("unroll") for (int rep_ = 0; rep_ < NREP(k); ++rep_)
    const float* x = args.in[0];
    bf16* H = (bf16*)args.out;
    bf16* WinT = (bf16*)(ws + WS_WIN); bf16* WabT = (bf16*)(ws + WS_WAB); bf16* WoT = (bf16*)(ws + WS_WO); bf16* WpleT = (bf16*)(ws + WS_WPLE); bf16* WrT = (bf16*)(ws + WS_WR);
    bf16* WguT = (bf16*)(ws + WS_WGU); bf16* WdT = (bf16*)(ws + WS_WD);
    bf16* UA = (bf16*)(ws + WS_RA); bf16* UB = (bf16*)(ws + WS_RB); bf16* AB = (bf16*)(ws + WS_RC); bf16* GA = (bf16*)(ws + WS_RD); bf16* GB = (bf16*)(ws + WS_RE);

    PHASE(0) {
        LAS float* scr = (LAS float*)(lds + wave * 16640);
        const int gw = vcu * NWAVES + wave, NGW = G * NWAVES;
        constexpr int I_IN = 16 * 112, I_SQ = 16 * 16, I_PP = 4 * 16, I_EG = 32 * 16 * 8, I_ED = 32 * 8 * 16;
        constexpr int NITEMS = I_IN + 4 * I_SQ + I_PP + 2 * I_EG + I_ED;
        for (int it = gw; it < NITEMS; it += NGW) {
            int r = it;
            if (r < 2 * I_EG) { const int up = r >= I_EG; if (up) r -= I_EG; const int e = r / 128, q = r % 128, kb = q / 8, nb = q % 8, n0 = 64 * nb;
                tr_item((up ? args.in[19] : args.in[18]) + (size_t)e * D * DE, DE, 64 * kb, n0, WguT + (size_t)e * 1024 * 1024, 1024, 256 * (n0 >> 7) + (up ? 128 : 0) + (n0 & 127), 0, args.in[13], scr, lane); continue; } r -= 2 * I_EG;
            if (r < I_ED) { const int e = r / 128, q = r % 128, kb = q / 16, nb = q % 16; tr_item(args.in[20] + (size_t)e * DE * D, D, 64 * kb, 64 * nb, WdT + (size_t)e * 1024 * 512, 512, 64 * nb, 0, nullptr, scr, lane); continue; } r -= I_ED;
            if (r < I_IN) { const int kb = r / 112, nb = r % 112; tr_item(args.in[3], INC, 64 * kb, 64 * nb, WinT, 1024, map_in(64 * nb), 0, nullptr, scr, lane); continue; } r -= I_IN;
            if (r < I_SQ) { tr_item(args.in[5], D, 64 * (r / 16), 64 * (r % 16), WabT, 2048, 64 * (r % 16), 0, nullptr, scr, lane); continue; } r -= I_SQ;
            if (r < I_SQ) { tr_item(args.in[10], D, 64 * (r / 16), 64 * (r % 16), WabT, 2048, 64 * (r % 16), 1024, nullptr, scr, lane); continue; } r -= I_SQ;
            if (r < I_SQ) { tr_item(args.in[12], D, 64 * (r / 16), 64 * (r % 16), WoT, 1024, 64 * (r % 16), 0, nullptr, scr, lane); continue; } r -= I_SQ;
            if (r < I_SQ) { tr_item(args.in[22], D, 64 * (r / 16), 64 * (r % 16), WpleT, 1280, 64 * (r % 16), 256, args.in[21], scr, lane); continue; } r -= I_SQ;
            tr_item(args.in[23], D, 64 * (r / 16), 64 * (r % 16), WpleT, 1280, 64 * (r % 16), 0, nullptr, scr, lane);
        }
        for (int i = vcu * 512 + tid; i < 256 * 1024; i += G * 512) { const int rr = i >> 10, k = i & 1023; float v = 0.f;
            if (rr < 4) v = args.in[14][k * 4 + rr] * args.in[13][k]; else if (rr < 36) v = args.in[16][k * 32 + rr - 4] * args.in[13][k];
            WrT[i] = (bf16)f2bf(v); }
        const float* g = args.in[2];
        for (int row = 2 * gw; row < T; row += 2 * NGW) {
            const float4* xr = (const float4*)(x + (size_t)row * D);
            float4 v[2][4]; float s0 = 0.f, s1 = 0.f;
#pragma unroll
            for (int j = 0; j < 4; ++j) { v[0][j] = xr[lane + 64 * j]; v[1][j] = xr[256 + lane + 64 * j]; }
#pragma unroll
            for (int j = 0; j < 4; ++j) { s0 += v[0][j].x * v[0][j].x + v[0][j].y * v[0][j].y + v[0][j].z * v[0][j].z + v[0][j].w * v[0][j].w;
                                          s1 += v[1][j].x * v[1][j].x + v[1][j].y * v[1][j].y + v[1][j].z * v[1][j].z + v[1][j].w * v[1][j].w; }
            const float r0 = rsqrtf(wave_sum(s0) * (1.f / D) + EPS), r1_ = rsqrtf(wave_sum(s1) * (1.f / D) + EPS);
#pragma unroll
            for (int j = 0; j < 4; ++j) { const int c = 4 * (lane + 64 * j); const float4 gg = *(const float4*)(g + c);
                uint2 o; o.x = pk2(v[0][j].x * r0 * gg.x, v[0][j].y * r0 * gg.y); o.y = pk2(v[0][j].z * r0 * gg.z, v[0][j].w * r0 * gg.w);
                *(uint2*)(H + (size_t)row * D + c) = o;
                o.x = pk2(v[1][j].x * r1_ * gg.x, v[1][j].y * r1_ * gg.y); o.y = pk2(v[1][j].z * r1_ * gg.z, v[1][j].w * r1_ * gg.w);
                *(uint2*)(H + (size_t)(row + 1) * D + c) = o; }
        }
        if (BOTH(0)) xcd_barrier(bar);
    }
    PHASE(1) {
        pg8::Gemm g{1024, 1024, 1024}; pg8::StaticOrder S; S.init(T, INC, G, bx, H, 1024, WinT, 1024);
        pg8::EpiInProj E{UA, (size_t)(WS_RB - WS_RA) / 2, args.in[11]};
        pg8::gemm_phase<pg8::EpiInProj, pg8::StaticOrder, true>(lds, g, S, E);
        if (BOTH(1)) xcd_barrier(bar);
    }

    bf16* ZZ = (bf16*)args.out; bf16* MIX = (bf16*)(ws + WS_RC); bf16* APLE = (bf16*)(ws + WS_RA);
    bf16* HMID = (bf16*)(ws + WS_RC); bf16* YB = (bf16*)(ws + WS_RD); bf16* X3 = (bf16*)(ws + WS_RC);
    int* tok_e = (int*)(ws + WS_TOK); float* tok_w = (float*)(ws + WS_TOK + 256 * 1024); int* tok_pos = (int*)(ws + WS_TOK + 512 * 1024);
    float* r1 = (float*)(ws + WS_TOK + 768 * 1024); float* r2 = (float*)(ws + WS_TOK + 896 * 1024);
    float* ssp1 = (float*)(ws + WS_SSP1); float* ssp3 = (float*)(ws + WS_SSP3); int* ltok = (int*)(ws + WS_LTOK); float* lw = (float*)(ws + WS_LW); float* lr = (float*)(ws + WS_LR);
    unsigned* cnt = (unsigned*)(ctl + CW_CNT);
    LAS int* tab = (LAS int*)(lds + LDSCTL_OFF + 1024);
#define MOE_TABLES() do { if (tid == 0) { int us = 0, es = 0; for (int e = 0; e < NE; ++e) { const int c = (int)cnt[e]; tab[e] = us; tab[40 + e] = es; tab[80 + e] = c; us += 4 * ((c + 255) >> 8); es += c; } tab[32] = us; tab[72] = es; } \
        LDS_WAIT(); __syncthreads(); } while (0)

    PHASE(2) {
        typedef float f32x2 __attribute__((ext_vector_type(2)));
        const int c0_ = 2 * tid;
        const float* cwb = args.in[6]; const float* cwa = args.in[4];
        LAS float* red = (LAS float*)(lds + LDSCTL_OFF + 4096); LAS float* tot = (LAS float*)(lds + LDSCTL_OFF + 4096 + 2048);
        const int upw = (1024 + G - 1) / G;
        bool have_prev = false;
        for (int un = vcu * upw; un < (vcu + 1) * upw && un < 1024; ++un) {
            const int t0 = un * 32; const bool first = (t0 & (SEQ - 1)) == 0;
            int c0 = c0_; asm volatile("" : "+v"(c0));
            {
                const int rlo = (have_prev || first) ? 0 : -30;
                const int npieces = (32 - rlo) * 128;
                v4u pc[16];
#pragma unroll
                for (int i = 0; i < 16; ++i) { const int pidx = tid + 512 * i; if (pidx < npieces) { const int row = t0 + rlo + (pidx >> 7);
                        pc[i] = *(const v4u*)(UB + (size_t)row * 1024 + (pidx & 127) * 8); } }
#pragma unroll
                for (int i = 0; i < 16; ++i) { const int pidx = tid + 512 * i; if (pidx < npieces) { const int row = t0 + rlo + (pidx >> 7);
                        *(LAS v4u*)(lds + (row & 63) * 2048 + (pidx & 127) * 16) = pc[i]; } }
            }
            f32x2 wb[31];
#pragma unroll
            for (int k = 0; k < 31; ++k) wb[k] = *(const f32x2*)(cwb + k * 1024 + c0);
            const f32x2 bb = *(const f32x2*)(args.in[7] + c0);
            LDS_WAIT(); __syncthreads();
            f32x2 acc[32];
#pragma unroll
            for (int j = 0; j < 32; ++j) acc[j] = bb;
            const int sb = (t0 + 34) & 63;
#pragma unroll
            for (int si = 0; si < 62; ++si) {
                const bool dead = first && si < 30;
                const unsigned w = *(const LAS unsigned*)(lds + ((sb + si) & 63) * 2048 + tid * 4);
                f32x2 uv = (f32x2){__builtin_bit_cast(float, w << 16), __builtin_bit_cast(float, w & 0xffff0000u)};
                if (dead) uv = (f32x2){0.f, 0.f};
#pragma unroll
                for (int j = (si > 30 ? si - 30 : 0); j <= (si < 31 ? si : 31); ++j) acc[j] += wb[si - j] * uv;
                if ((si & 7) == 7) asm volatile("" ::: "memory");
            }
            float v1[32], v2[32];
#pragma unroll
            for (int j = 0; j < 32; ++j) { v1[j] = acc[j].x + acc[j].y; v2[j] = acc[j].x * acc[j].x + acc[j].y * acc[j].y; }
#define BFLY(v, NN, bit) _Pragma("unroll") for (int i = 0; i < (NN) / 2; ++i) { const bool up_ = (lane & (bit)) != 0; const float keep_ = up_ ? v[i + (NN) / 2] : v[i], send_ = up_ ? v[i] : v[i + (NN) / 2]; v[i] = keep_ + __shfl_xor(send_, (bit)); }
            BFLY(v1, 32, 16) BFLY(v1, 16, 8) BFLY(v1, 8, 4) BFLY(v1, 4, 2) BFLY(v1, 2, 1)
            BFLY(v2, 32, 16) BFLY(v2, 16, 8) BFLY(v2, 8, 4) BFLY(v2, 4, 2) BFLY(v2, 2, 1)
#undef BFLY
            v1[0] += __shfl_xor(v1[0], 32); v2[0] += __shfl_xor(v2[0], 32);
            red[wave * 64 + lane] = lane < 32 ? v1[0] : v2[0];
            LDS_WAIT(); __syncthreads();
            if (tid < 64) { float sm = 0.f;
#pragma unroll
                for (int w8 = 0; w8 < 8; ++w8) sm += red[w8 * 64 + tid];
                tot[tid] = sm; }
            LDS_WAIT(); __syncthreads();
            asm volatile("" : "+v"(c0));
            unsigned rua[34], rab[32];
#pragma unroll
            for (int j = 0; j < 34; ++j) rua[j] = *(const unsigned*)(UA + (size_t)((first && j < 2) ? t0 : t0 - 2 + j) * 1024 + c0);
#pragma unroll
            for (int j = 0; j < 32; ++j) rab[j] = *(const unsigned*)(AB + (size_t)(t0 + j) * 1024 + c0);
            const f32x2 lg = *(const f32x2*)(args.in[8] + c0), lb = *(const f32x2*)(args.in[9] + c0);
#pragma unroll
            for (int j = 0; j < 32; ++j) { const float mu = tot[j] * (1.f / 1024.f); const float var = tot[32 + j] * (1.f / 1024.f) - mu * mu; const float rstd = rsqrtf(var + EPS);
                const f32x2 y = (acc[j] - mu) * rstd * lg + lb;
                *(unsigned*)(ZZ + (size_t)(t0 + j) * 2048 + 1024 + c0) = pg8::cvt_pk_bf16(y.x * pg8::fsig(y.x), y.y * pg8::fsig(y.y)); }
            asm volatile("" : "+v"(c0));
            const f32x2 wa0 = *(const f32x2*)(cwa + c0), wa1 = *(const f32x2*)(cwa + 1024 + c0), wa2 = *(const f32x2*)(cwa + 2048 + c0);
#define BF2(w_) ((f32x2){__builtin_bit_cast(float, (w_) << 16), __builtin_bit_cast(float, (w_) & 0xffff0000u)})
            if (first) { rua[0] = 0u; rua[1] = 0u; }
#pragma unroll
            for (int j = 0; j < 32; ++j) { const f32x2 za = BF2(rab[j]) * (wa0 * BF2(rua[j]) + wa1 * BF2(rua[j + 1]) + wa2 * BF2(rua[j + 2]));
                *(unsigned*)(ZZ + (size_t)(t0 + j) * 2048 + c0) = pg8::cvt_pk_bf16(za.x, za.y); }
#undef BF2
            have_prev = true;
        }
        if (BOTH(2)) xcd_barrier(bar);
    }
    PHASE(3) {
        pg8::Gemm g{2048, 2048, 2048}; pg8::StaticOrder S; S.init(T, D, G, bx, ZZ, 2048, WabT, 2048);
        pg8::EpiMix E{GA, GB, MIX};
        pg8::gemm_phase<pg8::EpiMix, pg8::StaticOrder, true>(lds, g, S, E);
        if (BOTH(3)) xcd_barrier(bar);
    }
    PHASE(4) {
        pg8::Gemm g{1024, 1024, 1024}; pg8::StaticOrder S; S.init(T, D, G, bx, MIX, 1024, WoT, 1024);
        pg8::EpiWo E{x, APLE, ssp1};
        pg8::gemm_phase<pg8::EpiWo, pg8::StaticOrder, true>(lds, g, S, E);
        if (BOTH(4)) xcd_barrier(bar);
    }
    PHASE(5) {
        pg8::Gemm g{1280, 1024, 1024}; pg8::StaticOrder S; S.init(T, 256, G, bx, APLE + 256, 1280, WrT, 1024);
        pg8::EpiRouter E{ssp1, args.in[15], args.in[17], cnt, tok_e, tok_w, tok_pos, r1, ltok, lw, lr};
        pg8::gemm_phase<pg8::EpiRouter, pg8::StaticOrder, false>(lds, g, S, E);
        const int nidle = G > 128 ? G - 128 : G, me = G > 128 ? bx - 128 : bx;
        if (me >= 0) { const float* p = args.in[1];
            for (size_t i = (size_t)me * 512 + tid; i < (size_t)T * 64; i += (size_t)nidle * 512) { const size_t t = i >> 6; const int c = (int)(i & 63) * 4; const float4 v = *(const float4*)(p + t * PLE + c);
                uint2 o; o.x = pk2(v.x, v.y); o.y = pk2(v.z, v.w); *(uint2*)(APLE + t * APITCH + c) = o; } }
        if (BOTH(5)) xcd_barrier(bar);
    }
    PHASE(6) {
        MOE_TABLES();
        pg8::Gemm g{1280, 1024, 1024};
        pg8::MoeOrder<true> S{tab, tab[32], G, bx, (const char*)(APLE + 256), (const char*)WguT, (size_t)1024 * 1024 * 2, (size_t)256 * 1024 * 2, 1280, ltok};
        pg8::EpiMoeUp E{lr, HMID};
        pg8::gemm_phase<pg8::EpiMoeUp, pg8::MoeOrder<true>, true>(lds, g, S, E);
        if (BOTH(6)) xcd_barrier(bar);
    }
    PHASE(7) {
        MOE_TABLES();
        pg8::Gemm g{512, 512, 512};
        pg8::MoeOrder<false> S{tab, tab[32], G, bx, (const char*)HMID, (const char*)WdT, (size_t)1024 * 512 * 2, (size_t)256 * 512 * 2, 512, ltok};
        pg8::EpiMoeDown E{lw, YB};
        pg8::gemm_phase<pg8::EpiMoeDown, pg8::MoeOrder<false>, true>(lds, g, S, E);
        if (BOTH(7)) xcd_barrier(bar);
    }
    PHASE(8) {
        MOE_TABLES();
        const int gw = vcu * NWAVES + wave, NGW = G * NWAVES;
        for (int t = gw; t < T; t += NGW) {
            const int sa = tab[40 + tok_e[t * 2]] + tok_pos[t * 2], sb = tab[40 + tok_e[t * 2 + 1]] + tok_pos[t * 2 + 1];
            float s = 0.f;
#pragma unroll
            for (int j = 0; j < 2; ++j) { const int c = 8 * (lane + 64 * j);
                bf16* xp = APLE + (size_t)t * APITCH + 256 + c;
                const v4u xv = *(const v4u*)xp, ya = *(const v4u*)(YB + (size_t)sa * D + c), yb = *(const v4u*)(YB + (size_t)sb * D + c);
                v4u o;
#pragma unroll
                for (int q = 0; q < 4; ++q) { const float lo = bf2f(xv[q] & 0xffff) + bf2f(ya[q] & 0xffff) + bf2f(yb[q] & 0xffff), hi = bf2f(xv[q] >> 16) + bf2f(ya[q] >> 16) + bf2f(yb[q] >> 16);
                    s += lo * lo + hi * hi; o[q] = pk2(lo, hi); }
                *(v4u*)xp = o; }
            s = wave_sum(s);
            if (lane == 0) r2[t] = rsqrtf(s * (1.f / D) + EPS);
        }
        if (BOTH(8)) xcd_barrier(bar);
    }
    PHASE(9) {
        pg8::Gemm g{1280, 1280, 1280}; pg8::StaticOrder S; S.init(T, D, G, bx, APLE, 1280, WpleT, 1280);
        pg8::EpiPle E{APLE, r2, X3, ssp3, (pg8::u32x2*)(ws + WS_SCR + (size_t)bx * 131072)};
        pg8::gemm_phase<pg8::EpiPle, pg8::StaticOrder, true>(lds, g, S, E);
        if (BOTH(9)) xcd_barrier(bar);
    }
    PHASE(10) {
        const int gw = vcu * NWAVES + wave, NGW = G * NWAVES; const float* gfin = args.in[24];
        for (int row = gw; row < T; row += NGW) {
            float ss = lane < 16 ? ssp3[(size_t)row * 16 + lane] : 0.f; ss = wave_sum(ss);
            const float r = rsqrtf(ss * (1.f / D) + EPS);
#pragma unroll
            for (int j = 0; j < 4; ++j) { const int c = 4 * (lane + 64 * j); const uint2 w = *(const uint2*)(X3 + (size_t)row * D + c); const float4 gg = *(const float4*)(gfin + c);
                *(float4*)(args.out + (size_t)row * D + c) = make_float4(bf2f(w.x & 0xffff) * r * gg.x, bf2f(w.x >> 16) * r * gg.y, bf2f(w.y & 0xffff) * r * gg.z, bf2f(w.y >> 16) * r * gg.w); }
        }
    }
#undef MOE_TABLES
#undef IN
#undef BOTH
}

#ifndef OPT_UPTO
#define OPT_UPTO 11
#endif
extern "C" void kernel_launch(void* const* d_in, const int* in_sizes, int n_in, void* d_out, int out_size, void* d_ws, size_t ws_size, hipStream_t stream) {
    static int grid = 0;
    if (grid == 0) {
        if (n_in != 25 || in_sizes[0] != T * D || out_size != T * D || ws_size < WS_END2) { fprintf(stderr, "kernel_launch: unexpected shapes (n_in %d, in0 %d, out %d, ws %zu)\n", n_in, n_in > 0 ? in_sizes[0] : -1, out_size, ws_size); grid = -1; return; }
        int dev = 0, cus = 0, per_cu = 0;
        if (hipGetDevice(&dev) != hipSuccess || hipDeviceGetAttribute(&cus, hipDeviceAttributeMultiprocessorCount, dev) != hipSuccess) { fprintf(stderr, "kernel_launch: device query failed\n"); grid = -1; return; }
        if (hipFuncSetAttribute((const void*)mega, hipFuncAttributeMaxDynamicSharedMemorySize, LDS_BYTES) != hipSuccess) { fprintf(stderr, "kernel_launch: hipFuncSetAttribute failed\n"); grid = -1; return; }
        if (hipOccupancyMaxActiveBlocksPerMultiprocessor(&per_cu, (const void*)mega, NWAVES * 64, LDS_BYTES) != hipSuccess || per_cu < 1) { fprintf(stderr, "kernel_launch: occupancy query says %d blocks per CU\n", per_cu); (void)hipGetLastError(); grid = -1; return; }
        grid = cus;
    }
    if (grid < 0) return;
    const float* x = (const float*)d_in[0]; const float* p = (const float*)d_in[1];
    const float* conv_a_w = (const float*)d_in[4]; const float* w_out_a = (const float*)d_in[5]; const float* conv_b_w = (const float*)d_in[6]; const float* conv_b_b = (const float*)d_in[7];
    const float* ln_b_g = (const float*)d_in[8]; const float* ln_b_b = (const float*)d_in[9]; const float* w_out_b = (const float*)d_in[10];
    const float* w_o = (const float*)d_in[12]; const float* ffn_g = (const float*)d_in[13]; const float* w_rg = (const float*)d_in[14]; const float* b_rg = (const float*)d_in[15];
    const float* w_re = (const float*)d_in[16]; const float* b_re = (const float*)d_in[17]; const float* w_eg = (const float*)d_in[18]; const float* w_eu = (const float*)d_in[19];
    const float* w_ed = (const float*)d_in[20]; const float* ple_g = (const float*)d_in[21]; const float* w_pg = (const float*)d_in[22]; const float* w_pp = (const float*)d_in[23];
    const float* fin_g = (const float*)d_in[24];
    unsigned char* ws = (unsigned char*)d_ws; float* out = (float*)d_out;
    unsigned* ctl = (unsigned*)(ws + WS_CTL);
    int* tok_e = (int*)(ws + WS_TOK); float* tok_w = (float*)(ws + WS_TOK + 256 * 1024); int* tok_pos = (int*)(ws + WS_TOK + 512 * 1024);
    float* r1 = (float*)(ws + WS_TOK + 768 * 1024); float* r2 = (float*)(ws + WS_TOK + 896 * 1024);
    float* ssp1 = (float*)(ws + WS_SSP1); int* ltok = (int*)(ws + WS_LTOK); float* lw = (float*)(ws + WS_LW);
    bf16* UA = (bf16*)(ws + WS_RA); bf16* UB = (bf16*)(ws + WS_RB); bf16* AB = (bf16*)(ws + WS_RC); bf16* GA = (bf16*)(ws + WS_RD); bf16* GB = (bf16*)(ws + WS_RE);
    bf16* ZZ = (bf16*)d_out; bf16* MIX = (bf16*)(ws + WS_RC); float* X1 = (float*)(ws + WS_RA); bf16* APLE = (bf16*)(ws + WS_RA);
    bf16* HMID = (bf16*)(ws + WS_RC); bf16* YB = (bf16*)(ws + WS_RD); float* X3 = (float*)(ws + WS_RC);

    if (hipMemsetAsync(ws + WS_CTL, 0, 1 * MiB, stream) != hipSuccess) { fprintf(stderr, "kernel_launch: memset failed\n"); return; }
    Args a{};
    for (int i = 0; i < 25; ++i) a.in[i] = (const float*)d_in[i];
    a.out = out; a.ws = ws; a.ph_lo = 0; a.ph_hi = OPT_UPTO;
    void* kargs[] = {&a};
    const hipError_t le = hipLaunchCooperativeKernel((const void*)mega, dim3(grid), dim3(NWAVES * 64), kargs, LDS_BYTES, stream);
    if (le != hipSuccess) { fprintf(stderr, "kernel_launch: cooperative launch failed: %s (grid %d)\n", hipGetErrorString(le), grid); return; }
#if OPT_UPTO < 11
    if (OPT_UPTO <= 1) nv_inproj<<<dim3(T / 8, 4), 256, 0, stream>>>((const bf16*)d_out, (const float*)d_in[3], (const float*)d_in[11], UA, UB, AB, GA, GB);
    if (OPT_UPTO <= 2) nv_conv<<<T, 256, 0, stream>>>(UA, UB, AB, conv_a_w, conv_b_w, conv_b_b, ln_b_g, ln_b_b, ZZ);
    if (OPT_UPTO <= 3) nv_outab<<<dim3(T / 8, 4), 256, 0, stream>>>(ZZ, w_out_a, w_out_b, GA, GB, MIX);
    if (OPT_UPTO <= 4) { nv_wo<<<dim3(T / 8, 4), 256, 0, stream>>>(MIX, w_o, x, X1, APLE); nv_rowss<<<T / 4, 256, 0, stream>>>(X1, ssp1); }
    if (OPT_UPTO <= 5) { nv_router<<<T / 4, 256, 0, stream>>>(X1, ssp1, ffn_g, w_rg, b_rg, w_re, b_re, ctl + CW_CNT, tok_e, tok_w, tok_pos, r1, ltok, lw); nv_pcvt<<<T * PLE / 4 / 256, 256, 0, stream>>>(p, APLE); }
    if (OPT_UPTO <= 6) nv_moe_up<<<dim3(T / 8, NE), 256, 0, stream>>>(X1, r1, ffn_g, w_eg, w_eu, ctl + CW_CNT, ltok, HMID);
    if (OPT_UPTO <= 7) nv_moe_down<<<dim3(T / 8, NE), 256, 0, stream>>>(HMID, w_ed, ctl + CW_CNT, lw, YB);
    if (OPT_UPTO <= 8) nv_combine<<<T / 4, 256, 0, stream>>>(X1, YB, ctl + CW_CNT, tok_e, tok_pos, APLE, r2);
    if (OPT_UPTO <= 9) nv_ple<<<dim3(T / 8, 4), 256, 0, stream>>>(X1, r2, ple_g, w_pg, p, w_pp, X3);
    if (OPT_UPTO <= 10) nv_final<<<T / 4, 256, 0, stream>>>(X3, fin_g, out);
#endif
}
```

```cpp
#include <hip/hip_runtime.h>
#include <cstdio>
#include <cstdint>

typedef unsigned short bf16;
constexpr int T = 32768, D = 1024, SEQ = 2048, PLE = 256, NE = 32, NG = 4, EPG = 8, DE = 512, INC = 7168;
constexpr float EPS = 1e-6f;
constexpr size_t MiB = 1u << 20;
constexpr size_t WS_CTL = 0;
constexpr size_t WS_TOK = 1 * MiB;
constexpr size_t WS_SSP1 = 2 * MiB;
constexpr size_t WS_SSP3 = 4 * MiB;
constexpr size_t WS_LTOK = 6 * MiB;
constexpr size_t WS_LW = 136 * MiB;
constexpr size_t WS_RA = 144 * MiB, WS_RB = 208 * MiB, WS_RC = 272 * MiB, WS_RD = 336 * MiB, WS_RE = 400 * MiB;
constexpr size_t WS_END = 464 * MiB;
constexpr int APITCH = 1280;
constexpr int CW_CNT = 64;

__device__ __forceinline__ unsigned f2bf(float f) { unsigned u = __builtin_bit_cast(unsigned, f); return (u + 0x7fffu + ((u >> 16) & 1u)) >> 16; }
__device__ __forceinline__ float bf2f(unsigned short b) { return __builtin_bit_cast(float, (unsigned)b << 16); }
__device__ __forceinline__ float sigmoidf_(float v) { return 1.f / (1.f + __expf(-v)); }
__device__ __forceinline__ float siluf_(float v) { return v / (1.f + __expf(-v)); }
__device__ __forceinline__ float wave_sum(float v) {
#pragma unroll
    for (int o = 1; o < 64; o <<= 1) v += __shfl_xor(v, o);
    return v;
}

#define REP_MASK 0
#define OPT_UPTO 11
namespace pg8 {
#define PG8_LAS __attribute__((address_space(3)))
typedef unsigned short bf16_t;
typedef short bf16x8 __attribute__((ext_vector_type(8)));
typedef float f32x4 __attribute__((ext_vector_type(4)));
typedef unsigned u32x4 __attribute__((ext_vector_type(4)));
typedef unsigned u32x2 __attribute__((ext_vector_type(2)));
constexpr int BM = 256, BK = 64, HALF = 128, HTB = HALF * BK * 2, STAGE_BYTES = 8 * HTB, NXCD = 8, WGM = 8;
__host__ __device__ __forceinline__ int lds_byte(int r, int c) { const int st = (r >> 4) * 2 + (c >> 5), rr = r & 15, cc = c & 31, ob = rr * 64 + cc * 2; return st * 1024 + (ob ^ (((ob >> 9) & 1) << 5)); }
__host__ __device__ __forceinline__ void stage_rc(int b, int& R, int& C) { const int st = b / 1024, sb = b % 1024, swz = sb ^ (((sb >> 9) & 1) << 5); R = (st >> 1) * 16 + swz / 64; C = (st & 1) * 32 + (swz % 64) / 2; }
__host__ __device__ __forceinline__ int perm32(int rho) { const int n = rho >> 4, i = rho & 15; return 8 * (i >> 2) + 4 * n + (i & 3); }

struct Unit { int pm, pn, e, nrow, slot0; };
struct Gemm { int lda, ldb, K; };

__device__ __forceinline__ unsigned cvt_pk_bf16(float lo, float hi) { unsigned r; asm volatile("v_cvt_pk_bf16_f32 %0, %1, %2" : "=v"(r) : "v"(lo), "v"(hi)); return r; }
__device__ __forceinline__ float fsig(float v) { return __builtin_amdgcn_rcpf(1.f + __expf(-v)); }
__device__ __forceinline__ f32x4 sig4(f32x4 v) { return (f32x4){fsig(v[0]), fsig(v[1]), fsig(v[2]), fsig(v[3])}; }
__device__ __forceinline__ f32x4 bfx4(u32x2 w) { return (f32x4){__builtin_bit_cast(float, w.x << 16), __builtin_bit_cast(float, w.x & 0xffff0000u), __builtin_bit_cast(float, w.y << 16), __builtin_bit_cast(float, w.y & 0xffff0000u)}; }

struct StaticOrder {
    static constexpr bool GATHER = false;
    int nM, nN, nwg, G, c; const char* A; const char* Bt; size_t atile, btile;
    __device__ __forceinline__ void init(int M, int N, int G_, int c_, const void* A_, int lda, const void* Bt_, int ldb) { nM = M / BM; nN = N / BM; nwg = nM * nN; G = G_; c = c_; A = (const char*)A_; Bt = (const char*)Bt_; atile = (size_t)BM * lda * 2; btile = (size_t)BM * ldb * 2; }
    __device__ __forceinline__ bool next(int i, Unit& u) const {
        const long L = (long)i * G + c; if (L >= nwg) return false;
        int wgid = (int)L; { const int q = nwg / NXCD, r = nwg % NXCD, xcd = wgid % NXCD, off = wgid / NXCD; wgid = (xcd < r ? xcd * (q + 1) : r * (q + 1) + (xcd - r) * q) + off; }
        const int nig = WGM * nN, gid = wgid / nig, fm = gid * WGM, gsz = (nM - fm) < WGM ? (nM - fm) : WGM;
        u.pm = fm + ((wgid % nig) % gsz); u.pn = (wgid % nig) / gsz; u.e = 0; u.nrow = 256; u.slot0 = 0; return true;
    }
    __device__ __forceinline__ void ptrs(const Unit& u, const char*& cA, const char*& cB) const { cA = A + (size_t)u.pm * atile; cB = Bt + (size_t)u.pn * btile; }
    __device__ __forceinline__ void rows(const Unit&, const int (&)[2], const int (&)[2], unsigned (&)[2][2]) const {}
};

typedef int v4i_t __attribute__((ext_vector_type(4)));
typedef int v8i_t __attribute__((ext_vector_type(8)));
__device__ __forceinline__ v8i_t cat8(bf16x8 lo, bf16x8 hi) { const v4i_t l = __builtin_bit_cast(v4i_t, lo), h = __builtin_bit_cast(v4i_t, hi); return __builtin_shufflevector(l, h, 0, 1, 2, 3, 4, 5, 6, 7); }
__device__ __forceinline__ void mfma8(f32x4& acc, v8i_t b, v8i_t a, int one) {
    asm volatile("s_nop 1\n\tv_mfma_scale_f32_16x16x128_f8f6f4 %0, %1, %2, %0, %3, %3 op_sel_hi:[0,0,0]" : "+v"(acc) : "v"(b), "v"(a), "v"(one));
}
#define MFMA_DRAIN() asm volatile("s_nop 15\n\ts_nop 7" ::: "memory")
template <class Epi, class Sched, bool ALIGN_EPI, bool FP8 = false>
__device__ __forceinline__ void gemm_phase(PG8_LAS unsigned char* lds, const Gemm g, const Sched& S, const Epi& E) {
    const int tid = threadIdx.x, wid = __builtin_amdgcn_readfirstlane(tid >> 6), lane = tid & 63, wr = wid >> 2, wc = wid & 3, fr = lane & 15, fq = lane >> 4;
    const int K = g.K, nt = K / BK;
    int Rr[2], Cc[2]; unsigned vA[2][2], vN[2][2], voffB[2];
#pragma unroll
    for (int i = 0; i < 2; ++i) { int R, C; stage_rc(tid * 16 + i * 8192, R, C); Rr[i] = R; Cc[i] = C; const int Rb = Epi::PERM ? ((R & ~31) + perm32(R & 31)) : R;
        voffB[i] = (unsigned)(Rb * g.ldb + C) * 2u; vA[0][i] = (unsigned)(R * g.lda + C) * 2u; vA[1][i] = (unsigned)((R + HALF) * g.lda + C) * 2u; vN[0][i] = vA[0][i]; vN[1][i] = vA[1][i]; }
    const size_t kstep = (size_t)(BK * 2);
    const size_t hstepB = (size_t)HALF * g.ldb * 2;
    const unsigned ldsw = (unsigned)wid * 1024u;
    const int aoff = FP8 ? lds_byte(wr * 64 + fr, fq * 16) : lds_byte(wr * 64 + fr, fq * 8), boff = FP8 ? lds_byte(wc * 32 + fr, fq * 16) : lds_byte(wc * 32 + fr, fq * 8);
    constexpr int kstr = FP8 ? 16 : 1024;
#define PG8_SA(b, h) (((b) * 2 + (h)) * HTB)
#define PG8_SB(b, h) ((4 + (b) * 2 + (h)) * HTB)
#define PG8_STAGE(bufoff, gbase, voff) do { _Pragma("unroll") for (int _i = 0; _i < 2; ++_i) \
        __builtin_amdgcn_global_load_lds((const unsigned*)((const char*)(gbase) + (voff)[_i]), (PG8_LAS unsigned*)(lds + (bufoff) + ldsw + _i * 8192), 16, 0, 0); } while (0)
#define PG8_LDA(dst, b, h) do { _Pragma("unroll") for (int m = 0; m < 4; ++m) _Pragma("unroll") for (int k = 0; k < 2; ++k) dst[m][k] = *(const PG8_LAS bf16x8*)(lds + PG8_SA(b, h) + aoff + m * 2048 + k * kstr); } while (0)
#define PG8_LDB(dst, b, h) do { _Pragma("unroll") for (int n = 0; n < 2; ++n) _Pragma("unroll") for (int k = 0; k < 2; ++k) dst[n][k] = *(const PG8_LAS bf16x8*)(lds + PG8_SB(b, h) + boff + n * 2048 + k * kstr); } while (0)
#define PG8_MMA(ai, bj, At, Bt) do { __builtin_amdgcn_s_setprio(1); _Pragma("unroll") for (int m = 0; m < 4; ++m) _Pragma("unroll") for (int n = 0; n < 2; ++n) { \
        if constexpr (FP8) mfma8(acc[ai][bj][m][n], cat8(Bt[n][0], Bt[n][1]), cat8(At[m][0], At[m][1]), one8); \
        else { _Pragma("unroll") for (int k = 0; k < 2; ++k) acc[ai][bj][m][n] = __builtin_amdgcn_mfma_f32_16x16x32_bf16(Bt[n][k], At[m][k], acc[ai][bj][m][n], 0, 0, 0); } } \
        __builtin_amdgcn_s_setprio(0); } while (0)
#define PG8_WAIT_V(n) asm volatile("s_waitcnt vmcnt(" #n ")" ::: "memory")
#define PG8_WAIT_L(n) asm volatile("s_waitcnt lgkmcnt(" #n ")" ::: "memory")
#define PG8_BAR __builtin_amdgcn_s_barrier()
#define PG8_SCHED __builtin_amdgcn_sched_barrier(0)
    int one8 = 0x7f7f7f7f; asm volatile("" : "+v"(one8));
    Unit cur, nxt; int ui = 0;
    if (!S.next(0, cur)) return;
    f32x4 acc[2][2][4][2];
#pragma unroll
    for (int a = 0; a < 2; ++a)
#pragma unroll
        for (int b = 0; b < 2; ++b)
#pragma unroll
            for (int m = 0; m < 4; ++m)
#pragma unroll
                for (int n = 0; n < 2; ++n) acc[a][b][m][n] = (f32x4){0.f, 0.f, 0.f, 0.f};
    bf16x8 At[4][2], B0[2][2], B1[2][2];
    const char* cA; const char* cB; S.ptrs(cur, cA, cB);
    if constexpr (Sched::GATHER) S.rows(cur, Rr, Cc, vA);
    PG8_STAGE(PG8_SB(0, 0), cB, voffB); PG8_STAGE(PG8_SB(0, 1), cB + hstepB, voffB); PG8_STAGE(PG8_SA(0, 0), cA, vA[0]); PG8_STAGE(PG8_SA(0, 1), cA, vA[1]);
    if (wr == 1) PG8_BAR;
    PG8_WAIT_V(2); PG8_BAR;
    PG8_STAGE(PG8_SB(1, 0), cB + kstep, voffB); PG8_STAGE(PG8_SA(1, 0), cA + kstep, vA[0]); PG8_STAGE(PG8_SB(1, 1), cB + hstepB + kstep, voffB);
    PG8_WAIT_V(6); PG8_BAR;
    for (;;) {
        const bool has_next = S.next(ui + 1, nxt);
        const char* nA = cA; const char* nB = cB;
        if (has_next) { S.ptrs(nxt, nA, nB); if constexpr (Sched::GATHER) S.rows(nxt, Rr, Cc, vN); }
        else { if constexpr (Sched::GATHER) {
#pragma unroll
            for (int h = 0; h < 2; ++h)
#pragma unroll
                for (int i = 0; i < 2; ++i) vN[h][i] = vA[h][i]; } }
        for (int t = 0; t < nt; t += 2) {
            const bool last = (t == nt - 2);
            if constexpr (Epi::MID_T > 0) { if (t == Epi::MID_T) E.mid(acc, cur, wr, wc, fr, fq); }
            const char* a1 = cA + (size_t)(t + 1) * kstep;
            const char* a2 = last ? nA : cA + (size_t)(t + 2) * kstep; const char* b2 = last ? nB : cB + (size_t)(t + 2) * kstep;
            const char* a3 = a2 + kstep; const char* b3 = b2 + kstep;
            PG8_LDB(B0, 0, 0); PG8_LDB(B1, 0, 1); PG8_SCHED; PG8_LDA(At, 0, 0); PG8_STAGE(PG8_SA(1, 1), a1, vA[1]);
            PG8_WAIT_V(8); PG8_WAIT_L(0); PG8_BAR; PG8_MMA(0, 0, At, B0); PG8_MMA(0, 1, At, B1); PG8_BAR; PG8_SCHED;
            if constexpr (Sched::GATHER) { if (last) {
#pragma unroll
                for (int h = 0; h < 2; ++h)
#pragma unroll
                    for (int i = 0; i < 2; ++i) vA[h][i] = vN[h][i]; } }
            PG8_LDA(At, 0, 1); PG8_STAGE(PG8_SB(0, 0), b2, voffB); PG8_STAGE(PG8_SB(0, 1), b2 + hstepB, voffB); PG8_STAGE(PG8_SA(0, 0), a2, vA[0]);
            PG8_WAIT_V(8); PG8_WAIT_L(0); PG8_BAR; PG8_MMA(1, 0, At, B0); PG8_MMA(1, 1, At, B1); PG8_BAR; PG8_SCHED;
            PG8_LDB(B0, 1, 0); PG8_LDB(B1, 1, 1); PG8_SCHED; PG8_LDA(At, 1, 0); PG8_STAGE(PG8_SA(0, 1), a2, vA[1]);
            PG8_WAIT_V(8); PG8_WAIT_L(0); PG8_BAR; PG8_MMA(0, 0, At, B0); PG8_MMA(0, 1, At, B1); PG8_BAR; PG8_SCHED;
            PG8_LDA(At, 1, 1); PG8_STAGE(PG8_SB(1, 0), b3, voffB); PG8_STAGE(PG8_SB(1, 1), b3 + hstepB, voffB); PG8_STAGE(PG8_SA(1, 0), a3, vA[0]);
            PG8_WAIT_V(8); PG8_WAIT_L(0); PG8_BAR; PG8_MMA(1, 0, At, B0); PG8_MMA(1, 1, At, B1); PG8_BAR; PG8_SCHED;
        }
        if constexpr (ALIGN_EPI) { if (wr == 0) PG8_BAR; }
        if constexpr (FP8) MFMA_DRAIN();
        if constexpr (!Epi::AFTER_DRAIN) { E(acc, cur, wr, wc, fr, fq); }
        if (!has_next) break;
#pragma unroll
        for (int a = 0; a < 2; ++a)
#pragma unroll
            for (int b = 0; b < 2; ++b)
#pragma unroll
                for (int m = 0; m < 4; ++m)
#pragma unroll
                    for (int n = 0; n < 2; ++n) acc[a][b][m][n] = (f32x4){0.f, 0.f, 0.f, 0.f};
        cur = nxt; cA = nA; cB = nB; ++ui;
        if constexpr (ALIGN_EPI) { if (wr == 1) PG8_BAR; }
    }
    PG8_WAIT_V(0);
    if constexpr (!ALIGN_EPI) { if (wr == 0) PG8_BAR; }
    PG8_BAR;
    if constexpr (Epi::AFTER_DRAIN) { E.fused(acc, cur, wr, wc, fr, fq, lds, wid, lane); }
#undef PG8_SA
#undef PG8_SB
#undef PG8_STAGE
#undef PG8_LDA
#undef PG8_LDB
#undef PG8_MMA
#undef PG8_WAIT_V
#undef PG8_WAIT_L
#undef PG8_BAR
#undef PG8_SCHED
}

struct EpiInProj {
    static constexpr bool PERM = true, AFTER_DRAIN = false; static constexpr int MID_T = 0;
    bf16_t* R0; size_t rs; const float* b_gate; int skip;
    __device__ __forceinline__ void operator()(const f32x4 (&acc)[2][2][4][2], const Unit& u, int wr, int wc, int fr, int fq) const {
        const int row0 = u.pm * BM + wr * 64 + fr, cc = wc * 32 + 8 * fq;
        if (skip) return;
        if (u.pn < 16) {
            const bool sg = u.pn >= 8; bf16_t* O = R0 + (size_t)(sg ? 1 : 0) * rs + (u.pn & 7) * 128 + cc;
#pragma unroll
            for (int ai = 0; ai < 2; ++ai)
#pragma unroll
                for (int m = 0; m < 4; ++m) {
                    f32x4 b0 = acc[ai][1][m][0], b1 = acc[ai][1][m][1];
                    if (sg) { b0 = sig4(b0); b1 = sig4(b1); }
                    const f32x4 v0 = acc[ai][0][m][0] * b0, v1 = acc[ai][0][m][1] * b1;
                    u32x4 w; w.x = cvt_pk_bf16(v0[0], v0[1]); w.y = cvt_pk_bf16(v0[2], v0[3]); w.z = cvt_pk_bf16(v1[0], v1[1]); w.w = cvt_pk_bf16(v1[2], v1[3]);
                    *(u32x4*)(O + (size_t)(row0 + ai * HALF + m * 16) * 1024) = w; }
        } else {
            const int sec = (u.pn - 16) >> 2, ct = ((u.pn - 16) & 3) * 256 + cc;
            bf16_t* O = R0 + (size_t)(2 + sec) * rs + ct;
            f32x4 bv[2][2];
#pragma unroll
            for (int bj = 0; bj < 2; ++bj)
#pragma unroll
                for (int n = 0; n < 2; ++n) bv[bj][n] = sec ? *(const f32x4*)(b_gate + (sec - 1) * 1024 + ct + bj * HALF + 4 * n) : (f32x4){0.f, 0.f, 0.f, 0.f};
#pragma unroll
            for (int ai = 0; ai < 2; ++ai)
#pragma unroll
                for (int m = 0; m < 4; ++m)
#pragma unroll
                    for (int bj = 0; bj < 2; ++bj) {
                        f32x4 v0 = acc[ai][bj][m][0] + bv[bj][0], v1 = acc[ai][bj][m][1] + bv[bj][1];
                        if (sec) { v0 = sig4(v0); v1 = sig4(v1); }
                        u32x4 w; w.x = cvt_pk_bf16(v0[0], v0[1]); w.y = cvt_pk_bf16(v0[2], v0[3]); w.z = cvt_pk_bf16(v1[0], v1[1]); w.w = cvt_pk_bf16(v1[2], v1[3]);
                        *(u32x4*)(O + (size_t)(row0 + ai * HALF + m * 16) * 1024 + bj * HALF) = w; }
        }
    }
};

struct EpiMix {
    static constexpr bool PERM = true, AFTER_DRAIN = false; static constexpr int MID_T = 16;
    const bf16_t *GA, *GB; bf16_t* MIX;
    __device__ __forceinline__ void mid(f32x4 (&acc)[2][2][4][2], const Unit& u, int wr, int wc, int fr, int fq) const {
        int row0 = u.pm * BM + wr * 64 + fr, col0 = u.pn * BM + wc * 32 + 8 * fq;
        asm volatile("" : "+v"(row0), "+v"(col0));
#pragma unroll
        for (int ai = 0; ai < 2; ++ai)
#pragma unroll
            for (int m = 0; m < 4; ++m)
#pragma unroll
                for (int bj = 0; bj < 2; ++bj) { const size_t o = (size_t)(row0 + ai * HALF + m * 16) * 1024 + col0 + bj * HALF;
                    const u32x4 ga = *(const u32x4*)(GA + o), gb = *(const u32x4*)(GB + o);
                    const f32x4 a0 = bfx4((u32x2){ga.x, ga.y}), a1 = bfx4((u32x2){ga.z, ga.w}), b0 = bfx4((u32x2){gb.x, gb.y}), b1 = bfx4((u32x2){gb.z, gb.w});
#pragma unroll
                    for (int j = 0; j < 4; ++j) { acc[ai][bj][m][0][j] *= a0[j] * __builtin_amdgcn_rcpf(b0[j]); acc[ai][bj][m][1][j] *= a1[j] * __builtin_amdgcn_rcpf(b1[j]); }
                    asm volatile("" : "+v"(acc[ai][bj][m][0]), "+v"(acc[ai][bj][m][1]) :: "memory"); }
    }
    __device__ __forceinline__ void operator()(const f32x4 (&acc)[2][2][4][2], const Unit& u, int wr, int wc, int fr, int fq) const {
        const int row0 = u.pm * BM + wr * 64 + fr, col0 = u.pn * BM + wc * 32 + 8 * fq;
#pragma unroll
        for (int ai = 0; ai < 2; ++ai)
#pragma unroll
            for (int m = 0; m < 4; ++m)
#pragma unroll
                for (int bj = 0; bj < 2; ++bj) { const size_t o = (size_t)(row0 + ai * HALF + m * 16) * 1024 + col0 + bj * HALF;
                    const u32x4 gb = *(const u32x4*)(GB + o);
                    const f32x4 v0 = acc[ai][bj][m][0] * bfx4((u32x2){gb.x, gb.y}), v1 = acc[ai][bj][m][1] * bfx4((u32x2){gb.z, gb.w});
                    u32x4 w; w.x = cvt_pk_bf16(v0[0], v0[1]); w.y = cvt_pk_bf16(v0[2], v0[3]); w.z = cvt_pk_bf16(v1[0], v1[1]); w.w = cvt_pk_bf16(v1[2], v1[3]);
                    *(u32x4*)(MIX + o) = w; asm volatile("" ::: "memory"); }
    }
};
__device__ __forceinline__ unsigned cvt4_fp8(float a, float b, float c, float d) { int w = __builtin_amdgcn_cvt_pk_fp8_f32(a, b, 0, false); w = __builtin_amdgcn_cvt_pk_fp8_f32(c, d, w, true); return (unsigned)w; }
struct EpiWo {
    static constexpr bool PERM = true, AFTER_DRAIN = false; static constexpr int MID_T = 0;
    const float* x; bf16_t* APLE; unsigned char* X8; float* ssp;
    __device__ __forceinline__ void operator()(const f32x4 (&acc)[2][2][4][2], const Unit& u, int wr, int wc, int fr, int fq) const {
        const int row0 = u.pm * BM + wr * 64 + fr, col0 = u.pn * BM + wc * 32 + 8 * fq;
#pragma unroll
        for (int ai = 0; ai < 2; ++ai)
#pragma unroll
            for (int m = 0; m < 4; ++m) { const int row = row0 + ai * HALF + m * 16; float ss = 0.f;
#pragma unroll
                for (int bj = 0; bj < 2; ++bj) { const size_t o = (size_t)row * 1024 + col0 + bj * HALF;
                    const f32x4 v0 = *(const f32x4*)(x + o) + acc[ai][bj][m][0], v1 = *(const f32x4*)(x + o + 4) + acc[ai][bj][m][1];
                    ss += ((v0[0] * v0[0] + v0[1] * v0[1]) + (v0[2] * v0[2] + v0[3] * v0[3])) + ((v1[0] * v1[0] + v1[1] * v1[1]) + (v1[2] * v1[2] + v1[3] * v1[3]));
                    u32x4 w; w.x = cvt_pk_bf16(v0[0], v0[1]); w.y = cvt_pk_bf16(v0[2], v0[3]); w.z = cvt_pk_bf16(v1[0], v1[1]); w.w = cvt_pk_bf16(v1[2], v1[3]);
                    *(u32x4*)(APLE + (size_t)row * 1280 + 256 + col0 + bj * HALF) = w;
                    u32x2 q; q.x = cvt4_fp8(v0[0], v0[1], v0[2], v0[3]); q.y = cvt4_fp8(v1[0], v1[1], v1[2], v1[3]);
                    *(u32x2*)(X8 + o) = q; }
                ss += __shfl_xor(ss, 16); ss += __shfl_xor(ss, 32);
                if (fq == 0) ssp[(size_t)row * 16 + u.pn * 4 + wc] = ss; }
    }
};
struct EpiRouter {
    static constexpr bool PERM = false, AFTER_DRAIN = true; static constexpr int MID_T = 0;
    const float* ssp1; const float* brg; const float* bre; unsigned* cnt; int* tok_e; float* tok_w; int* tok_pos; float* r1; int* ltok; float* lw; float* lr;
    __device__ __forceinline__ void fused(f32x4 (&acc)[2][2][4][2], const Unit& u, int wr, int wc, int fr, int fq, PG8_LAS unsigned char* lds, int wid, int lane) const {
        PG8_LAS float* L = (PG8_LAS float*)lds;
        PG8_LAS int* hist = (PG8_LAS int*)(lds + 40960);
        const int tid = wid * 64 + lane;
        if (tid < 64) hist[tid] = 0;
        if (wc == 0) {
#pragma unroll
            for (int ai = 0; ai < 2; ++ai)
#pragma unroll
                for (int m = 0; m < 4; ++m)
#pragma unroll
                    for (int n = 0; n < 2; ++n) *(PG8_LAS f32x4*)(L + (ai * HALF + wr * 64 + m * 16 + fr) * 40 + 16 * n + 4 * fq) = acc[ai][0][m][n];
        } else if (wc == 1 && fq == 0) {
#pragma unroll
            for (int ai = 0; ai < 2; ++ai)
#pragma unroll
                for (int m = 0; m < 4; ++m) *(PG8_LAS f32x4*)(L + (ai * HALF + wr * 64 + m * 16 + fr) * 40 + 32) = acc[ai][0][m][0];
        }
        asm volatile("s_waitcnt lgkmcnt(0)" ::: "memory"); __builtin_amdgcn_s_barrier(); asm volatile("" ::: "memory");
        int ea = 0, eb = 0, la = 0, lb = 0; float wa_ = 0.f, wb_ = 0.f, r = 0.f; const int t = u.pm * BM + tid;
        if (tid < 256) {
            float ss = 0.f;
#pragma unroll
            for (int i = 0; i < 16; i += 4) { const f32x4 pv = *(const f32x4*)(ssp1 + (size_t)t * 16 + i); ss += (pv[0] + pv[1]) + (pv[2] + pv[3]); }
            r = rsqrtf(ss * (1.f / 1024.f) + 1e-6f);
            float lg[40];
#pragma unroll
            for (int i = 0; i < 36; i += 4) { const f32x4 v = *(const PG8_LAS f32x4*)(L + tid * 40 + i); lg[i] = v[0]; lg[i + 1] = v[1]; lg[i + 2] = v[2]; lg[i + 3] = v[3]; }
            float gl[4]; int grp = 0;
#pragma unroll
            for (int i = 0; i < 4; ++i) gl[i] = lg[i] * r + brg[i];
            float gm = gl[0];
#pragma unroll
            for (int i = 1; i < 4; ++i) if (gl[i] > gm) { gm = gl[i]; grp = i; }
            float den = 0.f;
#pragma unroll
            for (int i = 0; i < 4; ++i) den += __expf(gl[i] - gm);
            const float pg = 1.f / den;
            float el[8];
#pragma unroll
            for (int i = 0; i < 8; ++i) { float v = 0.f;
#pragma unroll
                for (int g2 = 0; g2 < 4; ++g2) v = (grp == g2) ? lg[4 + g2 * 8 + i] * r + bre[g2 * 8 + i] : v;
                el[i] = v; }
            int i0 = 0; float v0 = el[0];
#pragma unroll
            for (int i = 1; i < 8; ++i) if (el[i] > v0) { v0 = el[i]; i0 = i; }
            int i1 = -1; float v1 = -3.0e38f;
#pragma unroll
            for (int i = 0; i < 8; ++i) if (i != i0 && el[i] > v1) { v1 = el[i]; i1 = i; }
            const float e1 = __expf(v1 - v0); const float s0 = 1.f / (1.f + e1), s1 = e1 / (1.f + e1);
            ea = grp * 8 + i0; eb = grp * 8 + i1; wa_ = s0 * pg; wb_ = s1 * pg;
            la = __hip_atomic_fetch_add(&hist[ea], 1, __ATOMIC_RELAXED, __HIP_MEMORY_SCOPE_WORKGROUP); lb = __hip_atomic_fetch_add(&hist[eb], 1, __ATOMIC_RELAXED, __HIP_MEMORY_SCOPE_WORKGROUP);
        }
        asm volatile("s_waitcnt lgkmcnt(0)" ::: "memory"); __builtin_amdgcn_s_barrier(); asm volatile("" ::: "memory");
        if (tid < 32) { const int h = hist[tid]; hist[32 + tid] = h ? (int)atomicAdd(cnt + tid, (unsigned)h) : 0; }
        asm volatile("s_waitcnt vmcnt(0) lgkmcnt(0)" ::: "memory"); __builtin_amdgcn_s_barrier(); asm volatile("" ::: "memory");
        if (tid < 256) {
            const int pa = hist[32 + ea] + la, pb = hist[32 + eb] + lb;
            tok_e[t * 2] = ea; tok_e[t * 2 + 1] = eb; tok_w[t * 2] = wa_; tok_w[t * 2 + 1] = wb_; tok_pos[t * 2] = pa; tok_pos[t * 2 + 1] = pb; r1[t] = r;
            ltok[(size_t)ea * 32768 + pa] = t; lw[(size_t)ea * 32768 + pa] = wa_; lr[(size_t)ea * 32768 + pa] = r;
            ltok[(size_t)eb * 32768 + pb] = t; lw[(size_t)eb * 32768 + pb] = wb_; lr[(size_t)eb * 32768 + pb] = r;
        }
    }
};
template <bool GATHER_> struct MoeOrder {
    static constexpr bool GATHER = GATHER_;
    const PG8_LAS int* tab; int nwg, G, c; const char* A; const char* Bt; size_t bexp, btile; int lda; const int* ltok;
    __device__ __forceinline__ bool next(int i, Unit& u) const {
        const long L = (long)i * G + c; if (L >= nwg) return false;
        int wgid = (int)L; { const int q = nwg / NXCD, r = nwg % NXCD, xcd = wgid % NXCD, off = wgid / NXCD; wgid = (xcd < r ? xcd * (q + 1) : r * (q + 1) + (xcd - r) * q) + off; }
        int e = 0;
        for (int k = 1; k < 32; ++k) e += (__builtin_amdgcn_readfirstlane(tab[k]) <= wgid) ? 1 : 0;
        const int rem = wgid - __builtin_amdgcn_readfirstlane(tab[e]);
        u.pn = rem & 3; u.pm = rem >> 2; u.e = e; u.nrow = __builtin_amdgcn_readfirstlane(tab[80 + e]) - 256 * u.pm; u.slot0 = __builtin_amdgcn_readfirstlane(tab[40 + e]) + 256 * u.pm; return true;
    }
    __device__ __forceinline__ void ptrs(const Unit& u, const char*& cA, const char*& cB) const {
        cA = GATHER ? A : A + (size_t)u.slot0 * lda * 2; cB = Bt + (size_t)u.e * bexp + (size_t)u.pn * btile; }
    __device__ __forceinline__ void rows(const Unit& u, const int (&Rr)[2], const int (&Cc)[2], unsigned (&off)[2][2]) const {
#pragma unroll
        for (int h = 0; h < 2; ++h)
#pragma unroll
            for (int i = 0; i < 2; ++i) { const int r = h * HALF + Rr[i]; const int tok = (r < u.nrow) ? ltok[(size_t)u.e * 32768 + 256 * u.pm + r] : 0; off[h][i] = (unsigned)(tok * lda + Cc[i]) * 2u; }
    }
};
constexpr float SW1 = 32.f, SW2 = 16.f, SH = 4.f;
struct EpiMoeUp {
    static constexpr bool PERM = true, AFTER_DRAIN = false; static constexpr int MID_T = 0;
    const float* lr; unsigned char* HMID8;
    __device__ __forceinline__ void operator()(const f32x4 (&acc)[2][2][4][2], const Unit& u, int wr, int wc, int fr, int fq) const {
        const int cc = u.pn * 128 + wc * 32 + 8 * fq;
#pragma unroll
        for (int ai = 0; ai < 2; ++ai)
#pragma unroll
            for (int m = 0; m < 4; ++m) { const int row = ai * HALF + wr * 64 + m * 16 + fr;
                if (row < u.nrow) { const float r = lr[(size_t)u.e * 32768 + 256 * u.pm + row] * (1.f / SW1);
                    f32x4 v[2];
#pragma unroll
                    for (int n = 0; n < 2; ++n)
#pragma unroll
                        for (int j = 0; j < 4; ++j) { const float g = acc[ai][0][m][n][j] * r, up = acc[ai][1][m][n][j] * r; v[n][j] = g * fsig(g) * up * SH; }
                    u32x2 q; q.x = cvt4_fp8(v[0][0], v[0][1], v[0][2], v[0][3]); q.y = cvt4_fp8(v[1][0], v[1][1], v[1][2], v[1][3]);
                    *(u32x2*)(HMID8 + (size_t)(u.slot0 + row) * 512 + cc) = q; } }
    }
};
struct EpiMoeDown {
    static constexpr bool PERM = true, AFTER_DRAIN = false; static constexpr int MID_T = 0;
    const float* lw; bf16_t* YB;
    __device__ __forceinline__ void operator()(const f32x4 (&acc)[2][2][4][2], const Unit& u, int wr, int wc, int fr, int fq) const {
        const int cc = u.pn * 256 + wc * 32 + 8 * fq;
#pragma unroll
        for (int ai = 0; ai < 2; ++ai)
#pragma unroll
            for (int m = 0; m < 4; ++m) { const int row = ai * HALF + wr * 64 + m * 16 + fr;
                if (row < u.nrow) { const float gw = lw[(size_t)u.e * 32768 + 256 * u.pm + row] * (1.f / (SH * SW2));
#pragma unroll
                    for (int bj = 0; bj < 2; ++bj) { const f32x4 v0 = acc[ai][bj][m][0] * gw, v1 = acc[ai][bj][m][1] * gw;
                        u32x4 w; w.x = cvt_pk_bf16(v0[0], v0[1]); w.y = cvt_pk_bf16(v0[2], v0[3]); w.z = cvt_pk_bf16(v1[0], v1[1]); w.w = cvt_pk_bf16(v1[2], v1[3]);
                        *(u32x4*)(YB + (size_t)(u.slot0 + row) * 1024 + cc + bj * HALF) = w; } } }
    }
};
struct EpiPle {
    static constexpr bool PERM = false, AFTER_DRAIN = false; static constexpr int MID_T = 4;
    const bf16_t* APLE; const float* r2; bf16_t* X3; float* ssp; u32x2* scr;
    __device__ __forceinline__ void mid(f32x4 (&acc)[2][2][4][2], const Unit&, int, int, int, int) const {
        int tid = threadIdx.x;
        asm volatile("" : "+v"(tid));
#pragma unroll
        for (int ai = 0; ai < 2; ++ai)
#pragma unroll
            for (int bj = 0; bj < 2; ++bj)
#pragma unroll
                for (int m = 0; m < 4; ++m)
#pragma unroll
                    for (int n = 0; n < 2; ++n) { const f32x4 v = acc[ai][bj][m][n]; u32x2 w; w.x = cvt_pk_bf16(v[0], v[1]); w.y = cvt_pk_bf16(v[2], v[3]);
                        scr[(((ai * 2 + bj) * 4 + m) * 2 + n) * 512 + tid] = w; acc[ai][bj][m][n] = (f32x4){0.f, 0.f, 0.f, 0.f}; asm volatile("" ::: "memory"); }
    }
    __device__ __forceinline__ void operator()(const f32x4 (&acc)[2][2][4][2], const Unit& u, int wr, int wc, int fr, int fq) const {
        int tid = threadIdx.x; int row0 = u.pm * BM + wr * 64 + fr, col0 = u.pn * BM + wc * 32 + 4 * fq;
        asm volatile("" : "+v"(tid), "+v"(row0), "+v"(col0));
#pragma unroll
        for (int ai = 0; ai < 2; ++ai)
#pragma unroll
            for (int m = 0; m < 4; ++m) { const int row = row0 + ai * HALF + m * 16; const float rr = r2[row]; float ss = 0.f;
#pragma unroll
                for (int bj = 0; bj < 2; ++bj)
#pragma unroll
                    for (int n = 0; n < 2; ++n) { const size_t o = (size_t)row * 1024 + col0 + bj * HALF + n * 16;
                        const f32x4 pr = bfx4(scr[(((ai * 2 + bj) * 4 + m) * 2 + n) * 512 + tid]); const f32x4 a = acc[ai][bj][m][n] * rr;
                        const f32x4 v = bfx4(*(const u32x2*)(APLE + (size_t)row * 1280 + 256 + col0 + bj * HALF + n * 16)) + sig4(a) * pr;
                        u32x2 w; w.x = cvt_pk_bf16(v[0], v[1]); w.y = cvt_pk_bf16(v[2], v[3]);
                        *(u32x2*)(X3 + o) = w; ss += (v[0] * v[0] + v[1] * v[1]) + (v[2] * v[2] + v[3] * v[3]); }
                ss += __shfl_xor(ss, 16); ss += __shfl_xor(ss, 32);
                if (fq == 0) ssp[(size_t)row * 16 + u.pn * 4 + wc] = ss; asm volatile("" ::: "memory"); }
    }
};
}

#define GAS __attribute__((address_space(1)))
#define LAS __attribute__((address_space(3)))
typedef unsigned v4u __attribute__((ext_vector_type(4)));
typedef GAS unsigned gu32;
constexpr int NWAVES = 8;
constexpr int RING_BYTES = 131072, LDSCTL_OFF = RING_BYTES + 4096, MISC_OFF = LDSCTL_OFF + 320, LDS_BYTES = 147456;
constexpr size_t WS_WIN = 12 * MiB, WS_WAB = 26 * MiB, WS_WO = 30 * MiB, WS_WPLE = 32 * MiB, WS_WR = 35 * MiB, WS_WGU = 36 * MiB, WS_WD = 100 * MiB;
constexpr size_t WS_LR = 132 * MiB;
constexpr size_t WS_SCR = 464 * MiB;
constexpr size_t WS_END2 = 496 * MiB;
constexpr int CW_BAR = 4096;
#define LDS_WAIT() asm volatile("s_waitcnt lgkmcnt(0)" ::: "memory")
#define VM_WAIT() asm volatile("s_waitcnt vmcnt(0)" ::: "memory")

#define XB_TMO      128
#define XB_XCNT(j)  (256  + 64 * (j))
#define XB_XSUB(j)  (1280 + 64 * (j))
#define XB_XGEN(j)  (2304 + 64 * (j))
#define XB_TOP      3328
#define XB_TOPGEN   3392
#define XCD_BAR_WORDS 3456
#define XB_SPIN_CAP (1u << 18)
__device__ __forceinline__ unsigned xb_ld(unsigned* p)              { return __hip_atomic_load(p, __ATOMIC_RELAXED, __HIP_MEMORY_SCOPE_AGENT); }
__device__ __forceinline__ unsigned xb_add(unsigned* p, unsigned v) { return __hip_atomic_fetch_add(p, v, __ATOMIC_RELAXED, __HIP_MEMORY_SCOPE_AGENT); }
__device__ __forceinline__ unsigned xb_xcc_id() { return (unsigned)__builtin_amdgcn_s_getreg((3 << 11) | 20) & 0xFu; }
#define XB_SPIN(cond, bar) do { unsigned _sp = 0; while (cond) { __builtin_amdgcn_s_sleep(1); \
    if ((++_sp & 255u) == 0u) { if (xb_ld(&(bar)[XB_TMO])) break; if (_sp > XB_SPIN_CAP) { atomicAdd(&(bar)[XB_TMO], 1u); break; } } } } while (0)
struct XcdBarrier { unsigned* bar; unsigned x; volatile LAS unsigned* st; };
__device__ __forceinline__ XcdBarrier xcd_barrier_post(unsigned* bar, volatile LAS unsigned* st) {
    XcdBarrier b; b.bar = bar; b.x = xb_xcc_id(); b.st = st;
    if (threadIdx.x == 0) (void)xb_add(&bar[XB_XCNT(b.x)], 1u);
    return b;
}
__device__ __forceinline__ void xcd_barrier_complete(unsigned* bar, unsigned x, unsigned& nloc, unsigned& nx) {
    const unsigned G = gridDim.x * gridDim.y * gridDim.z;
    unsigned sum, cnt, mine, sp = 0u;
    for (;;) {
        sum = 0u; cnt = 0u; mine = 0u;
#pragma unroll
        for (unsigned j = 0; j < 16; ++j) { const unsigned c = xb_ld(&bar[XB_XCNT(j)]); sum += c; cnt += (c > 0u) ? 1u : 0u; mine = (j == x) ? c : mine; }
        if (sum == G) break;
        __builtin_amdgcn_s_sleep(1);
        if ((++sp & 255u) == 0u) { if (xb_ld(&bar[XB_TMO])) break; if (sp > XB_SPIN_CAP) { atomicAdd(&bar[XB_TMO], 1u); break; } }
    }
    nloc = mine > 0u ? mine : 1u; nx = cnt > 0u ? cnt : 1u;
}
__device__ __forceinline__ void xcd_barrier(const XcdBarrier& b) {
    asm volatile("s_waitcnt vmcnt(0)" ::: "memory");
    __syncthreads();
    if (threadIdx.x == 0) {
        unsigned* bar = b.bar;
        __builtin_amdgcn_s_waitcnt(0);
        unsigned nloc = b.st[0], nx = b.st[1];
        if (nloc == 0u) { xcd_barrier_complete(bar, b.x, nloc, nx); b.st[0] = nloc; b.st[1] = nx; }
        const unsigned old = xb_add(&bar[XB_XSUB(b.x)], 1u);
        const unsigned gen = old / nloc;
        if (old + 1u == (gen + 1u) * nloc) {
            __builtin_amdgcn_fence(__ATOMIC_RELEASE, "agent");
            asm volatile("s_waitcnt vmcnt(0)" ::: "memory");
            const unsigned og = xb_add(&bar[XB_TOP], 1u);
            const unsigned tg = og / nx;
            if (og + 1u == (tg + 1u) * nx) xb_add(&bar[XB_TOPGEN], 1u);
            else XB_SPIN(xb_ld(&bar[XB_TOPGEN]) == tg, bar);
            __builtin_amdgcn_fence(__ATOMIC_ACQUIRE, "agent");
            xb_add(&bar[XB_XGEN(b.x)], 1u);
            asm volatile("s_waitcnt vmcnt(0)" ::: "memory");
        } else {
            XB_SPIN(xb_ld(&bar[XB_XGEN(b.x)]) == gen, bar);
            __builtin_amdgcn_fence(__ATOMIC_ACQUIRE, "agent");
            asm volatile("s_waitcnt vmcnt(0)" ::: "memory");
        }
    }
    __syncthreads();
}

__device__ __forceinline__ unsigned pk2(float lo, float hi) { return f2bf(lo) | (f2bf(hi) << 16); }
__device__ __forceinline__ void tr_item(const float* __restrict__ W, int ldn, int k0, int n0, bf16* dst, int ldb, int drow0, int dk0, const float* __restrict__ scale, LAS float* scr, int lane) {
    const int lr_ = lane >> 4, lc = (lane & 15) * 4;
    float4 v[16];
#pragma unroll
    for (int i = 0; i < 16; ++i) v[i] = *(const float4*)(W + (size_t)(k0 + 4 * i + lr_) * ldn + n0 + lc);
#pragma unroll
    for (int i = 0; i < 16; ++i) { const int kk = 4 * i + lr_; const float sc = scale ? scale[k0 + kk] : 1.f; LAS float* d = scr + kk * 65 + lc;
        d[0] = v[i].x * sc; d[1] = v[i].y * sc; d[2] = v[i].z * sc; d[3] = v[i].w * sc; }
    LDS_WAIT(); asm volatile("" ::: "memory");
    const int c = lane & 7;
#pragma unroll
    for (int j = 0; j < 8; ++j) { const int n = (lane >> 3) + 8 * j; const LAS float* s_ = scr + (8 * c) * 65 + n;
        v4u o; o.x = pk2(s_[0 * 65], s_[1 * 65]); o.y = pk2(s_[2 * 65], s_[3 * 65]); o.z = pk2(s_[4 * 65], s_[5 * 65]); o.w = pk2(s_[6 * 65], s_[7 * 65]);
        *(GAS v4u*)(dst + (size_t)(drow0 + n) * ldb + dk0 + k0 + 8 * c) = o; }
    LDS_WAIT(); asm volatile("" ::: "memory");
}
__device__ __forceinline__ void tr_item8(const float* __restrict__ W, int ldn, int k0, int n0, unsigned char* dst, int ldb, int drow0, const float* __restrict__ scale, float mul, LAS float* scr, int lane) {
    const int lr_ = lane >> 4, lc = (lane & 15) * 4;
    float4 v[16];
#pragma unroll
    for (int i = 0; i < 16; ++i) v[i] = *(const float4*)(W + (size_t)(k0 + 4 * i + lr_) * ldn + n0 + lc);
#pragma unroll
    for (int i = 0; i < 16; ++i) { const int kk = 4 * i + lr_; const float sc = (scale ? scale[k0 + kk] : 1.f) * mul; LAS float* d = scr + kk * 65 + lc;
        d[0] = v[i].x * sc; d[1] = v[i].y * sc; d[2] = v[i].z * sc; d[3] = v[i].w * sc; }
    LDS_WAIT(); asm volatile("" ::: "memory");
    const int c = lane & 7;
#pragma unroll
    for (int j = 0; j < 8; ++j) { const int n = (lane >> 3) + 8 * j; const LAS float* s_ = scr + (8 * c) * 65 + n;
        uint2 o; o.x = pg8::cvt4_fp8(s_[0 * 65], s_[1 * 65], s_[2 * 65], s_[3 * 65]); o.y = pg8::cvt4_fp8(s_[4 * 65], s_[5 * 65], s_[6 * 65], s_[7 * 65]);
        *(uint2*)(dst + (size_t)(drow0 + n) * ldb + k0 + 8 * c) = o; }
    LDS_WAIT(); asm volatile("" ::: "memory");
}
__device__ __forceinline__ int map_in(int n0) {
    const int q = n0 >> 7, s = q >> 3, i = q & 7, off = n0 & 127;
    if (s == 0) return 4096 + 128 * i + off;
    if (s == 1) return 256 * i + off;
    if (s == 2) return 256 * i + 128 + off;
    if (s == 3) return 256 * (8 + i) + off;
    if (s == 4) return 256 * (8 + i) + 128 + off;
    if (s == 5) return 5120 + 128 * i + off;
    return 6144 + 128 * i + off;
}

struct Args { const float* in[25]; float* out; unsigned char* ws; int ph_lo, ph_hi; };

__global__ void __launch_bounds__(NWAVES * 64, 2) mega(Args args) {
    extern __shared__ __attribute__((aligned(16))) unsigned char lds_raw[];
    LAS unsigned char* lds = (LAS unsigned char*)lds_raw;
    volatile LAS unsigned* MISC = (volatile LAS unsigned*)(lds + MISC_OFF);
    const int tid = threadIdx.x, lane = tid & 63, wave = __builtin_amdgcn_readfirstlane(tid >> 6);
    const int G = gridDim.x; const int bx = blockIdx.x; const int vcu = (G % 8 == 0) ? (bx % 8) * (G / 8) + bx / 8 : bx;
    unsigned char* ws = args.ws;
    gu32* ctl = (gu32*)(ws + WS_CTL);
    for (int u = tid; u < (LDS_BYTES - LDSCTL_OFF) / 4; u += NWAVES * 64) ((LAS unsigned*)(lds + LDSCTL_OFF))[u] = 0u;
    __syncthreads();
    XcdBarrier bar = xcd_barrier_post((unsigned*)(ctl + CW_BAR), MISC + 8);
    const int lo = args.ph_lo, hi = args.ph_hi;
#ifndef PH_MASK
#define PH_MASK 0x7ff
#endif
#define IN(k) (((PH_MASK >> (k)) & 1) && lo <= (k) && (k) < hi)
#define BOTH(k) (IN(k) && (IN((k) + 1) || rep_ + 1 < NREP(k)))
#ifndef REP_MASK
#define REP_MASK 0
#endif
#ifndef PROBE_SKIP_EPI
#define PROBE_SKIP_EPI 0
#endif
#define NREP(k) (((REP_MASK >> (k)) & 1) ? 2 : 1)
#define PHASE(k) if (IN(k)) _Pragma("unroll") for (int rep_ = 0; rep_ < NREP(k); ++rep_)
    const float* x = args.in[0];
    bf16* H = (bf16*)args.out;
    bf16* WinT = (bf16*)(ws + WS_WIN); bf16* WabT = (bf16*)(ws + WS_WAB); bf16* WoT = (bf16*)(ws + WS_WO); bf16* WpleT = (bf16*)(ws + WS_WPLE); bf16* WrT = (bf16*)(ws + WS_WR);
    unsigned char* Wgu8 = ws + WS_WGU; unsigned char* Wd8 = ws + WS_WD;
    bf16* UA = (bf16*)(ws + WS_RA); bf16* UB = (bf16*)(ws + WS_RB); bf16* AB = (bf16*)(ws + WS_RC); bf16* GA = (bf16*)(ws + WS_RD); bf16* GB = (bf16*)(ws + WS_RE);

    PHASE(0) {
        LAS float* scr = (LAS float*)(lds + wave * 16640);
        const int gw = vcu * NWAVES + wave, NGW = G * NWAVES;
        constexpr int I_IN = 16 * 112, I_SQ = 16 * 16, I_PP = 4 * 16, I_EG = 32 * 16 * 8, I_ED = 32 * 8 * 16;
        constexpr int NITEMS = I_IN + 4 * I_SQ + I_PP + 2 * I_EG + I_ED;
        for (int it = gw; it < NITEMS; it += NGW) {
            int r = it;
            if (r < 2 * I_EG) { const int up = r >= I_EG; if (up) r -= I_EG; const int e = r / 128, q = r % 128, kb = q / 8, nb = q % 8, n0 = 64 * nb;
                tr_item8((up ? args.in[19] : args.in[18]) + (size_t)e * D * DE, DE, 64 * kb, n0, Wgu8 + (size_t)e * 1024 * 1024, 1024, 256 * (n0 >> 7) + (up ? 128 : 0) + (n0 & 127), args.in[13], pg8::SW1, scr, lane); continue; } r -= 2 * I_EG;
            if (r < I_ED) { const int e = r / 128, q = r % 128, kb = q / 16, nb = q % 16; tr_item8(args.in[20] + (size_t)e * DE * D, D, 64 * kb, 64 * nb, Wd8 + (size_t)e * 1024 * 512, 512, 64 * nb, nullptr, pg8::SW2, scr, lane); continue; } r -= I_ED;
            if (r < I_IN) { const int kb = r / 112, nb = r % 112; tr_item(args.in[3], INC, 64 * kb, 64 * nb, WinT, 1024, map_in(64 * nb), 0, nullptr, scr, lane); continue; } r -= I_IN;
            if (r < I_SQ) { tr_item(args.in[5], D, 64 * (r / 16), 64 * (r % 16), WabT, 2048, 64 * (r % 16), 0, nullptr, scr, lane); continue; } r -= I_SQ;
            if (r < I_SQ) { tr_item(args.in[10], D, 64 * (r / 16), 64 * (r % 16), WabT, 2048, 64 * (r % 16), 1024, nullptr, scr, lane); continue; } r -= I_SQ;
            if (r < I_SQ) { tr_item(args.in[12], D, 64 * (r / 16), 64 * (r % 16), WoT, 1024, 64 * (r % 16), 0, nullptr, scr, lane); continue; } r -= I_SQ;
            if (r < I_SQ) { tr_item(args.in[22], D, 64 * (r / 16), 64 * (r % 16), WpleT, 1280, 64 * (r % 16), 256, args.in[21], scr, lane); continue; } r -= I_SQ;
            tr_item(args.in[23], D, 64 * (r / 16), 64 * (r % 16), WpleT, 1280, 64 * (r % 16), 0, nullptr, scr, lane);
        }
        for (int i = vcu * 512 + tid; i < 256 * 1024; i += G * 512) { const int rr = i >> 10, k = i & 1023; float v = 0.f;
            if (rr < 4) v = args.in[14][k * 4 + rr] * args.in[13][k]; else if (rr < 36) v = args.in[16][k * 32 + rr - 4] * args.in[13][k];
            WrT[i] = (bf16)f2bf(v); }
        const float* g = args.in[2];
        for (int row = 2 * gw; row < T; row += 2 * NGW) {
            const float4* xr = (const float4*)(x + (size_t)row * D);
            float4 v[2][4]; float s0 = 0.f, s1 = 0.f;
#pragma unroll
            for (int j = 0; j < 4; ++j) { v[0][j] = xr[lane + 64 * j]; v[1][j] = xr[256 + lane + 64 * j]; }
#pragma unroll
            for (int j = 0; j < 4; ++j) { s0 += v[0][j].x * v[0][j].x + v[0][j].y * v[0][j].y + v[0][j].z * v[0][j].z + v[0][j].w * v[0][j].w;
                                          s1 += v[1][j].x * v[1][j].x + v[1][j].y * v[1][j].y + v[1][j].z * v[1][j].z + v[1][j].w * v[1][j].w; }
            const float r0 = rsqrtf(wave_sum(s0) * (1.f / D) + EPS), r1_ = rsqrtf(wave_sum(s1) * (1.f / D) + EPS);
#pragma unroll
            for (int j = 0; j < 4; ++j) { const int c = 4 * (lane + 64 * j); const float4 gg = *(const float4*)(g + c);
                uint2 o; o.x = pk2(v[0][j].x * r0 * gg.x, v[0][j].y * r0 * gg.y); o.y = pk2(v[0][j].z * r0 * gg.z, v[0][j].w * r0 * gg.w);
                *(uint2*)(H + (size_t)row * D + c) = o;
                o.x = pk2(v[1][j].x * r1_ * gg.x, v[1][j].y * r1_ * gg.y); o.y = pk2(v[1][j].z * r1_ * gg.z, v[1][j].w * r1_ * gg.w);
                *(uint2*)(H + (size_t)(row + 1) * D + c) = o; }
        }
        if (BOTH(0)) xcd_barrier(bar);
    }
    PHASE(1) {
        pg8::Gemm g{1024, 1024, 1024}; pg8::StaticOrder S; S.init(T, INC, G, bx, H, 1024, WinT, 1024);
        pg8::EpiInProj E{UA, (size_t)(WS_RB - WS_RA) / 2, args.in[11], (PROBE_SKIP_EPI && rep_ == 1) ? (args.ph_hi > 5 ? 1 : 0) : 0};
        pg8::gemm_phase<pg8::EpiInProj, pg8::StaticOrder, true>(lds, g, S, E);
        if (BOTH(1)) xcd_barrier(bar);
    }

    bf16* ZZ = (bf16*)args.out; bf16* MIX = (bf16*)(ws + WS_RC); bf16* APLE = (bf16*)(ws + WS_RA);
    unsigned char* HMID8 = ws + WS_RC; bf16* YB = (bf16*)(ws + WS_RD); bf16* X3 = (bf16*)(ws + WS_RC); unsigned char* X8 = ws + WS_RB + 16 * MiB;
    int* tok_e = (int*)(ws + WS_TOK); float* tok_w = (float*)(ws + WS_TOK + 256 * 1024); int* tok_pos = (int*)(ws + WS_TOK + 512 * 1024);
    float* r1 = (float*)(ws + WS_TOK + 768 * 1024); float* r2 = (float*)(ws + WS_TOK + 896 * 1024);
    float* ssp1 = (float*)(ws + WS_SSP1); float* ssp3 = (float*)(ws + WS_SSP3); int* ltok = (int*)(ws + WS_LTOK); float* lw = (float*)(ws + WS_LW); float* lr = (float*)(ws + WS_LR);
    unsigned* cnt = (unsigned*)(ctl + CW_CNT);
    LAS int* tab = (LAS int*)(lds + LDSCTL_OFF + 1024);
#define MOE_TABLES() do { if (tid == 0) { int us = 0, es = 0; for (int e = 0; e < NE; ++e) { const int c = (int)cnt[e]; tab[e] = us; tab[40 + e] = es; tab[80 + e] = c; us += 4 * ((c + 255) >> 8); es += c; } tab[32] = us; tab[72] = es; } \
        LDS_WAIT(); __syncthreads(); } while (0)

    PHASE(2) {
        typedef float f32x2 __attribute__((ext_vector_type(2)));
        const int c0_ = 2 * tid;
        const float* cwb = args.in[6]; const float* cwa = args.in[4];
        LAS float* red = (LAS float*)(lds + LDSCTL_OFF + 4096); LAS float* tot = (LAS float*)(lds + LDSCTL_OFF + 4096 + 2048);
        const int upw = (1024 + G - 1) / G;
        bool have_prev = false;
        for (int un = vcu * upw; un < (vcu + 1) * upw && un < 1024; ++un) {
            const int t0 = un * 32; const bool first = (t0 & (SEQ - 1)) == 0;
            int c0 = c0_; asm volatile("" : "+v"(c0));
            {
                const int rlo = (have_prev || first) ? 0 : -30;
                const int npieces = (32 - rlo) * 128;
                v4u pc[16];
#pragma unroll
                for (int i = 0; i < 16; ++i) { const int pidx = tid + 512 * i; if (pidx < npieces) { const int row = t0 + rlo + (pidx >> 7);
                        pc[i] = *(const v4u*)(UB + (size_t)row * 1024 + (pidx & 127) * 8); } }
#pragma unroll
                for (int i = 0; i < 16; ++i) { const int pidx = tid + 512 * i; if (pidx < npieces) { const int row = t0 + rlo + (pidx >> 7);
                        *(LAS v4u*)(lds + (row & 63) * 2048 + (pidx & 127) * 16) = pc[i]; } }
            }
            f32x2 wb[31];
#pragma unroll
            for (int k = 0; k < 31; ++k) wb[k] = *(const f32x2*)(cwb + k * 1024 + c0);
            const f32x2 bb = *(const f32x2*)(args.in[7] + c0);
            LDS_WAIT(); __syncthreads();
            f32x2 acc[32];
#pragma unroll
            for (int j = 0; j < 32; ++j) acc[j] = bb;
            const int sb = (t0 + 34) & 63;
#pragma unroll
            for (int si = 0; si < 62; ++si) {
                const bool dead = first && si < 30;
                const unsigned w = *(const LAS unsigned*)(lds + ((sb + si) & 63) * 2048 + tid * 4);
                f32x2 uv = (f32x2){__builtin_bit_cast(float, w << 16), __builtin_bit_cast(float, w & 0xffff0000u)};
                if (dead) uv = (f32x2){0.f, 0.f};
#pragma unroll
                for (int j = (si > 30 ? si - 30 : 0); j <= (si < 31 ? si : 31); ++j) acc[j] += wb[si - j] * uv;
                if ((si & 7) == 7) asm volatile("" ::: "memory");
            }
            float v1[32], v2[32];
#pragma unroll
            for (int j = 0; j < 32; ++j) { v1[j] = acc[j].x + acc[j].y; v2[j] = acc[j].x * acc[j].x + acc[j].y * acc[j].y; }
#define BFLY(v, NN, bit) _Pragma("unroll") for (int i = 0; i < (NN) / 2; ++i) { const bool up_ = (lane & (bit)) != 0; const float keep_ = up_ ? v[i + (NN) / 2] : v[i], send_ = up_ ? v[i] : v[i + (NN) / 2]; v[i] = keep_ + __shfl_xor(send_, (bit)); }
            BFLY(v1, 32, 16) BFLY(v1, 16, 8) BFLY(v1, 8, 4) BFLY(v1, 4, 2) BFLY(v1, 2, 1)
            BFLY(v2, 32, 16) BFLY(v2, 16, 8) BFLY(v2, 8, 4) BFLY(v2, 4, 2) BFLY(v2, 2, 1)
#undef BFLY
            v1[0] += __shfl_xor(v1[0], 32); v2[0] += __shfl_xor(v2[0], 32);
            red[wave * 64 + lane] = lane < 32 ? v1[0] : v2[0];
            LDS_WAIT(); __syncthreads();
            if (tid < 64) { float sm = 0.f;
#pragma unroll
                for (int w8 = 0; w8 < 8; ++w8) sm += red[w8 * 64 + tid];
                tot[tid] = sm; }
            LDS_WAIT(); __syncthreads();
            asm volatile("" : "+v"(c0));
            unsigned rua[34], rab[32];
#pragma unroll
            for (int j = 0; j < 34; ++j) rua[j] = *(const unsigned*)(UA + (size_t)((first && j < 2) ? t0 : t0 - 2 + j) * 1024 + c0);
#pragma unroll
            for (int j = 0; j < 32; ++j) rab[j] = *(const unsigned*)(AB + (size_t)(t0 + j) * 1024 + c0);
            const f32x2 lg = *(const f32x2*)(args.in[8] + c0), lb = *(const f32x2*)(args.in[9] + c0);
#pragma unroll
            for (int j = 0; j < 32; ++j) { const float mu = tot[j] * (1.f / 1024.f); const float var = tot[32 + j] * (1.f / 1024.f) - mu * mu; const float rstd = rsqrtf(var + EPS);
                const f32x2 y = (acc[j] - mu) * rstd * lg + lb;
                *(unsigned*)(ZZ + (size_t)(t0 + j) * 2048 + 1024 + c0) = pg8::cvt_pk_bf16(y.x * pg8::fsig(y.x), y.y * pg8::fsig(y.y)); }
            asm volatile("" : "+v"(c0));
            const f32x2 wa0 = *(const f32x2*)(cwa + c0), wa1 = *(const f32x2*)(cwa + 1024 + c0), wa2 = *(const f32x2*)(cwa + 2048 + c0);
#define BF2(w_) ((f32x2){__builtin_bit_cast(float, (w_) << 16), __builtin_bit_cast(float, (w_) & 0xffff0000u)})
            if (first) { rua[0] = 0u; rua[1] = 0u; }
#pragma unroll
            for (int j = 0; j < 32; ++j) { const f32x2 za = BF2(rab[j]) * (wa0 * BF2(rua[j]) + wa1 * BF2(rua[j + 1]) + wa2 * BF2(rua[j + 2]));
                *(unsigned*)(ZZ + (size_t)(t0 + j) * 2048 + c0) = pg8::cvt_pk_bf16(za.x, za.y); }
#undef BF2
            have_prev = true;
        }
        if (BOTH(2)) xcd_barrier(bar);
    }
    PHASE(3) {
        pg8::Gemm g{2048, 2048, 2048}; pg8::StaticOrder S; S.init(T, D, G, bx, ZZ, 2048, WabT, 2048);
        pg8::EpiMix E{GA, GB, MIX};
        pg8::gemm_phase<pg8::EpiMix, pg8::StaticOrder, true>(lds, g, S, E);
        if (BOTH(3)) xcd_barrier(bar);
    }
    PHASE(4) {
        pg8::Gemm g{1024, 1024, 1024}; pg8::StaticOrder S; S.init(T, D, G, bx, MIX, 1024, WoT, 1024);
        pg8::EpiWo E{x, APLE, X8, ssp1};
        pg8::gemm_phase<pg8::EpiWo, pg8::StaticOrder, true>(lds, g, S, E);
        if (BOTH(4)) xcd_barrier(bar);
    }
    PHASE(5) {
        pg8::Gemm g{1280, 1024, 1024}; pg8::StaticOrder S; S.init(T, 256, G, bx, APLE + 256, 1280, WrT, 1024);
        pg8::EpiRouter E{ssp1, args.in[15], args.in[17], cnt, tok_e, tok_w, tok_pos, r1, ltok, lw, lr};
        pg8::gemm_phase<pg8::EpiRouter, pg8::StaticOrder, false>(lds, g, S, E);
        const int nidle = G > 128 ? G - 128 : G, me = G > 128 ? bx - 128 : bx;
        if (me >= 0) { const float* p = args.in[1];
            for (size_t i = (size_t)me * 512 + tid; i < (size_t)T * 64; i += (size_t)nidle * 512) { const size_t t = i >> 6; const int c = (int)(i & 63) * 4; const float4 v = *(const float4*)(p + t * PLE + c);
                uint2 o; o.x = pk2(v.x, v.y); o.y = pk2(v.z, v.w); *(uint2*)(APLE + t * APITCH + c) = o; } }
        if (BOTH(5)) xcd_barrier(bar);
    }
    PHASE(6) {
        MOE_TABLES();
        pg8::Gemm g{512, 512, 512};
        pg8::MoeOrder<true> S{tab, tab[32], G, bx, (const char*)X8, (const char*)Wgu8, (size_t)1024 * 1024, (size_t)256 * 1024, 512, ltok};
        pg8::EpiMoeUp E{lr, HMID8};
        pg8::gemm_phase<pg8::EpiMoeUp, pg8::MoeOrder<true>, true, true>(lds, g, S, E);
        if (BOTH(6)) xcd_barrier(bar);
    }
    PHASE(7) {
        MOE_TABLES();
        pg8::Gemm g{256, 256, 256};
        pg8::MoeOrder<false> S{tab, tab[32], G, bx, (const char*)HMID8, (const char*)Wd8, (size_t)1024 * 512, (size_t)256 * 512, 256, ltok};
        pg8::EpiMoeDown E{lw, YB};
        pg8::gemm_phase<pg8::EpiMoeDown, pg8::MoeOrder<false>, true, true>(lds, g, S, E);
        if (BOTH(7)) xcd_barrier(bar);
    }
    PHASE(8) {
        MOE_TABLES();
        const int gw = vcu * NWAVES + wave, NGW = G * NWAVES;
        for (int t = gw; t < T; t += NGW) {
            const int sa = tab[40 + tok_e[t * 2]] + tok_pos[t * 2], sb = tab[40 + tok_e[t * 2 + 1]] + tok_pos[t * 2 + 1];
            float s = 0.f;
#pragma unroll
            for (int j = 0; j < 2; ++j) { const int c = 8 * (lane + 64 * j);
                bf16* xp = APLE + (size_t)t * APITCH + 256 + c;
                const v4u xv = *(const v4u*)xp, ya = *(const v4u*)(YB + (size_t)sa * D + c), yb = *(const v4u*)(YB + (size_t)sb * D + c);
                v4u o;
#pragma unroll
                for (int q = 0; q < 4; ++q) { const float lo = bf2f(xv[q] & 0xffff) + bf2f(ya[q] & 0xffff) + bf2f(yb[q] & 0xffff), hi = bf2f(xv[q] >> 16) + bf2f(ya[q] >> 16) + bf2f(yb[q] >> 16);
                    s += lo * lo + hi * hi; o[q] = pk2(lo, hi); }
                *(v4u*)xp = o; }
            s = wave_sum(s);
            if (lane == 0) r2[t] = rsqrtf(s * (1.f / D) + EPS);
        }
        if (BOTH(8)) xcd_barrier(bar);
    }
    PHASE(9) {
        pg8::Gemm g{1280, 1280, 1280}; pg8::StaticOrder S; S.init(T, D, G, bx, APLE, 1280, WpleT, 1280);
        pg8::EpiPle E{APLE, r2, X3, ssp3, (pg8::u32x2*)(ws + WS_SCR + (size_t)bx * 131072)};
        pg8::gemm_phase<pg8::EpiPle, pg8::StaticOrder, true>(lds, g, S, E);
        if (BOTH(9)) xcd_barrier(bar);
    }
    PHASE(10) {
        const int gw = vcu * NWAVES + wave, NGW = G * NWAVES; const float* gfin = args.in[24];
        for (int row = gw; row < T; row += NGW) {
            float ss = lane < 16 ? ssp3[(size_t)row * 16 + lane] : 0.f; ss = wave_sum(ss);
            const float r = rsqrtf(ss * (1.f / D) + EPS);
#pragma unroll
            for (int j = 0; j < 4; ++j) { const int c = 4 * (lane + 64 * j); const uint2 w = *(const uint2*)(X3 + (size_t)row * D + c); const float4 gg = *(const float4*)(gfin + c);
                *(float4*)(args.out + (size_t)row * D + c) = make_float4(bf2f(w.x & 0xffff) * r * gg.x, bf2f(w.x >> 16) * r * gg.y, bf2f(w.y & 0xffff) * r * gg.z, bf2f(w.y >> 16) * r * gg.w); }
        }
    }
#undef MOE_TABLES
#undef IN
#undef BOTH
}

#ifndef OPT_UPTO
#define OPT_UPTO 11
#endif
extern "C" void kernel_launch(void* const* d_in, const int* in_sizes, int n_in, void* d_out, int out_size, void* d_ws, size_t ws_size, hipStream_t stream) {
    static int grid = 0;
    if (grid == 0) {
        if (n_in != 25 || in_sizes[0] != T * D || out_size != T * D || ws_size < WS_END2) { fprintf(stderr, "kernel_launch: unexpected shapes (n_in %d, in0 %d, out %d, ws %zu)\n", n_in, n_in > 0 ? in_sizes[0] : -1, out_size, ws_size); grid = -1; return; }
        int dev = 0, cus = 0, per_cu = 0;
        if (hipGetDevice(&dev) != hipSuccess || hipDeviceGetAttribute(&cus, hipDeviceAttributeMultiprocessorCount, dev) != hipSuccess) { fprintf(stderr, "kernel_launch: device query failed\n"); grid = -1; return; }
        if (hipFuncSetAttribute((const void*)mega, hipFuncAttributeMaxDynamicSharedMemorySize, LDS_BYTES) != hipSuccess) { fprintf(stderr, "kernel_launch: hipFuncSetAttribute failed\n"); grid = -1; return; }
        if (hipOccupancyMaxActiveBlocksPerMultiprocessor(&per_cu, (const void*)mega, NWAVES * 64, LDS_BYTES) != hipSuccess || per_cu < 1) { fprintf(stderr, "kernel_launch: occupancy query says %d blocks per CU\n", per_cu); (void)hipGetLastError(); grid = -1; return; }
        grid = cus;
    }
    if (grid < 0) return;
    const float* x = (const float*)d_in[0]; const float* p = (const float*)d_in[1];
    const float* conv_a_w = (const float*)d_in[4]; const float* w_out_a = (const float*)d_in[5]; const float* conv_b_w = (const float*)d_in[6]; const float* conv_b_b = (const float*)d_in[7];
    const float* ln_b_g = (const float*)d_in[8]; const float* ln_b_b = (const float*)d_in[9]; const float* w_out_b = (const float*)d_in[10];
    const float* w_o = (const float*)d_in[12]; const float* ffn_g = (const float*)d_in[13]; const float* w_rg = (const float*)d_in[14]; const float* b_rg = (const float*)d_in[15];
    const float* w_re = (const float*)d_in[16]; const float* b_re = (const float*)d_in[17]; const float* w_eg = (const float*)d_in[18]; const float* w_eu = (const float*)d_in[19];
    const float* w_ed = (const float*)d_in[20]; const float* ple_g = (const float*)d_in[21]; const float* w_pg = (const float*)d_in[22]; const float* w_pp = (const float*)d_in[23];
    const float* fin_g = (const float*)d_in[24];
    unsigned char* ws = (unsigned char*)d_ws; float* out = (float*)d_out;
    unsigned* ctl = (unsigned*)(ws + WS_CTL);
    int* tok_e = (int*)(ws + WS_TOK); float* tok_w = (float*)(ws + WS_TOK + 256 * 1024); int* tok_pos = (int*)(ws + WS_TOK + 512 * 1024);
    float* r1 = (float*)(ws + WS_TOK + 768 * 1024); float* r2 = (float*)(ws + WS_TOK + 896 * 1024);
    float* ssp1 = (float*)(ws + WS_SSP1); int* ltok = (int*)(ws + WS_LTOK); float* lw = (float*)(ws + WS_LW);
    bf16* UA = (bf16*)(ws + WS_RA); bf16* UB = (bf16*)(ws + WS_RB); bf16* AB = (bf16*)(ws + WS_RC); bf16* GA = (bf16*)(ws + WS_RD); bf16* GB = (bf16*)(ws + WS_RE);
    bf16* ZZ = (bf16*)d_out; bf16* MIX = (bf16*)(ws + WS_RC); float* X1 = (float*)(ws + WS_RA); bf16* APLE = (bf16*)(ws + WS_RA);
    bf16* HMID = (bf16*)(ws + WS_RC); bf16* YB = (bf16*)(ws + WS_RD); float* X3 = (float*)(ws + WS_RC);

    if (hipMemsetAsync(ws + WS_CTL, 0, 1 * MiB, stream) != hipSuccess) { fprintf(stderr, "kernel_launch: memset failed\n"); return; }
    Args a{};
    for (int i = 0; i < 25; ++i) a.in[i] = (const float*)d_in[i];
    a.out = out; a.ws = ws; a.ph_lo = 0; a.ph_hi = OPT_UPTO;
    void* kargs[] = {&a};
    const hipError_t le = hipLaunchCooperativeKernel((const void*)mega, dim3(grid), dim3(NWAVES * 64), kargs, LDS_BYTES, stream);
    if (le != hipSuccess) { fprintf(stderr, "kernel_launch: cooperative launch failed: %s (grid %d)\n", hipGetErrorString(le), grid); return; }
#if OPT_UPTO < 11
    if (OPT_UPTO <= 1) nv_inproj<<<dim3(T / 8, 4), 256, 0, stream>>>((const bf16*)d_out, (const float*)d_in[3], (const float*)d_in[11], UA, UB, AB, GA, GB);
    if (OPT_UPTO <= 2) nv_conv<<<T, 256, 0, stream>>>(UA, UB, AB, conv_a_w, conv_b_w, conv_b_b, ln_b_g, ln_b_b, ZZ);
    if (OPT_UPTO <= 3) nv_outab<<<dim3(T / 8, 4), 256, 0, stream>>>(ZZ, w_out_a, w_out_b, GA, GB, MIX);
    if (OPT_UPTO <= 4) { nv_wo<<<dim3(T / 8, 4), 256, 0, stream>>>(MIX, w_o, x, X1, APLE); nv_rowss<<<T / 4, 256, 0, stream>>>(X1, ssp1); }
    if (OPT_UPTO <= 5) { nv_router<<<T / 4, 256, 0, stream>>>(X1, ssp1, ffn_g, w_rg, b_rg, w_re, b_re, ctl + CW_CNT, tok_e, tok_w, tok_pos, r1, ltok, lw); nv_pcvt<<<T * PLE / 4 / 256, 256, 0, stream>>>(p, APLE); }
    if (OPT_UPTO <= 6) nv_moe_up<<<dim3(T / 8, NE), 256, 0, stream>>>(X1, r1, ffn_g, w_eg, w_eu, ctl + CW_CNT, ltok, HMID);
    if (OPT_UPTO <= 7) nv_moe_down<<<dim3(T / 8, NE), 256, 0, stream>>>(HMID, w_ed, ctl + CW_CNT, lw, YB);
    if (OPT_UPTO <= 8) nv_combine<<<T / 4, 256, 0, stream>>>(X1, YB, ctl + CW_CNT, tok_e, tok_pos, APLE, r2);
    if (OPT_UPTO <= 9) nv_ple<<<dim3(T / 8, 4), 256, 0, stream>>>(X1, r2, ple_g, w_pg, p, w_pp, X3);
    if (OPT_UPTO <= 10) nv_final<<<T / 4, 256, 0, stream>>>(X3, fin_g, out);
#endif
}
```

```cpp
#include <hip/hip_runtime.h>
#include <cstdio>
#include <cstdint>

typedef unsigned short bf16;
constexpr int T = 32768, D = 1024, SEQ = 2048, PLE = 256, NE = 32, NG = 4, EPG = 8, DE = 512, INC = 7168;
constexpr float EPS = 1e-6f;
constexpr size_t MiB = 1u << 20;
constexpr size_t WS_CTL = 0;
constexpr size_t WS_TOK = 1 * MiB;
constexpr size_t WS_SSP1 = 2 * MiB;
constexpr size_t WS_SSP3 = 4 * MiB;
constexpr size_t WS_LTOK = 6 * MiB;
constexpr size_t WS_LW = 136 * MiB;
constexpr size_t WS_RA = 144 * MiB, WS_RB = 208 * MiB, WS_RC = 272 * MiB, WS_RD = 336 * MiB, WS_RE = 400 * MiB;
constexpr size_t WS_END = 464 * MiB;
constexpr int APITCH = 1280;
constexpr int CW_CNT = 64;

__device__ __forceinline__ unsigned f2bf(float f) { unsigned u = __builtin_bit_cast(unsigned, f); return (u + 0x7fffu + ((u >> 16) & 1u)) >> 16; }
__device__ __forceinline__ float bf2f(unsigned short b) { return __builtin_bit_cast(float, (unsigned)b << 16); }
__device__ __forceinline__ float sigmoidf_(float v) { return 1.f / (1.f + __expf(-v)); }
__device__ __forceinline__ float siluf_(float v) { return v / (1.f + __expf(-v)); }
__device__ __forceinline__ float wave_sum(float v) {
#pragma unroll
    for (int o = 1; o < 64; o <<= 1) v += __shfl_xor(v, o);
    return v;
}

#define REP_MASK 0
#define OPT_UPTO 11
namespace pg8 {
#define PG8_LAS __attribute__((address_space(3)))
typedef unsigned short bf16_t;
typedef short bf16x8 __attribute__((ext_vector_type(8)));
typedef float f32x4 __attribute__((ext_vector_type(4)));
typedef unsigned u32x4 __attribute__((ext_vector_type(4)));
typedef unsigned u32x2 __attribute__((ext_vector_type(2)));
constexpr int BM = 256, BK = 64, HALF = 128, HTB = HALF * BK * 2, STAGE_BYTES = 8 * HTB, NXCD = 8, WGM = 8;
__host__ __device__ __forceinline__ int lds_byte(int r, int c) { const int st = (r >> 4) * 2 + (c >> 5), rr = r & 15, cc = c & 31, ob = rr * 64 + cc * 2; return st * 1024 + (ob ^ (((ob >> 9) & 1) << 5)); }
__host__ __device__ __forceinline__ void stage_rc(int b, int& R, int& C) { const int st = b / 1024, sb = b % 1024, swz = sb ^ (((sb >> 9) & 1) << 5); R = (st >> 1) * 16 + swz / 64; C = (st & 1) * 32 + (swz % 64) / 2; }
__host__ __device__ __forceinline__ int perm32(int rho) { const int n = rho >> 4, i = rho & 15; return 8 * (i >> 2) + 4 * n + (i & 3); }

struct Unit { int pm, pn, e, nrow, slot0; };
struct Gemm { int lda, ldb, K; };

__device__ __forceinline__ unsigned cvt_pk_bf16(float lo, float hi) { unsigned r; asm volatile("v_cvt_pk_bf16_f32 %0, %1, %2" : "=v"(r) : "v"(lo), "v"(hi)); return r; }
__device__ __forceinline__ float fsig(float v) { return __builtin_amdgcn_rcpf(1.f + __expf(-v)); }
__device__ __forceinline__ f32x4 sig4(f32x4 v) { return (f32x4){fsig(v[0]), fsig(v[1]), fsig(v[2]), fsig(v[3])}; }
__device__ __forceinline__ f32x4 bfx4(u32x2 w) { return (f32x4){__builtin_bit_cast(float, w.x << 16), __builtin_bit_cast(float, w.x & 0xffff0000u), __builtin_bit_cast(float, w.y << 16), __builtin_bit_cast(float, w.y & 0xffff0000u)}; }

struct StaticOrder {
    static constexpr bool GATHER = false;
    int nM, nN, nwg, G, c; const char* A; const char* Bt; size_t atile, btile;
    __device__ __forceinline__ void init(int M, int N, int G_, int c_, const void* A_, int lda, const void* Bt_, int ldb) { nM = M / BM; nN = N / BM; nwg = nM * nN; G = G_; c = c_; A = (const char*)A_; Bt = (const char*)Bt_; atile = (size_t)BM * lda * 2; btile = (size_t)BM * ldb * 2; }
    __device__ __forceinline__ bool next(int i, Unit& u) const {
        const long L = (long)i * G + c; if (L >= nwg) return false;
        int wgid = (int)L; { const int q = nwg / NXCD, r = nwg % NXCD, xcd = wgid % NXCD, off = wgid / NXCD; wgid = (xcd < r ? xcd * (q + 1) : r * (q + 1) + (xcd - r) * q) + off; }
        const int nig = WGM * nN, gid = wgid / nig, fm = gid * WGM, gsz = (nM - fm) < WGM ? (nM - fm) : WGM;
        u.pm = fm + ((wgid % nig) % gsz); u.pn = (wgid % nig) / gsz; u.e = 0; u.nrow = 256; u.slot0 = 0; return true;
    }
    __device__ __forceinline__ void ptrs(const Unit& u, const char*& cA, const char*& cB) const { cA = A + (size_t)u.pm * atile; cB = Bt + (size_t)u.pn * btile; }
    __device__ __forceinline__ void rows(const Unit&, const int (&)[2], const int (&)[2], unsigned (&)[2][2]) const {}
};

typedef int v4i_t __attribute__((ext_vector_type(4)));
typedef int v8i_t __attribute__((ext_vector_type(8)));
__device__ __forceinline__ v8i_t cat8(bf16x8 lo, bf16x8 hi) { const v4i_t l = __builtin_bit_cast(v4i_t, lo), h = __builtin_bit_cast(v4i_t, hi); return __builtin_shufflevector(l, h, 0, 1, 2, 3, 4, 5, 6, 7); }
__device__ __forceinline__ void mfma8(f32x4& acc, v8i_t b, v8i_t a, int one) {
    asm volatile("s_nop 1\n\tv_mfma_scale_f32_16x16x128_f8f6f4 %0, %1, %2, %0, %3, %3 op_sel_hi:[0,0,0]" : "+v"(acc) : "v"(b), "v"(a), "v"(one));
}
#define MFMA_DRAIN() asm volatile("s_nop 15\n\ts_nop 7" ::: "memory")
template <class Epi, class Sched, bool ALIGN_EPI, bool FP8 = false>
__device__ __forceinline__ void gemm_phase(PG8_LAS unsigned char* lds, const Gemm g, const Sched& S, const Epi& E) {
    const int tid = threadIdx.x, wid = __builtin_amdgcn_readfirstlane(tid >> 6), lane = tid & 63, wr = wid >> 2, wc = wid & 3, fr = lane & 15, fq = lane >> 4;
    const int K = g.K, nt = K / BK;
    int Rr[2], Cc[2]; unsigned vA[2][2], vN[2][2], voffB[2];
#pragma unroll
    for (int i = 0; i < 2; ++i) { int R, C; stage_rc(tid * 16 + i * 8192, R, C); Rr[i] = R; Cc[i] = C; const int Rb = Epi::PERM ? ((R & ~31) + perm32(R & 31)) : R;
        voffB[i] = (unsigned)(Rb * g.ldb + C) * 2u; vA[0][i] = (unsigned)(R * g.lda + C) * 2u; vA[1][i] = (unsigned)((R + HALF) * g.lda + C) * 2u; vN[0][i] = vA[0][i]; vN[1][i] = vA[1][i]; }
    const size_t kstep = (size_t)(BK * 2);
    const size_t hstepB = (size_t)HALF * g.ldb * 2;
    const unsigned ldsw = (unsigned)wid * 1024u;
    const int aoff = FP8 ? lds_byte(wr * 64 + fr, fq * 16) : lds_byte(wr * 64 + fr, fq * 8), boff = FP8 ? lds_byte(wc * 32 + fr, fq * 16) : lds_byte(wc * 32 + fr, fq * 8);
    constexpr int kstr = FP8 ? 16 : 1024;
#define PG8_SA(b, h) (((b) * 2 + (h)) * HTB)
#define PG8_SB(b, h) ((4 + (b) * 2 + (h)) * HTB)
#define PG8_STAGE(bufoff, gbase, voff) do { _Pragma("unroll") for (int _i = 0; _i < 2; ++_i) \
        __builtin_amdgcn_global_load_lds((const unsigned*)((const char*)(gbase) + (voff)[_i]), (PG8_LAS unsigned*)(lds + (bufoff) + ldsw + _i * 8192), 16, 0, 0); } while (0)
#define PG8_LDA(dst, b, h) do { _Pragma("unroll") for (int m = 0; m < 4; ++m) _Pragma("unroll") for (int k = 0; k < 2; ++k) dst[m][k] = *(const PG8_LAS bf16x8*)(lds + PG8_SA(b, h) + aoff + m * 2048 + k * kstr); } while (0)
#define PG8_LDB(dst, b, h) do { _Pragma("unroll") for (int n = 0; n < 2; ++n) _Pragma("unroll") for (int k = 0; k < 2; ++k) dst[n][k] = *(const PG8_LAS bf16x8*)(lds + PG8_SB(b, h) + boff + n * 2048 + k * kstr); } while (0)
#define PG8_MMA(ai, bj, At, Bt) do { __builtin_amdgcn_s_setprio(1); _Pragma("unroll") for (int m = 0; m < 4; ++m) _Pragma("unroll") for (int n = 0; n < 2; ++n) { \
        if constexpr (FP8) mfma8(acc[ai][bj][m][n], cat8(Bt[n][0], Bt[n][1]), cat8(At[m][0], At[m][1]), one8); \
        else { _Pragma("unroll") for (int k = 0; k < 2; ++k) acc[ai][bj][m][n] = __builtin_amdgcn_mfma_f32_16x16x32_bf16(Bt[n][k], At[m][k], acc[ai][bj][m][n], 0, 0, 0); } } \
        __builtin_amdgcn_s_setprio(0); } while (0)
#define PG8_WAIT_V(n) asm volatile("s_waitcnt vmcnt(" #n ")" ::: "memory")
#define PG8_WAIT_L(n) asm volatile("s_waitcnt lgkmcnt(" #n ")" ::: "memory")
#define PG8_BAR __builtin_amdgcn_s_barrier()
#define PG8_SCHED __builtin_amdgcn_sched_barrier(0)
    int one8 = 0x7f7f7f7f; asm volatile("" : "+v"(one8));
    Unit cur, nxt; int ui = 0;
    if (!S.next(0, cur)) return;
    f32x4 acc[2][2][4][2];
#pragma unroll
    for (int a = 0; a < 2; ++a)
#pragma unroll
        for (int b = 0; b < 2; ++b)
#pragma unroll
            for (int m = 0; m < 4; ++m)
#pragma unroll
                for (int n = 0; n < 2; ++n) acc[a][b][m][n] = (f32x4){0.f, 0.f, 0.f, 0.f};
    bf16x8 At[4][2], B0[2][2], B1[2][2];
    const char* cA; const char* cB; S.ptrs(cur, cA, cB);
    if constexpr (Sched::GATHER) S.rows(cur, Rr, Cc, vA);
    PG8_STAGE(PG8_SB(0, 0), cB, voffB); PG8_STAGE(PG8_SB(0, 1), cB + hstepB, voffB); PG8_STAGE(PG8_SA(0, 0), cA, vA[0]); PG8_STAGE(PG8_SA(0, 1), cA, vA[1]);
    if (wr == 1) PG8_BAR;
    PG8_WAIT_V(2); PG8_BAR;
    PG8_STAGE(PG8_SB(1, 0), cB + kstep, voffB); PG8_STAGE(PG8_SA(1, 0), cA + kstep, vA[0]); PG8_STAGE(PG8_SB(1, 1), cB + hstepB + kstep, voffB);
    PG8_WAIT_V(6); PG8_BAR;
    for (;;) {
        const bool has_next = S.next(ui + 1, nxt);
        const char* nA = cA; const char* nB = cB;
        if (has_next) { S.ptrs(nxt, nA, nB); if constexpr (Sched::GATHER) S.rows(nxt, Rr, Cc, vN); }
        else { if constexpr (Sched::GATHER) {
#pragma unroll
            for (int h = 0; h < 2; ++h)
#pragma unroll
                for (int i = 0; i < 2; ++i) vN[h][i] = vA[h][i]; } }
        for (int t = 0; t < nt; t += 2) {
            const bool last = (t == nt - 2);
            if constexpr (Epi::MID_T > 0) { if (t == Epi::MID_T) E.mid(acc, cur, wr, wc, fr, fq); }
            const char* a1 = cA + (size_t)(t + 1) * kstep;
            const char* a2 = last ? nA : cA + (size_t)(t + 2) * kstep; const char* b2 = last ? nB : cB + (size_t)(t + 2) * kstep;
            const char* a3 = a2 + kstep; const char* b3 = b2 + kstep;
            PG8_LDB(B0, 0, 0); PG8_LDB(B1, 0, 1); PG8_SCHED; PG8_LDA(At, 0, 0); PG8_STAGE(PG8_SA(1, 1), a1, vA[1]);
            PG8_WAIT_V(8); PG8_WAIT_L(0); PG8_BAR; PG8_MMA(0, 0, At, B0); PG8_MMA(0, 1, At, B1); PG8_BAR; PG8_SCHED;
            if constexpr (Sched::GATHER) { if (last) {
#pragma unroll
                for (int h = 0; h < 2; ++h)
#pragma unroll
                    for (int i = 0; i < 2; ++i) vA[h][i] = vN[h][i]; } }
            PG8_LDA(At, 0, 1); PG8_STAGE(PG8_SB(0, 0), b2, voffB); PG8_STAGE(PG8_SB(0, 1), b2 + hstepB, voffB); PG8_STAGE(PG8_SA(0, 0), a2, vA[0]);
            PG8_WAIT_V(8); PG8_WAIT_L(0); PG8_BAR; PG8_MMA(1, 0, At, B0); PG8_MMA(1, 1, At, B1); PG8_BAR; PG8_SCHED;
            PG8_LDB(B0, 1, 0); PG8_LDB(B1, 1, 1); PG8_SCHED; PG8_LDA(At, 1, 0); PG8_STAGE(PG8_SA(0, 1), a2, vA[1]);
            PG8_WAIT_V(8); PG8_WAIT_L(0); PG8_BAR; PG8_MMA(0, 0, At, B0); PG8_MMA(0, 1, At, B1); PG8_BAR; PG8_SCHED;
            PG8_LDA(At, 1, 1); PG8_STAGE(PG8_SB(1, 0), b3, voffB); PG8_STAGE(PG8_SB(1, 1), b3 + hstepB, voffB); PG8_STAGE(PG8_SA(1, 0), a3, vA[0]);
            PG8_WAIT_V(8); PG8_WAIT_L(0); PG8_BAR; PG8_MMA(1, 0, At, B0); PG8_MMA(1, 1, At, B1); PG8_BAR; PG8_SCHED;
        }
        if constexpr (ALIGN_EPI) { if (wr == 0) PG8_BAR; }
        if constexpr (FP8) MFMA_DRAIN();
        if constexpr (!Epi::AFTER_DRAIN) { E(acc, cur, wr, wc, fr, fq); }
        if (!has_next) break;
#pragma unroll
        for (int a = 0; a < 2; ++a)
#pragma unroll
            for (int b = 0; b < 2; ++b)
#pragma unroll
                for (int m = 0; m < 4; ++m)
#pragma unroll
                    for (int n = 0; n < 2; ++n) acc[a][b][m][n] = (f32x4){0.f, 0.f, 0.f, 0.f};
        cur = nxt; cA = nA; cB = nB; ++ui;
        if constexpr (ALIGN_EPI) { if (wr == 1) PG8_BAR; }
    }
    PG8_WAIT_V(0);
    if constexpr (!ALIGN_EPI) { if (wr == 0) PG8_BAR; }
    PG8_BAR;
    if constexpr (Epi::AFTER_DRAIN) { E.fused(acc, cur, wr, wc, fr, fq, lds, wid, lane); }
#undef PG8_SA
#undef PG8_SB
#undef PG8_STAGE
#undef PG8_LDA
#undef PG8_LDB
#undef PG8_MMA
#undef PG8_WAIT_V
#undef PG8_WAIT_L
#undef PG8_BAR
#undef PG8_SCHED
}

struct EpiInProj {
    static constexpr bool PERM = true, AFTER_DRAIN = false; static constexpr int MID_T = 0;
    bf16_t* R0; size_t rs; const float* b_gate; int skip;
    __device__ __forceinline__ void operator()(const f32x4 (&acc)[2][2][4][2], const Unit& u, int wr, int wc, int fr, int fq) const {
        const int row0 = u.pm * BM + wr * 64 + fr, cc = wc * 32 + 8 * fq;
        if (skip) return;
        if (u.pn >= 20) {
            const int ch = (u.pn - 20) * 128 + cc;
            f32x4 ba[2], bb[2];
#pragma unroll
            for (int n = 0; n < 2; ++n) { ba[n] = *(const f32x4*)(b_gate + ch + 4 * n); bb[n] = *(const f32x4*)(b_gate + 1024 + ch + 4 * n); }
#pragma unroll
            for (int ai = 0; ai < 2; ++ai)
#pragma unroll
                for (int m = 0; m < 4; ++m) {
                    const f32x4 a0 = sig4(acc[ai][0][m][0] + ba[0]), a1 = sig4(acc[ai][0][m][1] + ba[1]), g0 = sig4(acc[ai][1][m][0] + bb[0]), g1 = sig4(acc[ai][1][m][1] + bb[1]);
                    f32x4 r0, r1;
#pragma unroll
                    for (int j = 0; j < 4; ++j) { r0[j] = a0[j] * __builtin_amdgcn_rcpf(g0[j]); r1[j] = a1[j] * __builtin_amdgcn_rcpf(g1[j]); }
                    u32x4 w; w.x = cvt_pk_bf16(r0[0], r0[1]); w.y = cvt_pk_bf16(r0[2], r0[3]); w.z = cvt_pk_bf16(r1[0], r1[1]); w.w = cvt_pk_bf16(r1[2], r1[3]);
                    const size_t o = (size_t)(row0 + ai * HALF + m * 16) * 1024 + ch;
                    *(u32x4*)(R0 + 3 * rs + o) = w;
                    w.x = cvt_pk_bf16(g0[0], g0[1]); w.y = cvt_pk_bf16(g0[2], g0[3]); w.z = cvt_pk_bf16(g1[0], g1[1]); w.w = cvt_pk_bf16(g1[2], g1[3]);
                    *(u32x4*)(R0 + 4 * rs + o) = w; }
        } else if (u.pn < 16) {
            const bool sg = u.pn >= 8; bf16_t* O = R0 + (size_t)(sg ? 1 : 0) * rs + (u.pn & 7) * 128 + cc;
#pragma unroll
            for (int ai = 0; ai < 2; ++ai)
#pragma unroll
                for (int m = 0; m < 4; ++m) {
                    f32x4 b0 = acc[ai][1][m][0], b1 = acc[ai][1][m][1];
                    if (sg) { b0 = sig4(b0); b1 = sig4(b1); }
                    const f32x4 v0 = acc[ai][0][m][0] * b0, v1 = acc[ai][0][m][1] * b1;
                    u32x4 w; w.x = cvt_pk_bf16(v0[0], v0[1]); w.y = cvt_pk_bf16(v0[2], v0[3]); w.z = cvt_pk_bf16(v1[0], v1[1]); w.w = cvt_pk_bf16(v1[2], v1[3]);
                    *(u32x4*)(O + (size_t)(row0 + ai * HALF + m * 16) * 1024) = w; }
        } else {
            const int ct = (u.pn - 16) * 256 + cc;
            bf16_t* O = R0 + (size_t)2 * rs + ct;
#pragma unroll
            for (int ai = 0; ai < 2; ++ai)
#pragma unroll
                for (int m = 0; m < 4; ++m)
#pragma unroll
                    for (int bj = 0; bj < 2; ++bj) {
                        const f32x4 v0 = acc[ai][bj][m][0], v1 = acc[ai][bj][m][1];
                        u32x4 w; w.x = cvt_pk_bf16(v0[0], v0[1]); w.y = cvt_pk_bf16(v0[2], v0[3]); w.z = cvt_pk_bf16(v1[0], v1[1]); w.w = cvt_pk_bf16(v1[2], v1[3]);
                        *(u32x4*)(O + (size_t)(row0 + ai * HALF + m * 16) * 1024 + bj * HALF) = w; }
        }
    }
};

struct EpiMix {
    static constexpr bool PERM = true, AFTER_DRAIN = false; static constexpr int MID_T = 16;
    const bf16_t *GA, *GB; bf16_t* MIX;
    __device__ __forceinline__ void mid(f32x4 (&acc)[2][2][4][2], const Unit& u, int wr, int wc, int fr, int fq) const {
        int row0 = u.pm * BM + wr * 64 + fr, col0 = u.pn * BM + wc * 32 + 8 * fq;
        asm volatile("" : "+v"(row0), "+v"(col0));
#pragma unroll
        for (int ai = 0; ai < 2; ++ai)
#pragma unroll
            for (int m = 0; m < 4; ++m)
#pragma unroll
                for (int bj = 0; bj < 2; ++bj) { const size_t o = (size_t)(row0 + ai * HALF + m * 16) * 1024 + col0 + bj * HALF;
                    const u32x4 gr = *(const u32x4*)(GA + o);
                    acc[ai][bj][m][0] *= bfx4((u32x2){gr.x, gr.y}); acc[ai][bj][m][1] *= bfx4((u32x2){gr.z, gr.w});
                    asm volatile("" : "+v"(acc[ai][bj][m][0]), "+v"(acc[ai][bj][m][1]) :: "memory"); }
    }
    __device__ __forceinline__ void operator()(const f32x4 (&acc)[2][2][4][2], const Unit& u, int wr, int wc, int fr, int fq) const {
        const int row0 = u.pm * BM + wr * 64 + fr, col0 = u.pn * BM + wc * 32 + 8 * fq;
#pragma unroll
        for (int ai = 0; ai < 2; ++ai)
#pragma unroll
            for (int m = 0; m < 4; ++m)
#pragma unroll
                for (int bj = 0; bj < 2; ++bj) { const size_t o = (size_t)(row0 + ai * HALF + m * 16) * 1024 + col0 + bj * HALF;
                    const u32x4 gb = *(const u32x4*)(GB + o);
                    const f32x4 v0 = acc[ai][bj][m][0] * bfx4((u32x2){gb.x, gb.y}), v1 = acc[ai][bj][m][1] * bfx4((u32x2){gb.z, gb.w});
                    u32x4 w; w.x = cvt_pk_bf16(v0[0], v0[1]); w.y = cvt_pk_bf16(v0[2], v0[3]); w.z = cvt_pk_bf16(v1[0], v1[1]); w.w = cvt_pk_bf16(v1[2], v1[3]);
                    *(u32x4*)(MIX + o) = w; asm volatile("" ::: "memory"); }
    }
};
__device__ __forceinline__ unsigned cvt4_fp8(float a, float b, float c, float d) { int w = __builtin_amdgcn_cvt_pk_fp8_f32(a, b, 0, false); w = __builtin_amdgcn_cvt_pk_fp8_f32(c, d, w, true); return (unsigned)w; }
struct EpiWo {
    static constexpr bool PERM = true, AFTER_DRAIN = false; static constexpr int MID_T = 0;
    const float* x; bf16_t* APLE; unsigned char* X8; float* ssp;
    __device__ __forceinline__ void operator()(const f32x4 (&acc)[2][2][4][2], const Unit& u, int wr, int wc, int fr, int fq) const {
        const int row0 = u.pm * BM + wr * 64 + fr, col0 = u.pn * BM + wc * 32 + 8 * fq;
#pragma unroll
        for (int ai = 0; ai < 2; ++ai)
#pragma unroll
            for (int m = 0; m < 4; ++m) { const int row = row0 + ai * HALF + m * 16; float ss = 0.f;
#pragma unroll
                for (int bj = 0; bj < 2; ++bj) { const size_t o = (size_t)row * 1024 + col0 + bj * HALF;
                    const f32x4 v0 = *(const f32x4*)(x + o) + acc[ai][bj][m][0], v1 = *(const f32x4*)(x + o + 4) + acc[ai][bj][m][1];
                    ss += ((v0[0] * v0[0] + v0[1] * v0[1]) + (v0[2] * v0[2] + v0[3] * v0[3])) + ((v1[0] * v1[0] + v1[1] * v1[1]) + (v1[2] * v1[2] + v1[3] * v1[3]));
                    u32x4 w; w.x = cvt_pk_bf16(v0[0], v0[1]); w.y = cvt_pk_bf16(v0[2], v0[3]); w.z = cvt_pk_bf16(v1[0], v1[1]); w.w = cvt_pk_bf16(v1[2], v1[3]);
                    *(u32x4*)(APLE + (size_t)row * 1280 + 256 + col0 + bj * HALF) = w;
                    u32x2 q; q.x = cvt4_fp8(v0[0], v0[1], v0[2], v0[3]); q.y = cvt4_fp8(v1[0], v1[1], v1[2], v1[3]);
                    *(u32x2*)(X8 + o) = q; }
                ss += __shfl_xor(ss, 16); ss += __shfl_xor(ss, 32);
                if (fq == 0) ssp[(size_t)row * 16 + u.pn * 4 + wc] = ss; }
    }
};
struct EpiRouter {
    static constexpr bool PERM = false, AFTER_DRAIN = true; static constexpr int MID_T = 0;
    const float* ssp1; const float* brg; const float* bre; unsigned* cnt; int* tok_e; float* tok_w; int* tok_pos; float* r1; int* ltok; float* lw; float* lr;
    __device__ __forceinline__ void fused(f32x4 (&acc)[2][2][4][2], const Unit& u, int wr, int wc, int fr, int fq, PG8_LAS unsigned char* lds, int wid, int lane) const {
        PG8_LAS float* L = (PG8_LAS float*)lds;
        PG8_LAS int* hist = (PG8_LAS int*)(lds + 40960);
        const int tid = wid * 64 + lane;
        if (tid < 64) hist[tid] = 0;
        if (wc == 0) {
#pragma unroll
            for (int ai = 0; ai < 2; ++ai)
#pragma unroll
                for (int m = 0; m < 4; ++m)
#pragma unroll
                    for (int n = 0; n < 2; ++n) *(PG8_LAS f32x4*)(L + (ai * HALF + wr * 64 + m * 16 + fr) * 40 + 16 * n + 4 * fq) = acc[ai][0][m][n];
        } else if (wc == 1 && fq == 0) {
#pragma unroll
            for (int ai = 0; ai < 2; ++ai)
#pragma unroll
                for (int m = 0; m < 4; ++m) *(PG8_LAS f32x4*)(L + (ai * HALF + wr * 64 + m * 16 + fr) * 40 + 32) = acc[ai][0][m][0];
        }
        asm volatile("s_waitcnt lgkmcnt(0)" ::: "memory"); __builtin_amdgcn_s_barrier(); asm volatile("" ::: "memory");
        int ea = 0, eb = 0, la = 0, lb = 0; float wa_ = 0.f, wb_ = 0.f, r = 0.f; const int t = u.pm * BM + tid;
        if (tid < 256) {
            float ss = 0.f;
#pragma unroll
            for (int i = 0; i < 16; i += 4) { const f32x4 pv = *(const f32x4*)(ssp1 + (size_t)t * 16 + i); ss += (pv[0] + pv[1]) + (pv[2] + pv[3]); }
            r = rsqrtf(ss * (1.f / 1024.f) + 1e-6f);
            float lg[40];
#pragma unroll
            for (int i = 0; i < 36; i += 4) { const f32x4 v = *(const PG8_LAS f32x4*)(L + tid * 40 + i); lg[i] = v[0]; lg[i + 1] = v[1]; lg[i + 2] = v[2]; lg[i + 3] = v[3]; }
            float gl[4]; int grp = 0;
#pragma unroll
            for (int i = 0; i < 4; ++i) gl[i] = lg[i] * r + brg[i];
            float gm = gl[0];
#pragma unroll
            for (int i = 1; i < 4; ++i) if (gl[i] > gm) { gm = gl[i]; grp = i; }
            float den = 0.f;
#pragma unroll
            for (int i = 0; i < 4; ++i) den += __expf(gl[i] - gm);
            const float pg = 1.f / den;
            float el[8];
#pragma unroll
            for (int i = 0; i < 8; ++i) { float v = 0.f;
#pragma unroll
                for (int g2 = 0; g2 < 4; ++g2) v = (grp == g2) ? lg[4 + g2 * 8 + i] * r + bre[g2 * 8 + i] : v;
                el[i] = v; }
            int i0 = 0; float v0 = el[0];
#pragma unroll
            for (int i = 1; i < 8; ++i) if (el[i] > v0) { v0 = el[i]; i0 = i; }
            int i1 = -1; float v1 = -3.0e38f;
#pragma unroll
            for (int i = 0; i < 8; ++i) if (i != i0 && el[i] > v1) { v1 = el[i]; i1 = i; }
            const float e1 = __expf(v1 - v0); const float s0 = 1.f / (1.f + e1), s1 = e1 / (1.f + e1);
            ea = grp * 8 + i0; eb = grp * 8 + i1; wa_ = s0 * pg; wb_ = s1 * pg;
            la = __hip_atomic_fetch_add(&hist[ea], 1, __ATOMIC_RELAXED, __HIP_MEMORY_SCOPE_WORKGROUP); lb = __hip_atomic_fetch_add(&hist[eb], 1, __ATOMIC_RELAXED, __HIP_MEMORY_SCOPE_WORKGROUP);
        }
        asm volatile("s_waitcnt lgkmcnt(0)" ::: "memory"); __builtin_amdgcn_s_barrier(); asm volatile("" ::: "memory");
        if (tid < 32) { const int h = hist[tid]; hist[32 + tid] = h ? (int)atomicAdd(cnt + tid, (unsigned)h) : 0; }
        asm volatile("s_waitcnt vmcnt(0) lgkmcnt(0)" ::: "memory"); __builtin_amdgcn_s_barrier(); asm volatile("" ::: "memory");
        if (tid < 256) {
            const int pa = hist[32 + ea] + la, pb = hist[32 + eb] + lb;
            tok_e[t * 2] = ea; tok_e[t * 2 + 1] = eb; tok_w[t * 2] = wa_; tok_w[t * 2 + 1] = wb_; tok_pos[t * 2] = pa; tok_pos[t * 2 + 1] = pb; r1[t] = r;
            ltok[(size_t)ea * 32768 + pa] = t; lw[(size_t)ea * 32768 + pa] = wa_; lr[(size_t)ea * 32768 + pa] = r;
            ltok[(size_t)eb * 32768 + pb] = t; lw[(size_t)eb * 32768 + pb] = wb_; lr[(size_t)eb * 32768 + pb] = r;
        }
    }
};
template <bool GATHER_> struct MoeOrder {
    static constexpr bool GATHER = GATHER_;
    const PG8_LAS int* tab; int nwg, G, c; const char* A; const char* Bt; size_t bexp, btile; int lda; const int* ltok;
    __device__ __forceinline__ bool next(int i, Unit& u) const {
        const long L = (long)i * G + c; if (L >= nwg) return false;
        int wgid = (int)L; { const int q = nwg / NXCD, r = nwg % NXCD, xcd = wgid % NXCD, off = wgid / NXCD; wgid = (xcd < r ? xcd * (q + 1) : r * (q + 1) + (xcd - r) * q) + off; }
        int e = 0;
        for (int k = 1; k < 32; ++k) e += (__builtin_amdgcn_readfirstlane(tab[k]) <= wgid) ? 1 : 0;
        const int rem = wgid - __builtin_amdgcn_readfirstlane(tab[e]);
        u.pn = rem & 3; u.pm = rem >> 2; u.e = e; u.nrow = __builtin_amdgcn_readfirstlane(tab[80 + e]) - 256 * u.pm; u.slot0 = __builtin_amdgcn_readfirstlane(tab[40 + e]) + 256 * u.pm; return true;
    }
    __device__ __forceinline__ void ptrs(const Unit& u, const char*& cA, const char*& cB) const {
        cA = GATHER ? A : A + (size_t)u.slot0 * lda * 2; cB = Bt + (size_t)u.e * bexp + (size_t)u.pn * btile; }
    __device__ __forceinline__ void rows(const Unit& u, const int (&Rr)[2], const int (&Cc)[2], unsigned (&off)[2][2]) const {
#pragma unroll
        for (int h = 0; h < 2; ++h)
#pragma unroll
            for (int i = 0; i < 2; ++i) { const int r = h * HALF + Rr[i]; const int tok = (r < u.nrow) ? ltok[(size_t)u.e * 32768 + 256 * u.pm + r] : 0; off[h][i] = (unsigned)(tok * lda + Cc[i]) * 2u; }
    }
};
constexpr float SW1 = 32.f, SW2 = 16.f, SH = 4.f;
struct EpiMoeUp {
    static constexpr bool PERM = true, AFTER_DRAIN = false; static constexpr int MID_T = 0;
    const float* lr; unsigned char* HMID8;
    __device__ __forceinline__ void operator()(const f32x4 (&acc)[2][2][4][2], const Unit& u, int wr, int wc, int fr, int fq) const {
        const int cc = u.pn * 128 + wc * 32 + 8 * fq;
#pragma unroll
        for (int ai = 0; ai < 2; ++ai)
#pragma unroll
            for (int m = 0; m < 4; ++m) { const int row = ai * HALF + wr * 64 + m * 16 + fr;
                if (row < u.nrow) { const float r = lr[(size_t)u.e * 32768 + 256 * u.pm + row] * (1.f / SW1);
                    f32x4 v[2];
#pragma unroll
                    for (int n = 0; n < 2; ++n)
#pragma unroll
                        for (int j = 0; j < 4; ++j) { const float g = acc[ai][0][m][n][j] * r, up = acc[ai][1][m][n][j] * r; v[n][j] = g * fsig(g) * up * SH; }
                    u32x2 q; q.x = cvt4_fp8(v[0][0], v[0][1], v[0][2], v[0][3]); q.y = cvt4_fp8(v[1][0], v[1][1], v[1][2], v[1][3]);
                    *(u32x2*)(HMID8 + (size_t)(u.slot0 + row) * 512 + cc) = q; } }
    }
};
struct EpiMoeDown {
    static constexpr bool PERM = true, AFTER_DRAIN = false; static constexpr int MID_T = 0;
    const float* lw; bf16_t* YB;
    __device__ __forceinline__ void operator()(const f32x4 (&acc)[2][2][4][2], const Unit& u, int wr, int wc, int fr, int fq) const {
        const int cc = u.pn * 256 + wc * 32 + 8 * fq;
#pragma unroll
        for (int ai = 0; ai < 2; ++ai)
#pragma unroll
            for (int m = 0; m < 4; ++m) { const int row = ai * HALF + wr * 64 + m * 16 + fr;
                if (row < u.nrow) { const float gw = lw[(size_t)u.e * 32768 + 256 * u.pm + row] * (1.f / (SH * SW2));
#pragma unroll
                    for (int bj = 0; bj < 2; ++bj) { const f32x4 v0 = acc[ai][bj][m][0] * gw, v1 = acc[ai][bj][m][1] * gw;
                        u32x4 w; w.x = cvt_pk_bf16(v0[0], v0[1]); w.y = cvt_pk_bf16(v0[2], v0[3]); w.z = cvt_pk_bf16(v1[0], v1[1]); w.w = cvt_pk_bf16(v1[2], v1[3]);
                        *(u32x4*)(YB + (size_t)(u.slot0 + row) * 1024 + cc + bj * HALF) = w; } } }
    }
};
struct EpiPle {
    static constexpr bool PERM = false, AFTER_DRAIN = false; static constexpr int MID_T = 4;
    const bf16_t* APLE; const float* r2; bf16_t* X3; float* ssp; u32x2* scr;
    __device__ __forceinline__ void mid(f32x4 (&acc)[2][2][4][2], const Unit&, int, int, int, int) const {
        int tid = threadIdx.x;
        asm volatile("" : "+v"(tid));
#pragma unroll
        for (int ai = 0; ai < 2; ++ai)
#pragma unroll
            for (int bj = 0; bj < 2; ++bj)
#pragma unroll
                for (int m = 0; m < 4; ++m)
#pragma unroll
                    for (int n = 0; n < 2; ++n) { const f32x4 v = acc[ai][bj][m][n]; u32x2 w; w.x = cvt_pk_bf16(v[0], v[1]); w.y = cvt_pk_bf16(v[2], v[3]);
                        scr[(((ai * 2 + bj) * 4 + m) * 2 + n) * 512 + tid] = w; acc[ai][bj][m][n] = (f32x4){0.f, 0.f, 0.f, 0.f}; asm volatile("" ::: "memory"); }
    }
    __device__ __forceinline__ void operator()(const f32x4 (&acc)[2][2][4][2], const Unit& u, int wr, int wc, int fr, int fq) const {
        int tid = threadIdx.x; int row0 = u.pm * BM + wr * 64 + fr, col0 = u.pn * BM + wc * 32 + 4 * fq;
        asm volatile("" : "+v"(tid), "+v"(row0), "+v"(col0));
#pragma unroll
        for (int ai = 0; ai < 2; ++ai)
#pragma unroll
            for (int m = 0; m < 4; ++m) { const int row = row0 + ai * HALF + m * 16; const float rr = r2[row]; float ss = 0.f;
#pragma unroll
                for (int bj = 0; bj < 2; ++bj)
#pragma unroll
                    for (int n = 0; n < 2; ++n) { const size_t o = (size_t)row * 1024 + col0 + bj * HALF + n * 16;
                        const f32x4 pr = bfx4(scr[(((ai * 2 + bj) * 4 + m) * 2 + n) * 512 + tid]); const f32x4 a = acc[ai][bj][m][n] * rr;
                        const f32x4 v = bfx4(*(const u32x2*)(APLE + (size_t)row * 1280 + 256 + col0 + bj * HALF + n * 16)) + sig4(a) * pr;
                        u32x2 w; w.x = cvt_pk_bf16(v[0], v[1]); w.y = cvt_pk_bf16(v[2], v[3]);
                        *(u32x2*)(X3 + o) = w; ss += (v[0] * v[0] + v[1] * v[1]) + (v[2] * v[2] + v[3] * v[3]); }
                ss += __shfl_xor(ss, 16); ss += __shfl_xor(ss, 32);
                if (fq == 0) ssp[(size_t)row * 16 + u.pn * 4 + wc] = ss; asm volatile("" ::: "memory"); }
    }
};
}

#define GAS __attribute__((address_space(1)))
#define LAS __attribute__((address_space(3)))
typedef unsigned v4u __attribute__((ext_vector_type(4)));
typedef GAS unsigned gu32;
constexpr int NWAVES = 8;
constexpr int RING_BYTES = 131072, LDSCTL_OFF = RING_BYTES + 4096, MISC_OFF = LDSCTL_OFF + 320, LDS_BYTES = 147456;
constexpr size_t WS_WIN = 12 * MiB, WS_WAB = 26 * MiB, WS_WO = 30 * MiB, WS_WPLE = 32 * MiB, WS_WR = 35 * MiB, WS_WGU = 36 * MiB, WS_WD = 100 * MiB;
constexpr size_t WS_LR = 132 * MiB;
constexpr size_t WS_SCR = 464 * MiB;
constexpr size_t WS_END2 = 496 * MiB;
constexpr int CW_BAR = 4096;
#define LDS_WAIT() asm volatile("s_waitcnt lgkmcnt(0)" ::: "memory")
#define VM_WAIT() asm volatile("s_waitcnt vmcnt(0)" ::: "memory")

#define XB_TMO      128
#define XB_XCNT(j)  (256  + 64 * (j))
#define XB_XSUB(j)  (1280 + 64 * (j))
#define XB_XGEN(j)  (2304 + 64 * (j))
#define XB_TOP      3328
#define XB_TOPGEN   3392
#define XCD_BAR_WORDS 3456
#define XB_SPIN_CAP (1u << 18)
__device__ __forceinline__ unsigned xb_ld(unsigned* p)              { return __hip_atomic_load(p, __ATOMIC_RELAXED, __HIP_MEMORY_SCOPE_AGENT); }
__device__ __forceinline__ unsigned xb_add(unsigned* p, unsigned v) { return __hip_atomic_fetch_add(p, v, __ATOMIC_RELAXED, __HIP_MEMORY_SCOPE_AGENT); }
__device__ __forceinline__ unsigned xb_xcc_id() { return (unsigned)__builtin_amdgcn_s_getreg((3 << 11) | 20) & 0xFu; }
#define XB_SPIN(cond, bar) do { unsigned _sp = 0; while (cond) { __builtin_amdgcn_s_sleep(1); \
    if ((++_sp & 255u) == 0u) { if (xb_ld(&(bar)[XB_TMO])) break; if (_sp > XB_SPIN_CAP) { atomicAdd(&(bar)[XB_TMO], 1u); break; } } } } while (0)
struct XcdBarrier { unsigned* bar; unsigned x; volatile LAS unsigned* st; };
__device__ __forceinline__ XcdBarrier xcd_barrier_post(unsigned* bar, volatile LAS unsigned* st) {
    XcdBarrier b; b.bar = bar; b.x = xb_xcc_id(); b.st = st;
    if (threadIdx.x == 0) (void)xb_add(&bar[XB_XCNT(b.x)], 1u);
    return b;
}
__device__ __forceinline__ void xcd_barrier_complete(unsigned* bar, unsigned x, unsigned& nloc, unsigned& nx) {
    const unsigned G = gridDim.x * gridDim.y * gridDim.z;
    unsigned sum, cnt, mine, sp = 0u;
    for (;;) {
        sum = 0u; cnt = 0u; mine = 0u;
#pragma unroll
        for (unsigned j = 0; j < 16; ++j) { const unsigned c = xb_ld(&bar[XB_XCNT(j)]); sum += c; cnt += (c > 0u) ? 1u : 0u; mine = (j == x) ? c : mine; }
        if (sum == G) break;
        __builtin_amdgcn_s_sleep(1);
        if ((++sp & 255u) == 0u) { if (xb_ld(&bar[XB_TMO])) break; if (sp > XB_SPIN_CAP) { atomicAdd(&bar[XB_TMO], 1u); break; } }
    }
    nloc = mine > 0u ? mine : 1u; nx = cnt > 0u ? cnt : 1u;
}
__device__ __forceinline__ void xcd_barrier(const XcdBarrier& b) {
    asm volatile("s_waitcnt vmcnt(0)" ::: "memory");
    __syncthreads();
    if (threadIdx.x == 0) {
        unsigned* bar = b.bar;
        __builtin_amdgcn_s_waitcnt(0);
        unsigned nloc = b.st[0], nx = b.st[1];
        if (nloc == 0u) { xcd_barrier_complete(bar, b.x, nloc, nx); b.st[0] = nloc; b.st[1] = nx; }
        const unsigned old = xb_add(&bar[XB_XSUB(b.x)], 1u);
        const unsigned gen = old / nloc;
        if (old + 1u == (gen + 1u) * nloc) {
            __builtin_amdgcn_fence(__ATOMIC_RELEASE, "agent");
            asm volatile("s_waitcnt vmcnt(0)" ::: "memory");
            const unsigned og = xb_add(&bar[XB_TOP], 1u);
            const unsigned tg = og / nx;
            if (og + 1u == (tg + 1u) * nx) xb_add(&bar[XB_TOPGEN], 1u);
            else XB_SPIN(xb_ld(&bar[XB_TOPGEN]) == tg, bar);
            __builtin_amdgcn_fence(__ATOMIC_ACQUIRE, "agent");
            xb_add(&bar[XB_XGEN(b.x)], 1u);
            asm volatile("s_waitcnt vmcnt(0)" ::: "memory");
        } else {
            XB_SPIN(xb_ld(&bar[XB_XGEN(b.x)]) == gen, bar);
            __builtin_amdgcn_fence(__ATOMIC_ACQUIRE, "agent");
            asm volatile("s_waitcnt vmcnt(0)" ::: "memory");
        }
    }
    __syncthreads();
}

__device__ __forceinline__ unsigned pk2(float lo, float hi) { return f2bf(lo) | (f2bf(hi) << 16); }
__device__ __forceinline__ void tr_item(const float* __restrict__ W, int ldn, int k0, int n0, bf16* dst, int ldb, int drow0, int dk0, const float* __restrict__ scale, LAS float* scr, int lane) {
    const int lr_ = lane >> 4, lc = (lane & 15) * 4;
    float4 v[16];
#pragma unroll
    for (int i = 0; i < 16; ++i) v[i] = *(const float4*)(W + (size_t)(k0 + 4 * i + lr_) * ldn + n0 + lc);
#pragma unroll
    for (int i = 0; i < 16; ++i) { const int kk = 4 * i + lr_; const float sc = scale ? scale[k0 + kk] : 1.f; LAS float* d = scr + kk * 65 + lc;
        d[0] = v[i].x * sc; d[1] = v[i].y * sc; d[2] = v[i].z * sc; d[3] = v[i].w * sc; }
    LDS_WAIT(); asm volatile("" ::: "memory");
    const int c = lane & 7;
#pragma unroll
    for (int j = 0; j < 8; ++j) { const int n = (lane >> 3) + 8 * j; const LAS float* s_ = scr + (8 * c) * 65 + n;
        v4u o; o.x = pk2(s_[0 * 65], s_[1 * 65]); o.y = pk2(s_[2 * 65], s_[3 * 65]); o.z = pk2(s_[4 * 65], s_[5 * 65]); o.w = pk2(s_[6 * 65], s_[7 * 65]);
        *(GAS v4u*)(dst + (size_t)(drow0 + n) * ldb + dk0 + k0 + 8 * c) = o; }
    LDS_WAIT(); asm volatile("" ::: "memory");
}
__device__ __forceinline__ void tr_item8(const float* __restrict__ W, int ldn, int k0, int n0, unsigned char* dst, int ldb, int drow0, const float* __restrict__ scale, float mul, LAS float* scr, int lane) {
    const int lr_ = lane >> 4, lc = (lane & 15) * 4;
    float4 v[16];
#pragma unroll
    for (int i = 0; i < 16; ++i) v[i] = *(const float4*)(W + (size_t)(k0 + 4 * i + lr_) * ldn + n0 + lc);
#pragma unroll
    for (int i = 0; i < 16; ++i) { const int kk = 4 * i + lr_; const float sc = (scale ? scale[k0 + kk] : 1.f) * mul; LAS float* d = scr + kk * 65 + lc;
        d[0] = v[i].x * sc; d[1] = v[i].y * sc; d[2] = v[i].z * sc; d[3] = v[i].w * sc; }
    LDS_WAIT(); asm volatile("" ::: "memory");
    const int c = lane & 7;
#pragma unroll
    for (int j = 0; j < 8; ++j) { const int n = (lane >> 3) + 8 * j; const LAS float* s_ = scr + (8 * c) * 65 + n;
        uint2 o; o.x = pg8::cvt4_fp8(s_[0 * 65], s_[1 * 65], s_[2 * 65], s_[3 * 65]); o.y = pg8::cvt4_fp8(s_[4 * 65], s_[5 * 65], s_[6 * 65], s_[7 * 65]);
        *(uint2*)(dst + (size_t)(drow0 + n) * ldb + k0 + 8 * c) = o; }
    LDS_WAIT(); asm volatile("" ::: "memory");
}
__device__ __forceinline__ int map_in(int n0) {
    const int q = n0 >> 7, s = q >> 3, i = q & 7, off = n0 & 127;
    if (s == 0) return 4096 + 128 * i + off;
    if (s == 1) return 256 * i + off;
    if (s == 2) return 256 * i + 128 + off;
    if (s == 3) return 256 * (8 + i) + off;
    if (s == 4) return 256 * (8 + i) + 128 + off;
    if (s == 5) return 5120 + 256 * i + off;
    return 5120 + 256 * i + 128 + off;
}

struct Args { const float* in[25]; float* out; unsigned char* ws; int ph_lo, ph_hi; };

__global__ void __launch_bounds__(NWAVES * 64, 2) mega(Args args) {
    extern __shared__ __attribute__((aligned(16))) unsigned char lds_raw[];
    LAS unsigned char* lds = (LAS unsigned char*)lds_raw;
    volatile LAS unsigned* MISC = (volatile LAS unsigned*)(lds + MISC_OFF);
    const int tid = threadIdx.x, lane = tid & 63, wave = __builtin_amdgcn_readfirstlane(tid >> 6);
    const int G = gridDim.x; const int bx = blockIdx.x; const int vcu = (G % 8 == 0) ? (bx % 8) * (G / 8) + bx / 8 : bx;
    unsigned char* ws = args.ws;
    gu32* ctl = (gu32*)(ws + WS_CTL);
    for (int u = tid; u < (LDS_BYTES - LDSCTL_OFF) / 4; u += NWAVES * 64) ((LAS unsigned*)(lds + LDSCTL_OFF))[u] = 0u;
    __syncthreads();
    XcdBarrier bar = xcd_barrier_post((unsigned*)(ctl + CW_BAR), MISC + 8);
    const int lo = args.ph_lo, hi = args.ph_hi;
#ifndef PH_MASK
#define PH_MASK 0x7ff
#endif
#define IN(k) (((PH_MASK >> (k)) & 1) && lo <= (k) && (k) < hi)
#define BOTH(k) (IN(k) && (IN((k) + 1) || rep_ + 1 < NREP(k)))
#ifndef REP_MASK
#define REP_MASK 0
#endif
#ifndef PROBE_SKIP_EPI
#define PROBE_SKIP_EPI 0
#endif
#define NREP(k) (((REP_MASK >> (k)) & 1) ? 2 : 1)
#ifndef PROBE_TS
#define PROBE_TS -1
#endif
    unsigned long long ts_acc_ = 0ull, ts_t0_ = 0ull;
#define TS_B(k) do { if (PROBE_TS == (k) && bx == 0 && tid == 0) ts_t0_ = __builtin_amdgcn_s_memrealtime(); } while (0)
#define TS_E(k) do { if (PROBE_TS == (k) && bx == 0 && tid == 0) ts_acc_ += __builtin_amdgcn_s_memrealtime() - ts_t0_; } while (0)
#define PHASE(k) if (IN(k)) _Pragma("unroll") for (int rep_ = 0; rep_ < NREP(k); ++rep_)
    const float* x = args.in[0];
    bf16* H = (bf16*)args.out;
    bf16* WinT = (bf16*)(ws + WS_WIN); bf16* WabT = (bf16*)(ws + WS_WAB); bf16* WoT = (bf16*)(ws + WS_WO); bf16* WpleT = (bf16*)(ws + WS_WPLE); bf16* WrT = (bf16*)(ws + WS_WR);
    unsigned char* Wgu8 = ws + WS_WGU; unsigned char* Wd8 = ws + WS_WD;
    bf16* UA = (bf16*)(ws + WS_RA); bf16* UB = (bf16*)(ws + WS_RB); bf16* AB = (bf16*)(ws + WS_RC); bf16* GA = (bf16*)(ws + WS_RD); bf16* GB = (bf16*)(ws + WS_RE);

    TS_B(0);
    PHASE(0) {
        LAS float* scr = (LAS float*)(lds + wave * 16640);
        const int gw = vcu * NWAVES + wave, NGW = G * NWAVES;
        constexpr int I_IN = 16 * 112, I_SQ = 16 * 16, I_PP = 4 * 16, I_EG = 32 * 16 * 8, I_ED = 32 * 8 * 16;
        constexpr int NITEMS = I_IN + 4 * I_SQ + I_PP + 2 * I_EG;
        for (int it = gw; it < NITEMS; it += NGW) {
            int r = it;
            if (r < 2 * I_EG) { const int up = r >= I_EG; if (up) r -= I_EG; const int e = r / 128, q = r % 128, kb = q / 8, nb = q % 8, n0 = 64 * nb;
                tr_item8((up ? args.in[19] : args.in[18]) + (size_t)e * D * DE, DE, 64 * kb, n0, Wgu8 + (size_t)e * 1024 * 1024, 1024, 256 * (n0 >> 7) + (up ? 128 : 0) + (n0 & 127), args.in[13], pg8::SW1, scr, lane); continue; } r -= 2 * I_EG;
            if (r < I_IN) { const int kb = r / 112, nb = r % 112; tr_item(args.in[3], INC, 64 * kb, 64 * nb, WinT, 1024, map_in(64 * nb), 0, nullptr, scr, lane); continue; } r -= I_IN;
            if (r < I_SQ) { tr_item(args.in[5], D, 64 * (r / 16), 64 * (r % 16), WabT, 2048, 64 * (r % 16), 0, nullptr, scr, lane); continue; } r -= I_SQ;
            if (r < I_SQ) { tr_item(args.in[10], D, 64 * (r / 16), 64 * (r % 16), WabT, 2048, 64 * (r % 16), 1024, nullptr, scr, lane); continue; } r -= I_SQ;
            if (r < I_SQ) { tr_item(args.in[12], D, 64 * (r / 16), 64 * (r % 16), WoT, 1024, 64 * (r % 16), 0, nullptr, scr, lane); continue; } r -= I_SQ;
            if (r < I_SQ) { tr_item(args.in[22], D, 64 * (r / 16), 64 * (r % 16), WpleT, 1280, 64 * (r % 16), 256, args.in[21], scr, lane); continue; } r -= I_SQ;
            tr_item(args.in[23], D, 64 * (r / 16), 64 * (r % 16), WpleT, 1280, 64 * (r % 16), 0, nullptr, scr, lane);
        }
        for (int i = vcu * 512 + tid; i < 256 * 1024; i += G * 512) { const int rr = i >> 10, k = i & 1023; float v = 0.f;
            if (rr < 4) v = args.in[14][k * 4 + rr] * args.in[13][k]; else if (rr < 36) v = args.in[16][k * 32 + rr - 4] * args.in[13][k];
            WrT[i] = (bf16)f2bf(v); }
        const float* g = args.in[2];
        for (int row = 2 * gw; row < T; row += 2 * NGW) {
            const float4* xr = (const float4*)(x + (size_t)row * D);
            float4 v[2][4]; float s0 = 0.f, s1 = 0.f;
#pragma unroll
            for (int j = 0; j < 4; ++j) { v[0][j] = xr[lane + 64 * j]; v[1][j] = xr[256 + lane + 64 * j]; }
#pragma unroll
            for (int j = 0; j < 4; ++j) { s0 += v[0][j].x * v[0][j].x + v[0][j].y * v[0][j].y + v[0][j].z * v[0][j].z + v[0][j].w * v[0][j].w;
                                          s1 += v[1][j].x * v[1][j].x + v[1][j].y * v[1][j].y + v[1][j].z * v[1][j].z + v[1][j].w * v[1][j].w; }
            const float r0 = rsqrtf(wave_sum(s0) * (1.f / D) + EPS), r1_ = rsqrtf(wave_sum(s1) * (1.f / D) + EPS);
#pragma unroll
            for (int j = 0; j < 4; ++j) { const int c = 4 * (lane + 64 * j); const float4 gg = *(const float4*)(g + c);
                uint2 o; o.x = pk2(v[0][j].x * r0 * gg.x, v[0][j].y * r0 * gg.y); o.y = pk2(v[0][j].z * r0 * gg.z, v[0][j].w * r0 * gg.w);
                *(uint2*)(H + (size_t)row * D + c) = o;
                o.x = pk2(v[1][j].x * r1_ * gg.x, v[1][j].y * r1_ * gg.y); o.y = pk2(v[1][j].z * r1_ * gg.z, v[1][j].w * r1_ * gg.w);
                *(uint2*)(H + (size_t)(row + 1) * D + c) = o; }
        }
        if (BOTH(0)) xcd_barrier(bar);
    }
    TS_E(0);
    TS_B(1);
    PHASE(1) {
        pg8::Gemm g{1024, 1024, 1024}; pg8::StaticOrder S; S.init(T, INC, G, bx, H, 1024, WinT, 1024);
        pg8::EpiInProj E{UA, (size_t)(WS_RB - WS_RA) / 2, args.in[11], (PROBE_SKIP_EPI && rep_ == 1) ? (args.ph_hi > 5 ? 1 : 0) : 0};
        pg8::gemm_phase<pg8::EpiInProj, pg8::StaticOrder, true>(lds, g, S, E);
        if (BOTH(1)) xcd_barrier(bar);
    }
    TS_E(1);

    bf16* ZZ = (bf16*)args.out; bf16* MIX = (bf16*)(ws + WS_RC); bf16* APLE = (bf16*)(ws + WS_RA);
    unsigned char* HMID8 = ws + WS_RC; bf16* YB = (bf16*)(ws + WS_RD); bf16* X3 = (bf16*)(ws + WS_RC); unsigned char* X8 = ws + WS_RB + 16 * MiB;
    int* tok_e = (int*)(ws + WS_TOK); float* tok_w = (float*)(ws + WS_TOK + 256 * 1024); int* tok_pos = (int*)(ws + WS_TOK + 512 * 1024);
    float* r1 = (float*)(ws + WS_TOK + 768 * 1024); float* r2 = (float*)(ws + WS_TOK + 896 * 1024);
    float* ssp1 = (float*)(ws + WS_SSP1); float* ssp3 = (float*)(ws + WS_SSP3); int* ltok = (int*)(ws + WS_LTOK); float* lw = (float*)(ws + WS_LW); float* lr = (float*)(ws + WS_LR);
    unsigned* cnt = (unsigned*)(ctl + CW_CNT);
    LAS int* tab = (LAS int*)(lds + LDSCTL_OFF + 1024);
#define MOE_TABLES() do { if (tid == 0) { int us = 0, es = 0; for (int e = 0; e < NE; ++e) { const int c = (int)cnt[e]; tab[e] = us; tab[40 + e] = es; tab[80 + e] = c; us += 4 * ((c + 255) >> 8); es += c; } tab[32] = us; tab[72] = es; } \
        LDS_WAIT(); __syncthreads(); } while (0)

    TS_B(2);
    PHASE(2) {
        typedef float f32x2 __attribute__((ext_vector_type(2)));
        const int c0_ = 2 * tid;
        const float* cwb = args.in[6]; const float* cwa = args.in[4];
        LAS float* red = (LAS float*)(lds + LDSCTL_OFF + 4096); LAS float* tot = (LAS float*)(lds + LDSCTL_OFF + 4096 + 2048);
        const int upw = (1024 + G - 1) / G;
        bool have_prev = false;
        for (int un = vcu * upw; un < (vcu + 1) * upw && un < 1024; ++un) {
            const int t0 = un * 32; const bool first = (t0 & (SEQ - 1)) == 0;
            int c0 = c0_; asm volatile("" : "+v"(c0));
            {
                const int rlo = (have_prev || first) ? 0 : -30;
                const int npieces = (32 - rlo) * 128;
                v4u pc[16];
#pragma unroll
                for (int i = 0; i < 16; ++i) { const int pidx = tid + 512 * i; if (pidx < npieces) { const int row = t0 + rlo + (pidx >> 7);
                        pc[i] = *(const v4u*)(UB + (size_t)row * 1024 + (pidx & 127) * 8); } }
#pragma unroll
                for (int i = 0; i < 16; ++i) { const int pidx = tid + 512 * i; if (pidx < npieces) { const int row = t0 + rlo + (pidx >> 7);
                        *(LAS v4u*)(lds + (row & 63) * 2048 + (pidx & 127) * 16) = pc[i]; } }
            }
            f32x2 wb[31];
#pragma unroll
            for (int k = 0; k < 31; ++k) wb[k] = *(const f32x2*)(cwb + k * 1024 + c0);
            const f32x2 bb = *(const f32x2*)(args.in[7] + c0);
            LDS_WAIT(); __syncthreads();
            f32x2 acc[32];
#pragma unroll
            for (int j = 0; j < 32; ++j) acc[j] = bb;
            const int sb = (t0 + 34) & 63;
#pragma unroll
            for (int si = 0; si < 62; ++si) {
                const bool dead = first && si < 30;
                const unsigned w = *(const LAS unsigned*)(lds + ((sb + si) & 63) * 2048 + tid * 4);
                f32x2 uv = (f32x2){__builtin_bit_cast(float, w << 16), __builtin_bit_cast(float, w & 0xffff0000u)};
                if (dead) uv = (f32x2){0.f, 0.f};
#pragma unroll
                for (int j = (si > 30 ? si - 30 : 0); j <= (si < 31 ? si : 31); ++j) acc[j] += wb[si - j] * uv;
                if ((si & 7) == 7) asm volatile("" ::: "memory");
            }
            float v1[32], v2[32];
#pragma unroll
            for (int j = 0; j < 32; ++j) { v1[j] = acc[j].x + acc[j].y; v2[j] = acc[j].x * acc[j].x + acc[j].y * acc[j].y; }
#define BFLY(v, NN, bit) _Pragma("unroll") for (int i = 0; i < (NN) / 2; ++i) { const bool up_ = (lane & (bit)) != 0; const float keep_ = up_ ? v[i + (NN) / 2] : v[i], send_ = up_ ? v[i] : v[i + (NN) / 2]; v[i] = keep_ + __shfl_xor(send_, (bit)); }
            BFLY(v1, 32, 16) BFLY(v1, 16, 8) BFLY(v1, 8, 4) BFLY(v1, 4, 2) BFLY(v1, 2, 1)
            BFLY(v2, 32, 16) BFLY(v2, 16, 8) BFLY(v2, 8, 4) BFLY(v2, 4, 2) BFLY(v2, 2, 1)
#undef BFLY
            v1[0] += __shfl_xor(v1[0], 32); v2[0] += __shfl_xor(v2[0], 32);
            red[wave * 64 + lane] = lane < 32 ? v1[0] : v2[0];
            LDS_WAIT(); __syncthreads();
            if (tid < 64) { float sm = 0.f;
#pragma unroll
                for (int w8 = 0; w8 < 8; ++w8) sm += red[w8 * 64 + tid];
                tot[tid] = sm; }
            LDS_WAIT(); __syncthreads();
            asm volatile("" : "+v"(c0));
            unsigned rua[34], rab[32];
#pragma unroll
            for (int j = 0; j < 34; ++j) rua[j] = *(const unsigned*)(UA + (size_t)((first && j < 2) ? t0 : t0 - 2 + j) * 1024 + c0);
#pragma unroll
            for (int j = 0; j < 32; ++j) rab[j] = *(const unsigned*)(AB + (size_t)(t0 + j) * 1024 + c0);
            const f32x2 lg = *(const f32x2*)(args.in[8] + c0), lb = *(const f32x2*)(args.in[9] + c0);
#pragma unroll
            for (int j = 0; j < 32; ++j) { const float mu = tot[j] * (1.f / 1024.f); const float var = tot[32 + j] * (1.f / 1024.f) - mu * mu; const float rstd = rsqrtf(var + EPS);
                const f32x2 y = (acc[j] - mu) * rstd * lg + lb;
                *(unsigned*)(ZZ + (size_t)(t0 + j) * 2048 + 1024 + c0) = pg8::cvt_pk_bf16(y.x * pg8::fsig(y.x), y.y * pg8::fsig(y.y)); }
            asm volatile("" : "+v"(c0));
            const f32x2 wa0 = *(const f32x2*)(cwa + c0), wa1 = *(const f32x2*)(cwa + 1024 + c0), wa2 = *(const f32x2*)(cwa + 2048 + c0);
#define BF2(w_) ((f32x2){__builtin_bit_cast(float, (w_) << 16), __builtin_bit_cast(float, (w_) & 0xffff0000u)})
            if (first) { rua[0] = 0u; rua[1] = 0u; }
#pragma unroll
            for (int j = 0; j < 32; ++j) { const f32x2 za = BF2(rab[j]) * (wa0 * BF2(rua[j]) + wa1 * BF2(rua[j + 1]) + wa2 * BF2(rua[j + 2]));
                *(unsigned*)(ZZ + (size_t)(t0 + j) * 2048 + c0) = pg8::cvt_pk_bf16(za.x, za.y); }
#undef BF2
            have_prev = true;
        }
        if (BOTH(2)) xcd_barrier(bar);
    }
    TS_E(2);
    TS_B(3);
    PHASE(3) {
        pg8::Gemm g{2048, 2048, 2048}; pg8::StaticOrder S; S.init(T, D, G, bx, ZZ, 2048, WabT, 2048);
        pg8::EpiMix E{GA, GB, MIX};
        pg8::gemm_phase<pg8::EpiMix, pg8::StaticOrder, true>(lds, g, S, E);
        if (BOTH(3)) xcd_barrier(bar);
    }
    TS_E(3);
    TS_B(4);
    PHASE(4) {
        pg8::Gemm g{1024, 1024, 1024}; pg8::StaticOrder S; S.init(T, D, G, bx, MIX, 1024, WoT, 1024);
        pg8::EpiWo E{x, APLE, X8, ssp1};
        pg8::gemm_phase<pg8::EpiWo, pg8::StaticOrder, true>(lds, g, S, E);
        if (BOTH(4)) xcd_barrier(bar);
    }
    TS_E(4);
    TS_B(5);
    PHASE(5) {
        pg8::Gemm g{1280, 1024, 1024}; pg8::StaticOrder S; S.init(T, 256, G, bx, APLE + 256, 1280, WrT, 1024);
        pg8::EpiRouter E{ssp1, args.in[15], args.in[17], cnt, tok_e, tok_w, tok_pos, r1, ltok, lw, lr};
        pg8::gemm_phase<pg8::EpiRouter, pg8::StaticOrder, false>(lds, g, S, E);
        const int nidle = G > 128 ? G - 128 : G, me = G > 128 ? bx - 128 : bx;
        if (me >= 0) { const float* p = args.in[1];
            { LAS float* scr = (LAS float*)(lds + wave * 16640);
              for (int r = me * NWAVES + wave; r < 32 * 8 * 16; r += nidle * NWAVES) { const int e = r / 128, q = r % 128, kb = q / 16, nb = q % 16;
                  tr_item8(args.in[20] + (size_t)e * DE * D, D, 64 * kb, 64 * nb, Wd8 + (size_t)e * 1024 * 512, 512, 64 * nb, nullptr, pg8::SW2, scr, lane); } }
            const size_t stride = (size_t)nidle * 512;
            for (size_t i0 = (size_t)me * 512 + tid; i0 < (size_t)T * 64; i0 += 8 * stride) {
                float4 v[8];
#pragma unroll
                for (int q = 0; q < 8; ++q) { const size_t i = i0 + q * stride; if (i < (size_t)T * 64) v[q] = *(const float4*)(p + (i >> 6) * PLE + (int)(i & 63) * 4); }
#pragma unroll
                for (int q = 0; q < 8; ++q) { const size_t i = i0 + q * stride; if (i < (size_t)T * 64) { uint2 o; o.x = pk2(v[q].x, v[q].y); o.y = pk2(v[q].z, v[q].w); *(uint2*)(APLE + (i >> 6) * APITCH + (int)(i & 63) * 4) = o; } }
            } }
        if (BOTH(5)) xcd_barrier(bar);
    }
    TS_E(5);
    TS_B(6);
    PHASE(6) {
        MOE_TABLES();
        pg8::Gemm g{512, 512, 512};
        pg8::MoeOrder<true> S{tab, tab[32], G, bx, (const char*)X8, (const char*)Wgu8, (size_t)1024 * 1024, (size_t)256 * 1024, 512, ltok};
        pg8::EpiMoeUp E{lr, HMID8};
        pg8::gemm_phase<pg8::EpiMoeUp, pg8::MoeOrder<true>, true, true>(lds, g, S, E);
        if (BOTH(6)) xcd_barrier(bar);
    }
    TS_E(6);
    TS_B(7);
    PHASE(7) {
        MOE_TABLES();
        pg8::Gemm g{256, 256, 256};
        pg8::MoeOrder<false> S{tab, tab[32], G, bx, (const char*)HMID8, (const char*)Wd8, (size_t)1024 * 512, (size_t)256 * 512, 256, ltok};
        pg8::EpiMoeDown E{lw, YB};
        pg8::gemm_phase<pg8::EpiMoeDown, pg8::MoeOrder<false>, true, true>(lds, g, S, E);
        if (BOTH(7)) xcd_barrier(bar);
    }
    TS_E(7);
    TS_B(8);
    PHASE(8) {
        MOE_TABLES();
        const int gw = vcu * NWAVES + wave, NGW = G * NWAVES;
        for (int t = 2 * gw; t < T; t += 2 * NGW) {
            int sl[2][2];
#pragma unroll
            for (int q = 0; q < 2; ++q) { const int4 te = *(const int4*)(tok_e + t * 2), tp = *(const int4*)(tok_pos + t * 2);
                sl[0][0] = tab[40 + te.x] + tp.x; sl[0][1] = tab[40 + te.y] + tp.y; sl[1][0] = tab[40 + te.z] + tp.z; sl[1][1] = tab[40 + te.w] + tp.w; }
            v4u xv[2][2], ya[2][2], yb[2][2];
#pragma unroll
            for (int q = 0; q < 2; ++q)
#pragma unroll
                for (int j = 0; j < 2; ++j) { const int c = 8 * (lane + 64 * j);
                    xv[q][j] = *(const v4u*)(APLE + (size_t)(t + q) * APITCH + 256 + c); ya[q][j] = *(const v4u*)(YB + (size_t)sl[q][0] * D + c); yb[q][j] = *(const v4u*)(YB + (size_t)sl[q][1] * D + c); }
#pragma unroll
            for (int q = 0; q < 2; ++q) { float s_ = 0.f;
#pragma unroll
                for (int j = 0; j < 2; ++j) { const int c = 8 * (lane + 64 * j); v4u o;
#pragma unroll
                    for (int k = 0; k < 4; ++k) { const float lo = bf2f(xv[q][j][k] & 0xffff) + bf2f(ya[q][j][k] & 0xffff) + bf2f(yb[q][j][k] & 0xffff), hi = bf2f(xv[q][j][k] >> 16) + bf2f(ya[q][j][k] >> 16) + bf2f(yb[q][j][k] >> 16);
                        s_ += lo * lo + hi * hi; o[k] = pk2(lo, hi); }
                    *(v4u*)(APLE + (size_t)(t + q) * APITCH + 256 + c) = o; }
                s_ = wave_sum(s_);
                if (lane == 0) r2[t + q] = rsqrtf(s_ * (1.f / D) + EPS); }
        }
        if (BOTH(8)) xcd_barrier(bar);
    }
    TS_E(8);
    TS_B(9);
    PHASE(9) {
        pg8::Gemm g{1280, 1280, 1280}; pg8::StaticOrder S; S.init(T, D, G, bx, APLE, 1280, WpleT, 1280);
        pg8::EpiPle E{APLE, r2, X3, ssp3, (pg8::u32x2*)(ws + WS_SCR + (size_t)bx * 131072)};
        pg8::gemm_phase<pg8::EpiPle, pg8::StaticOrder, true>(lds, g, S, E);
        if (BOTH(9)) xcd_barrier(bar);
    }
    TS_E(9);
    TS_B(10);
    PHASE(10) {
        const int gw = vcu * NWAVES + wave, NGW = G * NWAVES; const float* gfin = args.in[24];
        for (int row = 2 * gw; row < T; row += 2 * NGW) {
            float ss0 = lane < 16 ? ssp3[(size_t)row * 16 + lane] : 0.f, ss1 = lane < 16 ? ssp3[(size_t)(row + 1) * 16 + lane] : 0.f;
            uint2 w[2][4];
#pragma unroll
            for (int j = 0; j < 4; ++j) { const int c = 4 * (lane + 64 * j); w[0][j] = *(const uint2*)(X3 + (size_t)row * D + c); w[1][j] = *(const uint2*)(X3 + (size_t)(row + 1) * D + c); }
            ss0 = wave_sum(ss0); ss1 = wave_sum(ss1);
            const float r0 = rsqrtf(ss0 * (1.f / D) + EPS), r1_ = rsqrtf(ss1 * (1.f / D) + EPS);
#pragma unroll
            for (int j = 0; j < 4; ++j) { const int c = 4 * (lane + 64 * j); const float4 gg = *(const float4*)(gfin + c);
                *(float4*)(args.out + (size_t)row * D + c) = make_float4(bf2f(w[0][j].x & 0xffff) * r0 * gg.x, bf2f(w[0][j].x >> 16) * r0 * gg.y, bf2f(w[0][j].y & 0xffff) * r0 * gg.z, bf2f(w[0][j].y >> 16) * r0 * gg.w);
                *(float4*)(args.out + (size_t)(row + 1) * D + c) = make_float4(bf2f(w[1][j].x & 0xffff) * r1_ * gg.x, bf2f(w[1][j].x >> 16) * r1_ * gg.y, bf2f(w[1][j].y & 0xffff) * r1_ * gg.z, bf2f(w[1][j].y >> 16) * r1_ * gg.w); }
        }
    }
    TS_E(10);
    if (PROBE_TS >= 0 && bx == 0 && tid == 0) { const unsigned long long t1_ = __builtin_amdgcn_s_memrealtime(); while (__builtin_amdgcn_s_memrealtime() - t1_ < 4ull * ts_acc_) __builtin_amdgcn_s_sleep(8); }
#undef MOE_TABLES
#undef IN
#undef BOTH
}


#ifndef OPT_UPTO
#define OPT_UPTO 11
#endif
extern "C" void kernel_launch(void* const* d_in, const int* in_sizes, int n_in, void* d_out, int out_size, void* d_ws, size_t ws_size, hipStream_t stream) {
    static int grid = 0;
    if (grid == 0) {
        if (n_in != 25 || in_sizes[0] != T * D || out_size != T * D || ws_size < WS_END2) { fprintf(stderr, "kernel_launch: unexpected shapes (n_in %d, in0 %d, out %d, ws %zu)\n", n_in, n_in > 0 ? in_sizes[0] : -1, out_size, ws_size); grid = -1; return; }
        int dev = 0, cus = 0, per_cu = 0;
        if (hipGetDevice(&dev) != hipSuccess || hipDeviceGetAttribute(&cus, hipDeviceAttributeMultiprocessorCount, dev) != hipSuccess) { fprintf(stderr, "kernel_launch: device query failed\n"); grid = -1; return; }
        if (hipFuncSetAttribute((const void*)mega, hipFuncAttributeMaxDynamicSharedMemorySize, LDS_BYTES) != hipSuccess) { fprintf(stderr, "kernel_launch: hipFuncSetAttribute failed\n"); grid = -1; return; }
        if (hipOccupancyMaxActiveBlocksPerMultiprocessor(&per_cu, (const void*)mega, NWAVES * 64, LDS_BYTES) != hipSuccess || per_cu < 1) { fprintf(stderr, "kernel_launch: occupancy query says %d blocks per CU\n", per_cu); (void)hipGetLastError(); grid = -1; return; }
        grid = cus;
    }
    if (grid < 0) return;
    const float* x = (const float*)d_in[0]; const float* p = (const float*)d_in[1];
    const float* conv_a_w = (const float*)d_in[4]; const float* w_out_a = (const float*)d_in[5]; const float* conv_b_w = (const float*)d_in[6]; const float* conv_b_b = (const float*)d_in[7];
    const float* ln_b_g = (const float*)d_in[8]; const float* ln_b_b = (const float*)d_in[9]; const float* w_out_b = (const float*)d_in[10];
    const float* w_o = (const float*)d_in[12]; const float* ffn_g = (const float*)d_in[13]; const float* w_rg = (const float*)d_in[14]; const float* b_rg = (const float*)d_in[15];
    const float* w_re = (const float*)d_in[16]; const float* b_re = (const float*)d_in[17]; const float* w_eg = (const float*)d_in[18]; const float* w_eu = (const float*)d_in[19];
    const float* w_ed = (const float*)d_in[20]; const float* ple_g = (const float*)d_in[21]; const float* w_pg = (const float*)d_in[22]; const float* w_pp = (const float*)d_in[23];
    const float* fin_g = (const float*)d_in[24];
    unsigned char* ws = (unsigned char*)d_ws; float* out = (float*)d_out;
    unsigned* ctl = (unsigned*)(ws + WS_CTL);
    int* tok_e = (int*)(ws + WS_TOK); float* tok_w = (float*)(ws + WS_TOK + 256 * 1024); int* tok_pos = (int*)(ws + WS_TOK + 512 * 1024);
    float* r1 = (float*)(ws + WS_TOK + 768 * 1024); float* r2 = (float*)(ws + WS_TOK + 896 * 1024);
    float* ssp1 = (float*)(ws + WS_SSP1); int* ltok = (int*)(ws + WS_LTOK); float* lw = (float*)(ws + WS_LW);
    bf16* UA = (bf16*)(ws + WS_RA); bf16* UB = (bf16*)(ws + WS_RB); bf16* AB = (bf16*)(ws + WS_RC); bf16* GA = (bf16*)(ws + WS_RD); bf16* GB = (bf16*)(ws + WS_RE);
    bf16* ZZ = (bf16*)d_out; bf16* MIX = (bf16*)(ws + WS_RC); float* X1 = (float*)(ws + WS_RA); bf16* APLE = (bf16*)(ws + WS_RA);
    bf16* HMID = (bf16*)(ws + WS_RC); bf16* YB = (bf16*)(ws + WS_RD); float* X3 = (float*)(ws + WS_RC);

    if (hipMemsetAsync(ws + WS_CTL, 0, 1 * MiB, stream) != hipSuccess) { fprintf(stderr, "kernel_launch: memset failed\n"); return; }
    Args a{};
    for (int i = 0; i < 25; ++i) a.in[i] = (const float*)d_in[i];
    a.out = out; a.ws = ws; a.ph_lo = 0; a.ph_hi = OPT_UPTO;
    void* kargs[] = {&a};
    const hipError_t le = hipLaunchCooperativeKernel((const void*)mega, dim3(grid), dim3(NWAVES * 64), kargs, LDS_BYTES, stream);
    if (le != hipSuccess) { fprintf(stderr, "kernel_launch: cooperative launch failed: %s (grid %d)\n", hipGetErrorString(le), grid); return; }
#if OPT_UPTO < 11
    if (OPT_UPTO <= 1) nv_inproj<<<dim3(T / 8, 4), 256, 0, stream>>>((const bf16*)d_out, (const float*)d_in[3], (const float*)d_in[11], UA, UB, AB, GA, GB);
    if (OPT_UPTO <= 2) nv_conv<<<T, 256, 0, stream>>>(UA, UB, AB, conv_a_w, conv_b_w, conv_b_b, ln_b_g, ln_b_b, ZZ);
    if (OPT_UPTO <= 3) nv_outab<<<dim3(T / 8, 4), 256, 0, stream>>>(ZZ, w_out_a, w_out_b, GA, GB, MIX);
    if (OPT_UPTO <= 4) { nv_wo<<<dim3(T / 8, 4), 256, 0, stream>>>(MIX, w_o, x, X1, APLE); nv_rowss<<<T / 4, 256, 0, stream>>>(X1, ssp1); }
    if (OPT_UPTO <= 5) { nv_router<<<T / 4, 256, 0, stream>>>(X1, ssp1, ffn_g, w_rg, b_rg, w_re, b_re, ctl + CW_CNT, tok_e, tok_w, tok_pos, r1, ltok, lw); nv_pcvt<<<T * PLE / 4 / 256, 256, 0, stream>>>(p, APLE); }
    if (OPT_UPTO <= 6) nv_moe_up<<<dim3(T / 8, NE), 256, 0, stream>>>(X1, r1, ffn_g, w_eg, w_eu, ctl + CW_CNT, ltok, HMID);
    if (OPT_UPTO <= 7) nv_moe_down<<<dim3(T / 8, NE), 256, 0, stream>>>(HMID, w_ed, ctl + CW_CNT, lw, YB);
    if (OPT_UPTO <= 8) nv_combine<<<T / 4, 256, 0, stream>>>(X1, YB, ctl + CW_CNT, tok_e, tok_pos, APLE, r2);
    if (OPT_UPTO <= 9) nv_ple<<<dim3(T / 8, 4), 256, 0, stream>>>(X1, r2, ple_g, w_pg, p, w_pp, X3);
    if (OPT_UPTO <= 10) nv_final<<<T / 4, 256, 0, stream>>>(X3, fin_g, out);
#endif
}
```

```cpp
#include <hip/hip_runtime.h>
#include <cstdio>
#include <cstdint>

typedef unsigned short bf16;
constexpr int T = 32768, D = 1024, SEQ = 2048, PLE = 256, NE = 32, NG = 4, EPG = 8, DE = 512, INC = 7168;
constexpr float EPS = 1e-6f;
constexpr size_t MiB = 1u << 20;
constexpr size_t WS_CTL = 0;
constexpr size_t WS_TOK = 1 * MiB;
constexpr size_t WS_SSP1 = 2 * MiB;
constexpr size_t WS_SSP3 = 4 * MiB;
constexpr size_t WS_LTOK = 6 * MiB;
constexpr size_t WS_LW = 136 * MiB;
constexpr size_t WS_RA = 144 * MiB, WS_RB = 208 * MiB, WS_RC = 272 * MiB, WS_RD = 336 * MiB, WS_RE = 400 * MiB;
constexpr size_t WS_END = 464 * MiB;
constexpr int APITCH = 1280;
constexpr int CW_CNT = 64;

__device__ __forceinline__ unsigned f2bf(float f) { unsigned u = __builtin_bit_cast(unsigned, f); return (u + 0x7fffu + ((u >> 16) & 1u)) >> 16; }
__device__ __forceinline__ float bf2f(unsigned short b) { return __builtin_bit_cast(float, (unsigned)b << 16); }
__device__ __forceinline__ float sigmoidf_(float v) { return 1.f / (1.f + __expf(-v)); }
__device__ __forceinline__ float siluf_(float v) { return v / (1.f + __expf(-v)); }
__device__ __forceinline__ float wave_sum(float v) {
#pragma unroll
    for (int o = 1; o < 64; o <<= 1) v += __shfl_xor(v, o);
    return v;
}

#define REP_MASK 0
#define OPT_UPTO 11
namespace pg8 {
#define PG8_LAS __attribute__((address_space(3)))
typedef unsigned short bf16_t;
typedef short bf16x8 __attribute__((ext_vector_type(8)));
typedef float f32x4 __attribute__((ext_vector_type(4)));
typedef unsigned u32x4 __attribute__((ext_vector_type(4)));
typedef unsigned u32x2 __attribute__((ext_vector_type(2)));
constexpr int BM = 256, BK = 64, HALF = 128, HTB = HALF * BK * 2, STAGE_BYTES = 8 * HTB, NXCD = 8, WGM = 8;
__host__ __device__ __forceinline__ int lds_byte(int r, int c) { const int st = (r >> 4) * 2 + (c >> 5), rr = r & 15, cc = c & 31, ob = rr * 64 + cc * 2; return st * 1024 + (ob ^ (((ob >> 9) & 1) << 5)); }
__host__ __device__ __forceinline__ void stage_rc(int b, int& R, int& C) { const int st = b / 1024, sb = b % 1024, swz = sb ^ (((sb >> 9) & 1) << 5); R = (st >> 1) * 16 + swz / 64; C = (st & 1) * 32 + (swz % 64) / 2; }
__host__ __device__ __forceinline__ int perm32(int rho) { const int n = rho >> 4, i = rho & 15; return 8 * (i >> 2) + 4 * n + (i & 3); }

struct Unit { int pm, pn, e, nrow, slot0; };
struct Gemm { int lda, ldb, K; };

__device__ __forceinline__ unsigned cvt_pk_bf16(float lo, float hi) { unsigned r; asm volatile("v_cvt_pk_bf16_f32 %0, %1, %2" : "=v"(r) : "v"(lo), "v"(hi)); return r; }
__device__ __forceinline__ float fsig(float v) { return __builtin_amdgcn_rcpf(1.f + __expf(-v)); }
__device__ __forceinline__ f32x4 sig4(f32x4 v) { return (f32x4){fsig(v[0]), fsig(v[1]), fsig(v[2]), fsig(v[3])}; }
__device__ __forceinline__ f32x4 bfx4(u32x2 w) { return (f32x4){__builtin_bit_cast(float, w.x << 16), __builtin_bit_cast(float, w.x & 0xffff0000u), __builtin_bit_cast(float, w.y << 16), __builtin_bit_cast(float, w.y & 0xffff0000u)}; }

struct StaticOrder {
    static constexpr bool GATHER = false;
    int nM, nN, nwg, G, c; const char* A; const char* Bt; size_t atile, btile;
    __device__ __forceinline__ void init(int M, int N, int G_, int c_, const void* A_, int lda, const void* Bt_, int ldb) { nM = M / BM; nN = N / BM; nwg = nM * nN; G = G_; c = c_; A = (const char*)A_; Bt = (const char*)Bt_; atile = (size_t)BM * lda * 2; btile = (size_t)BM * ldb * 2; }
    __device__ __forceinline__ bool next(int i, Unit& u) const {
        const long L = (long)i * G + c; if (L >= nwg) return false;
        int wgid = (int)L; { const int q = nwg / NXCD, r = nwg % NXCD, xcd = wgid % NXCD, off = wgid / NXCD; wgid = (xcd < r ? xcd * (q + 1) : r * (q + 1) + (xcd - r) * q) + off; }
        const int nig = WGM * nN, gid = wgid / nig, fm = gid * WGM, gsz = (nM - fm) < WGM ? (nM - fm) : WGM;
        u.pm = fm + ((wgid % nig) % gsz); u.pn = (wgid % nig) / gsz; u.e = 0; u.nrow = 256; u.slot0 = 0; return true;
    }
    __device__ __forceinline__ void ptrs(const Unit& u, const char*& cA, const char*& cB) const { cA = A + (size_t)u.pm * atile; cB = Bt + (size_t)u.pn * btile; }
    __device__ __forceinline__ void rows(const Unit&, const int (&)[2], const int (&)[2], unsigned (&)[2][2]) const {}
};

typedef int v4i_t __attribute__((ext_vector_type(4)));
typedef int v8i_t __attribute__((ext_vector_type(8)));
__device__ __forceinline__ v8i_t cat8(bf16x8 lo, bf16x8 hi) { const v4i_t l = __builtin_bit_cast(v4i_t, lo), h = __builtin_bit_cast(v4i_t, hi); return __builtin_shufflevector(l, h, 0, 1, 2, 3, 4, 5, 6, 7); }
__device__ __forceinline__ void mfma8(f32x4& acc, v8i_t b, v8i_t a, int one) {
    asm volatile("s_nop 1\n\tv_mfma_scale_f32_16x16x128_f8f6f4 %0, %1, %2, %0, %3, %3 op_sel_hi:[0,0,0]" : "+v"(acc) : "v"(b), "v"(a), "v"(one));
}
#define MFMA_DRAIN() asm volatile("s_nop 15\n\ts_nop 7" ::: "memory")
template <class Epi, class Sched, bool ALIGN_EPI, bool FP8 = false>
__device__ __forceinline__ void gemm_phase(PG8_LAS unsigned char* lds, const Gemm g, const Sched& S, const Epi& E) {
    const int tid = threadIdx.x, wid = __builtin_amdgcn_readfirstlane(tid >> 6), lane = tid & 63, wr = wid >> 2, wc = wid & 3, fr = lane & 15, fq = lane >> 4;
    const int K = g.K, nt = K / BK;
    int Rr[2], Cc[2]; unsigned vA[2][2], vN[2][2], voffB[2];
#pragma unroll
    for (int i = 0; i < 2; ++i) { int R, C; stage_rc(tid * 16 + i * 8192, R, C); Rr[i] = R; Cc[i] = C; const int Rb = Epi::PERM ? ((R & ~31) + perm32(R & 31)) : R;
        voffB[i] = (unsigned)(Rb * g.ldb + C) * 2u; vA[0][i] = (unsigned)(R * g.lda + C) * 2u; vA[1][i] = (unsigned)((R + HALF) * g.lda + C) * 2u; vN[0][i] = vA[0][i]; vN[1][i] = vA[1][i]; }
    const size_t kstep = (size_t)(BK * 2);
    const size_t hstepB = (size_t)HALF * g.ldb * 2;
    const unsigned ldsw = (unsigned)wid * 1024u;
    const int aoff = FP8 ? lds_byte(wr * 64 + fr, fq * 16) : lds_byte(wr * 64 + fr, fq * 8), boff = FP8 ? lds_byte(wc * 32 + fr, fq * 16) : lds_byte(wc * 32 + fr, fq * 8);
    constexpr int kstr = FP8 ? 16 : 1024;
#define PG8_SA(b, h) (((b) * 2 + (h)) * HTB)
#define PG8_SB(b, h) ((4 + (b) * 2 + (h)) * HTB)
#define PG8_STAGE(bufoff, gbase, voff) do { _Pragma("unroll") for (int _i = 0; _i < 2; ++_i) \
        __builtin_amdgcn_global_load_lds((const unsigned*)((const char*)(gbase) + (voff)[_i]), (PG8_LAS unsigned*)(lds + (bufoff) + ldsw + _i * 8192), 16, 0, 0); } while (0)
#define PG8_LDA(dst, b, h) do { _Pragma("unroll") for (int m = 0; m < 4; ++m) _Pragma("unroll") for (int k = 0; k < 2; ++k) dst[m][k] = *(const PG8_LAS bf16x8*)(lds + PG8_SA(b, h) + aoff + m * 2048 + k * kstr); } while (0)
#define PG8_LDB(dst, b, h) do { _Pragma("unroll") for (int n = 0; n < 2; ++n) _Pragma("unroll") for (int k = 0; k < 2; ++k) dst[n][k] = *(const PG8_LAS bf16x8*)(lds + PG8_SB(b, h) + boff + n * 2048 + k * kstr); } while (0)
#define PG8_MMA(ai, bj, At, Bt) do { __builtin_amdgcn_s_setprio(1); _Pragma("unroll") for (int m = 0; m < 4; ++m) _Pragma("unroll") for (int n = 0; n < 2; ++n) { \
        if constexpr (FP8) mfma8(acc[ai][bj][m][n], cat8(Bt[n][0], Bt[n][1]), cat8(At[m][0], At[m][1]), one8); \
        else { _Pragma("unroll") for (int k = 0; k < 2; ++k) acc[ai][bj][m][n] = __builtin_amdgcn_mfma_f32_16x16x32_bf16(Bt[n][k], At[m][k], acc[ai][bj][m][n], 0, 0, 0); } } \
        __builtin_amdgcn_s_setprio(0); } while (0)
#define PG8_WAIT_V(n) asm volatile("s_waitcnt vmcnt(" #n ")" ::: "memory")
#define PG8_WAIT_L(n) asm volatile("s_waitcnt lgkmcnt(" #n ")" ::: "memory")
#define PG8_BAR __builtin_amdgcn_s_barrier()
#define PG8_SCHED __builtin_amdgcn_sched_barrier(0)
    int one8 = 0x7f7f7f7f; asm volatile("" : "+v"(one8));
    Unit cur, nxt; int ui = 0;
    if (!S.next(0, cur)) return;
    f32x4 acc[2][2][4][2];
#pragma unroll
    for (int a = 0; a < 2; ++a)
#pragma unroll
        for (int b = 0; b < 2; ++b)
#pragma unroll
            for (int m = 0; m < 4; ++m)
#pragma unroll
                for (int n = 0; n < 2; ++n) acc[a][b][m][n] = (f32x4){0.f, 0.f, 0.f, 0.f};
    bf16x8 At[4][2], B0[2][2], B1[2][2];
    const char* cA; const char* cB; S.ptrs(cur, cA, cB);
    if constexpr (Sched::GATHER) S.rows(cur, Rr, Cc, vA);
    PG8_STAGE(PG8_SB(0, 0), cB, voffB); PG8_STAGE(PG8_SB(0, 1), cB + hstepB, voffB); PG8_STAGE(PG8_SA(0, 0), cA, vA[0]); PG8_STAGE(PG8_SA(0, 1), cA, vA[1]);
    if (wr == 1) PG8_BAR;
    PG8_WAIT_V(2); PG8_BAR;
    PG8_STAGE(PG8_SB(1, 0), cB + kstep, voffB); PG8_STAGE(PG8_SA(1, 0), cA + kstep, vA[0]); PG8_STAGE(PG8_SB(1, 1), cB + hstepB + kstep, voffB);
    PG8_WAIT_V(6); PG8_BAR;
    for (;;) {
        const bool has_next = S.next(ui + 1, nxt);
        const char* nA = cA; const char* nB = cB;
        if (has_next) { S.ptrs(nxt, nA, nB); if constexpr (Sched::GATHER) S.rows(nxt, Rr, Cc, vN); }
        else { if constexpr (Sched::GATHER) {
#pragma unroll
            for (int h = 0; h < 2; ++h)
#pragma unroll
                for (int i = 0; i < 2; ++i) vN[h][i] = vA[h][i]; } }
        for (int t = 0; t < nt; t += 2) {
            const bool last = (t == nt - 2);
            if constexpr (Epi::MID_T > 0) { if (t == Epi::MID_T) { if constexpr (FP8) MFMA_DRAIN(); E.mid(acc, cur, wr, wc, fr, fq); } }
            const char* a1 = cA + (size_t)(t + 1) * kstep;
            const char* a2 = last ? nA : cA + (size_t)(t + 2) * kstep; const char* b2 = last ? nB : cB + (size_t)(t + 2) * kstep;
            const char* a3 = a2 + kstep; const char* b3 = b2 + kstep;
            PG8_LDB(B0, 0, 0); PG8_LDB(B1, 0, 1); PG8_SCHED; PG8_LDA(At, 0, 0); PG8_STAGE(PG8_SA(1, 1), a1, vA[1]);
            PG8_WAIT_V(8); PG8_WAIT_L(0); PG8_BAR; PG8_MMA(0, 0, At, B0); PG8_MMA(0, 1, At, B1); PG8_BAR; PG8_SCHED;
            if constexpr (Sched::GATHER) { if (last) {
#pragma unroll
                for (int h = 0; h < 2; ++h)
#pragma unroll
                    for (int i = 0; i < 2; ++i) vA[h][i] = vN[h][i]; } }
            PG8_LDA(At, 0, 1); PG8_STAGE(PG8_SB(0, 0), b2, voffB); PG8_STAGE(PG8_SB(0, 1), b2 + hstepB, voffB); PG8_STAGE(PG8_SA(0, 0), a2, vA[0]);
            PG8_WAIT_V(8); PG8_WAIT_L(0); PG8_BAR; PG8_MMA(1, 0, At, B0); PG8_MMA(1, 1, At, B1); PG8_BAR; PG8_SCHED;
            PG8_LDB(B0, 1, 0); PG8_LDB(B1, 1, 1); PG8_SCHED; PG8_LDA(At, 1, 0); PG8_STAGE(PG8_SA(0, 1), a2, vA[1]);
            PG8_WAIT_V(8); PG8_WAIT_L(0); PG8_BAR; PG8_MMA(0, 0, At, B0); PG8_MMA(0, 1, At, B1); PG8_BAR; PG8_SCHED;
            PG8_LDA(At, 1, 1); PG8_STAGE(PG8_SB(1, 0), b3, voffB); PG8_STAGE(PG8_SB(1, 1), b3 + hstepB, voffB); PG8_STAGE(PG8_SA(1, 0), a3, vA[0]);
            PG8_WAIT_V(8); PG8_WAIT_L(0); PG8_BAR; PG8_MMA(1, 0, At, B0); PG8_MMA(1, 1, At, B1); PG8_BAR; PG8_SCHED;
        }
        if constexpr (ALIGN_EPI) { if (wr == 0) PG8_BAR; }
        if constexpr (FP8) MFMA_DRAIN();
        if constexpr (!Epi::AFTER_DRAIN) { E(acc, cur, wr, wc, fr, fq); }
        if (!has_next) break;
#pragma unroll
        for (int a = 0; a < 2; ++a)
#pragma unroll
            for (int b = 0; b < 2; ++b)
#pragma unroll
                for (int m = 0; m < 4; ++m)
#pragma unroll
                    for (int n = 0; n < 2; ++n) acc[a][b][m][n] = (f32x4){0.f, 0.f, 0.f, 0.f};
        cur = nxt; cA = nA; cB = nB; ++ui;
        if constexpr (ALIGN_EPI) { if (wr == 1) PG8_BAR; }
    }
    PG8_WAIT_V(0);
    if constexpr (!ALIGN_EPI) { if (wr == 0) PG8_BAR; }
    PG8_BAR;
    if constexpr (Epi::AFTER_DRAIN) { E.fused(acc, cur, wr, wc, fr, fq, lds, wid, lane); }
#undef PG8_SA
#undef PG8_SB
#undef PG8_STAGE
#undef PG8_LDA
#undef PG8_LDB
#undef PG8_MMA
#undef PG8_WAIT_V
#undef PG8_WAIT_L
#undef PG8_BAR
#undef PG8_SCHED
}

struct EpiInProj {
    static constexpr bool PERM = true, AFTER_DRAIN = false; static constexpr int MID_T = 0;
    bf16_t* R0; size_t rs; const float* b_gate; int skip;
    __device__ __forceinline__ void operator()(const f32x4 (&acc)[2][2][4][2], const Unit& u, int wr, int wc, int fr, int fq) const {
        const int row0 = u.pm * BM + wr * 64 + fr, cc = wc * 32 + 8 * fq;
        if (skip) return;
        if (u.pn >= 20) {
            const int ch = (u.pn - 20) * 128 + cc;
            f32x4 ba[2], bb[2];
#pragma unroll
            for (int n = 0; n < 2; ++n) { ba[n] = *(const f32x4*)(b_gate + ch + 4 * n); bb[n] = *(const f32x4*)(b_gate + 1024 + ch + 4 * n); }
#pragma unroll
            for (int ai = 0; ai < 2; ++ai)
#pragma unroll
                for (int m = 0; m < 4; ++m) {
                    const f32x4 a0 = sig4(acc[ai][0][m][0] + ba[0]), a1 = sig4(acc[ai][0][m][1] + ba[1]), g0 = sig4(acc[ai][1][m][0] + bb[0]), g1 = sig4(acc[ai][1][m][1] + bb[1]);
                    f32x4 r0, r1;
#pragma unroll
                    for (int j = 0; j < 4; ++j) { r0[j] = a0[j] * __builtin_amdgcn_rcpf(g0[j]); r1[j] = a1[j] * __builtin_amdgcn_rcpf(g1[j]); }
                    u32x4 w; w.x = cvt_pk_bf16(r0[0], r0[1]); w.y = cvt_pk_bf16(r0[2], r0[3]); w.z = cvt_pk_bf16(r1[0], r1[1]); w.w = cvt_pk_bf16(r1[2], r1[3]);
                    const size_t o = (size_t)(row0 + ai * HALF + m * 16) * 1024 + ch;
                    *(u32x4*)(R0 + 3 * rs + o) = w;
                    w.x = cvt_pk_bf16(g0[0], g0[1]); w.y = cvt_pk_bf16(g0[2], g0[3]); w.z = cvt_pk_bf16(g1[0], g1[1]); w.w = cvt_pk_bf16(g1[2], g1[3]);
                    *(u32x4*)(R0 + 4 * rs + o) = w; }
        } else if (u.pn < 16) {
            const bool sg = u.pn >= 8; bf16_t* O = R0 + (size_t)(sg ? 1 : 0) * rs + (u.pn & 7) * 128 + cc;
#pragma unroll
            for (int ai = 0; ai < 2; ++ai)
#pragma unroll
                for (int m = 0; m < 4; ++m) {
                    f32x4 b0 = acc[ai][1][m][0], b1 = acc[ai][1][m][1];
                    if (sg) { b0 = sig4(b0); b1 = sig4(b1); }
                    const f32x4 v0 = acc[ai][0][m][0] * b0, v1 = acc[ai][0][m][1] * b1;
                    u32x4 w; w.x = cvt_pk_bf16(v0[0], v0[1]); w.y = cvt_pk_bf16(v0[2], v0[3]); w.z = cvt_pk_bf16(v1[0], v1[1]); w.w = cvt_pk_bf16(v1[2], v1[3]);
                    *(u32x4*)(O + (size_t)(row0 + ai * HALF + m * 16) * 1024) = w; }
        } else {
            const int ct = (u.pn - 16) * 256 + cc;
            bf16_t* O = R0 + (size_t)2 * rs + ct;
#pragma unroll
            for (int ai = 0; ai < 2; ++ai)
#pragma unroll
                for (int m = 0; m < 4; ++m)
#pragma unroll
                    for (int bj = 0; bj < 2; ++bj) {
                        const f32x4 v0 = acc[ai][bj][m][0], v1 = acc[ai][bj][m][1];
                        u32x4 w; w.x = cvt_pk_bf16(v0[0], v0[1]); w.y = cvt_pk_bf16(v0[2], v0[3]); w.z = cvt_pk_bf16(v1[0], v1[1]); w.w = cvt_pk_bf16(v1[2], v1[3]);
                        *(u32x4*)(O + (size_t)(row0 + ai * HALF + m * 16) * 1024 + bj * HALF) = w; }
        }
    }
};

struct EpiMix {
    static constexpr bool PERM = true, AFTER_DRAIN = false; static constexpr int MID_T = 16;
    const bf16_t *GA, *GB; bf16_t* MIX;
    __device__ __forceinline__ void mid(f32x4 (&acc)[2][2][4][2], const Unit& u, int wr, int wc, int fr, int fq) const {
        int row0 = u.pm * BM + wr * 64 + fr, col0 = u.pn * BM + wc * 32 + 8 * fq;
        asm volatile("" : "+v"(row0), "+v"(col0));
        u32x4 gb_[2][2];
#pragma unroll
        for (int bj = 0; bj < 2; ++bj) gb_[0][bj] = *(const u32x4*)(GA + (size_t)row0 * 1024 + col0 + bj * HALF);
#pragma unroll
        for (int g = 0; g < 8; ++g) { const int ai = g >> 2, m = g & 3;
            if (g < 7) { const int ai2 = (g + 1) >> 2, m2 = (g + 1) & 3;
#pragma unroll
                for (int bj = 0; bj < 2; ++bj) gb_[(g + 1) & 1][bj] = *(const u32x4*)(GA + (size_t)(row0 + ai2 * HALF + m2 * 16) * 1024 + col0 + bj * HALF); }
            asm volatile("" ::: "memory");
#pragma unroll
            for (int bj = 0; bj < 2; ++bj) { const u32x4 gr = gb_[g & 1][bj];
                acc[ai][bj][m][0] *= bfx4((u32x2){gr.x, gr.y}); acc[ai][bj][m][1] *= bfx4((u32x2){gr.z, gr.w}); }
        }
    }
    __device__ __forceinline__ void operator()(const f32x4 (&acc)[2][2][4][2], const Unit& u, int wr, int wc, int fr, int fq) const {
        int row0 = u.pm * BM + wr * 64 + fr, col0 = u.pn * BM + wc * 32 + 8 * fq;
        asm volatile("" : "+v"(row0), "+v"(col0));
        u32x4 gb_[2][2];
#pragma unroll
        for (int bj = 0; bj < 2; ++bj) gb_[0][bj] = *(const u32x4*)(GB + (size_t)row0 * 1024 + col0 + bj * HALF);
#pragma unroll
        for (int g = 0; g < 8; ++g) { const int ai = g >> 2, m = g & 3;
            if (g < 7) { const int ai2 = (g + 1) >> 2, m2 = (g + 1) & 3;
#pragma unroll
                for (int bj = 0; bj < 2; ++bj) gb_[(g + 1) & 1][bj] = *(const u32x4*)(GB + (size_t)(row0 + ai2 * HALF + m2 * 16) * 1024 + col0 + bj * HALF); }
            asm volatile("" ::: "memory");
#pragma unroll
            for (int bj = 0; bj < 2; ++bj) { const u32x4 gb = gb_[g & 1][bj]; const size_t o = (size_t)(row0 + ai * HALF + m * 16) * 1024 + col0 + bj * HALF;
                const f32x4 v0 = acc[ai][bj][m][0] * bfx4((u32x2){gb.x, gb.y}), v1 = acc[ai][bj][m][1] * bfx4((u32x2){gb.z, gb.w});
                u32x4 w; w.x = cvt_pk_bf16(v0[0], v0[1]); w.y = cvt_pk_bf16(v0[2], v0[3]); w.z = cvt_pk_bf16(v1[0], v1[1]); w.w = cvt_pk_bf16(v1[2], v1[3]);
                *(u32x4*)(MIX + o) = w; }
        }
    }
};
__device__ __forceinline__ unsigned cvt4_fp8(float a, float b, float c, float d) { int w = __builtin_amdgcn_cvt_pk_fp8_f32(a, b, 0, false); w = __builtin_amdgcn_cvt_pk_fp8_f32(c, d, w, true); return (unsigned)w; }
struct EpiWo {
    static constexpr bool PERM = true, AFTER_DRAIN = false; static constexpr int MID_T = 0;
    const float* x; bf16_t* APLE; unsigned char* X8; float* ssp;
    __device__ __forceinline__ void operator()(const f32x4 (&acc)[2][2][4][2], const Unit& u, int wr, int wc, int fr, int fq) const {
        int row0 = u.pm * BM + wr * 64 + fr, col0 = u.pn * BM + wc * 32 + 8 * fq;
        asm volatile("" : "+v"(row0), "+v"(col0));
        f32x4 xb_[2][2][2];
#pragma unroll
        for (int bj = 0; bj < 2; ++bj)
#pragma unroll
            for (int n = 0; n < 2; ++n) xb_[0][bj][n] = *(const f32x4*)(x + (size_t)row0 * 1024 + col0 + bj * HALF + 4 * n);
#pragma unroll
        for (int g = 0; g < 8; ++g) { const int ai = g >> 2, m = g & 3; const int row = row0 + ai * HALF + m * 16; float ss = 0.f;
            if (g < 7) { const int ai2 = (g + 1) >> 2, m2 = (g + 1) & 3;
#pragma unroll
                for (int bj = 0; bj < 2; ++bj)
#pragma unroll
                    for (int n = 0; n < 2; ++n) xb_[(g + 1) & 1][bj][n] = *(const f32x4*)(x + (size_t)(row0 + ai2 * HALF + m2 * 16) * 1024 + col0 + bj * HALF + 4 * n); }
            asm volatile("" ::: "memory");
#pragma unroll
            for (int bj = 0; bj < 2; ++bj) { const size_t o = (size_t)row * 1024 + col0 + bj * HALF;
                const f32x4 v0 = xb_[g & 1][bj][0] + acc[ai][bj][m][0], v1 = xb_[g & 1][bj][1] + acc[ai][bj][m][1];
                ss += ((v0[0] * v0[0] + v0[1] * v0[1]) + (v0[2] * v0[2] + v0[3] * v0[3])) + ((v1[0] * v1[0] + v1[1] * v1[1]) + (v1[2] * v1[2] + v1[3] * v1[3]));
                u32x4 w; w.x = cvt_pk_bf16(v0[0], v0[1]); w.y = cvt_pk_bf16(v0[2], v0[3]); w.z = cvt_pk_bf16(v1[0], v1[1]); w.w = cvt_pk_bf16(v1[2], v1[3]);
                *(u32x4*)(APLE + (size_t)row * 1280 + 256 + col0 + bj * HALF) = w;
                u32x2 q; q.x = cvt4_fp8(v0[0], v0[1], v0[2], v0[3]); q.y = cvt4_fp8(v1[0], v1[1], v1[2], v1[3]);
                *(u32x2*)(X8 + o) = q; }
            ss += __shfl_xor(ss, 16); ss += __shfl_xor(ss, 32);
            if (fq == 0) ssp[(size_t)row * 16 + u.pn * 4 + wc] = ss; }
    }
};
struct EpiRouter {
    static constexpr bool PERM = false, AFTER_DRAIN = true; static constexpr int MID_T = 0;
    const float* ssp1; const float* brg; const float* bre; unsigned* cnt; int* tok_e; float* tok_w; int* tok_pos; float* r1; int* ltok; float* lw; float* lr;
    __device__ __forceinline__ void fused(f32x4 (&acc)[2][2][4][2], const Unit& u, int wr, int wc, int fr, int fq, PG8_LAS unsigned char* lds, int wid, int lane) const {
        PG8_LAS float* L = (PG8_LAS float*)lds;
        PG8_LAS int* hist = (PG8_LAS int*)(lds + 40960);
        const int tid = wid * 64 + lane;
        if (tid < 64) hist[tid] = 0;
        if (wc == 0) {
#pragma unroll
            for (int ai = 0; ai < 2; ++ai)
#pragma unroll
                for (int m = 0; m < 4; ++m)
#pragma unroll
                    for (int n = 0; n < 2; ++n) *(PG8_LAS f32x4*)(L + (ai * HALF + wr * 64 + m * 16 + fr) * 40 + 16 * n + 4 * fq) = acc[ai][0][m][n];
        } else if (wc == 1 && fq == 0) {
#pragma unroll
            for (int ai = 0; ai < 2; ++ai)
#pragma unroll
                for (int m = 0; m < 4; ++m) *(PG8_LAS f32x4*)(L + (ai * HALF + wr * 64 + m * 16 + fr) * 40 + 32) = acc[ai][0][m][0];
        }
        asm volatile("s_waitcnt lgkmcnt(0)" ::: "memory"); __builtin_amdgcn_s_barrier(); asm volatile("" ::: "memory");
        int ea = 0, eb = 0, la = 0, lb = 0; float wa_ = 0.f, wb_ = 0.f, r = 0.f; const int t = u.pm * BM + tid;
        if (tid < 256) {
            float ss = 0.f;
#pragma unroll
            for (int i = 0; i < 16; i += 4) { const f32x4 pv = *(const f32x4*)(ssp1 + (size_t)t * 16 + i); ss += (pv[0] + pv[1]) + (pv[2] + pv[3]); }
            r = rsqrtf(ss * (1.f / 1024.f) + 1e-6f);
            float lg[40];
#pragma unroll
            for (int i = 0; i < 36; i += 4) { const f32x4 v = *(const PG8_LAS f32x4*)(L + tid * 40 + i); lg[i] = v[0]; lg[i + 1] = v[1]; lg[i + 2] = v[2]; lg[i + 3] = v[3]; }
            float gl[4]; int grp = 0;
#pragma unroll
            for (int i = 0; i < 4; ++i) gl[i] = lg[i] * r + brg[i];
            float gm = gl[0];
#pragma unroll
            for (int i = 1; i < 4; ++i) if (gl[i] > gm) { gm = gl[i]; grp = i; }
            float den = 0.f;
#pragma unroll
            for (int i = 0; i < 4; ++i) den += __expf(gl[i] - gm);
            const float pg = 1.f / den;
            float el[8];
#pragma unroll
            for (int i = 0; i < 8; ++i) { float v = 0.f;
#pragma unroll
                for (int g2 = 0; g2 < 4; ++g2) v = (grp == g2) ? lg[4 + g2 * 8 + i] * r + bre[g2 * 8 + i] : v;
                el[i] = v; }
            int i0 = 0; float v0 = el[0];
#pragma unroll
            for (int i = 1; i < 8; ++i) if (el[i] > v0) { v0 = el[i]; i0 = i; }
            int i1 = -1; float v1 = -3.0e38f;
#pragma unroll
            for (int i = 0; i < 8; ++i) if (i != i0 && el[i] > v1) { v1 = el[i]; i1 = i; }
            const float e1 = __expf(v1 - v0); const float s0 = 1.f / (1.f + e1), s1 = e1 / (1.f + e1);
            ea = grp * 8 + i0; eb = grp * 8 + i1; wa_ = s0 * pg; wb_ = s1 * pg;
            la = __hip_atomic_fetch_add(&hist[ea], 1, __ATOMIC_RELAXED, __HIP_MEMORY_SCOPE_WORKGROUP); lb = __hip_atomic_fetch_add(&hist[eb], 1, __ATOMIC_RELAXED, __HIP_MEMORY_SCOPE_WORKGROUP);
        }
        asm volatile("s_waitcnt lgkmcnt(0)" ::: "memory"); __builtin_amdgcn_s_barrier(); asm volatile("" ::: "memory");
        if (tid < 32) { const int h = hist[tid]; hist[32 + tid] = h ? (int)atomicAdd(cnt + tid, (unsigned)h) : 0; }
        asm volatile("s_waitcnt vmcnt(0) lgkmcnt(0)" ::: "memory"); __builtin_amdgcn_s_barrier(); asm volatile("" ::: "memory");
        if (tid < 256) {
            const int pa = hist[32 + ea] + la, pb = hist[32 + eb] + lb;
            tok_e[t * 2] = ea; tok_e[t * 2 + 1] = eb; tok_w[t * 2] = wa_; tok_w[t * 2 + 1] = wb_; tok_pos[t * 2] = pa; tok_pos[t * 2 + 1] = pb; r1[t] = r;
            ltok[(size_t)ea * 32768 + pa] = t; lw[(size_t)ea * 32768 + pa] = wa_; lr[(size_t)ea * 32768 + pa] = r;
            ltok[(size_t)eb * 32768 + pb] = t; lw[(size_t)eb * 32768 + pb] = wb_; lr[(size_t)eb * 32768 + pb] = r;
        }
    }
};
template <bool GATHER_> struct MoeOrder {
    static constexpr bool GATHER = GATHER_;
    const PG8_LAS int* tab; int nwg, G, c; const char* A; const char* Bt; size_t bexp, btile; int lda; const int* ltok;
    __device__ __forceinline__ bool next(int i, Unit& u) const {
        const long L = (long)i * G + c; if (L >= nwg) return false;
        int wgid = (int)L; { const int q = nwg / NXCD, r = nwg % NXCD, xcd = wgid % NXCD, off = wgid / NXCD; wgid = (xcd < r ? xcd * (q + 1) : r * (q + 1) + (xcd - r) * q) + off; }
        int e = 0;
        for (int k = 1; k < 32; ++k) e += (__builtin_amdgcn_readfirstlane(tab[k]) <= wgid) ? 1 : 0;
        const int rem = wgid - __builtin_amdgcn_readfirstlane(tab[e]);
        u.pn = rem & 3; u.pm = rem >> 2; u.e = e; u.nrow = __builtin_amdgcn_readfirstlane(tab[80 + e]) - 256 * u.pm; u.slot0 = __builtin_amdgcn_readfirstlane(tab[40 + e]) + 256 * u.pm; return true;
    }
    __device__ __forceinline__ void ptrs(const Unit& u, const char*& cA, const char*& cB) const {
        cA = GATHER ? A : A + (size_t)u.slot0 * lda * 2; cB = Bt + (size_t)u.e * bexp + (size_t)u.pn * btile; }
    __device__ __forceinline__ void rows(const Unit& u, const int (&Rr)[2], const int (&Cc)[2], unsigned (&off)[2][2]) const {
#pragma unroll
        for (int h = 0; h < 2; ++h)
#pragma unroll
            for (int i = 0; i < 2; ++i) { const int r = h * HALF + Rr[i]; const int tok = (r < u.nrow) ? ltok[(size_t)u.e * 32768 + 256 * u.pm + r] : 0; off[h][i] = (unsigned)(tok * lda + Cc[i]) * 2u; }
    }
};
constexpr float SW1 = 32.f, SW2 = 16.f, SH = 4.f, SWP = 16.f, SWG = 32.f;
struct EpiMoeUp {
    static constexpr bool PERM = true, AFTER_DRAIN = false; static constexpr int MID_T = 0;
    const float* lr; unsigned char* HMID8;
    __device__ __forceinline__ void operator()(const f32x4 (&acc)[2][2][4][2], const Unit& u, int wr, int wc, int fr, int fq) const {
        const int cc = u.pn * 128 + wc * 32 + 8 * fq;
        float rv[8];
#pragma unroll
        for (int g = 0; g < 8; ++g) { const int row = (g >> 2) * HALF + wr * 64 + (g & 3) * 16 + fr; rv[g] = lr[u.e * 32768 + 256 * u.pm + (row < u.nrow ? row : 0)]; }
#pragma unroll
        for (int ai = 0; ai < 2; ++ai)
#pragma unroll
            for (int m = 0; m < 4; ++m) { const int row = ai * HALF + wr * 64 + m * 16 + fr;
                if (row < u.nrow) { const float r = rv[ai * 4 + m] * (1.f / SW1);
                    f32x4 v[2];
#pragma unroll
                    for (int n = 0; n < 2; ++n)
#pragma unroll
                        for (int j = 0; j < 4; ++j) { const float g = acc[ai][0][m][n][j] * r, up = acc[ai][1][m][n][j] * r; v[n][j] = g * fsig(g) * up * SH; }
                    u32x2 q; q.x = cvt4_fp8(v[0][0], v[0][1], v[0][2], v[0][3]); q.y = cvt4_fp8(v[1][0], v[1][1], v[1][2], v[1][3]);
                    *(u32x2*)(HMID8 + (size_t)(u.slot0 + row) * 512 + cc) = q; } }
    }
};
struct EpiMoeDown {
    static constexpr bool PERM = true, AFTER_DRAIN = false; static constexpr int MID_T = 0;
    const float* lw; bf16_t* YB;
    __device__ __forceinline__ void operator()(const f32x4 (&acc)[2][2][4][2], const Unit& u, int wr, int wc, int fr, int fq) const {
        const int cc = u.pn * 256 + wc * 32 + 8 * fq;
        float rv[8];
#pragma unroll
        for (int g = 0; g < 8; ++g) { const int row = (g >> 2) * HALF + wr * 64 + (g & 3) * 16 + fr; rv[g] = lw[u.e * 32768 + 256 * u.pm + (row < u.nrow ? row : 0)]; }
#pragma unroll
        for (int ai = 0; ai < 2; ++ai)
#pragma unroll
            for (int m = 0; m < 4; ++m) { const int row = ai * HALF + wr * 64 + m * 16 + fr;
                if (row < u.nrow) { const float gw = rv[ai * 4 + m] * (1.f / (SH * SW2));
#pragma unroll
                    for (int bj = 0; bj < 2; ++bj) { const f32x4 v0 = acc[ai][bj][m][0] * gw, v1 = acc[ai][bj][m][1] * gw;
                        u32x4 w; w.x = cvt_pk_bf16(v0[0], v0[1]); w.y = cvt_pk_bf16(v0[2], v0[3]); w.z = cvt_pk_bf16(v1[0], v1[1]); w.w = cvt_pk_bf16(v1[2], v1[3]);
                        *(u32x4*)(YB + (size_t)(u.slot0 + row) * 1024 + cc + bj * HALF) = w; } } }
    }
};
struct EpiPle {
    static constexpr bool PERM = false, AFTER_DRAIN = false; static constexpr int MID_T = 2;
    const bf16_t* APLE; const float* r2; bf16_t* X3; float* ssp; u32x2* scr;
    __device__ __forceinline__ void mid(f32x4 (&acc)[2][2][4][2], const Unit&, int, int, int, int) const {
        int tid = threadIdx.x;
        asm volatile("" : "+v"(tid));
#pragma unroll
        for (int ai = 0; ai < 2; ++ai)
#pragma unroll
            for (int bj = 0; bj < 2; ++bj)
#pragma unroll
                for (int m = 0; m < 4; ++m)
#pragma unroll
                    for (int n = 0; n < 2; ++n) { const f32x4 v = acc[ai][bj][m][n] * (1.f / SWP); u32x2 w; w.x = cvt_pk_bf16(v[0], v[1]); w.y = cvt_pk_bf16(v[2], v[3]);
                        scr[(((ai * 2 + bj) * 4 + m) * 2 + n) * 512 + tid] = w; acc[ai][bj][m][n] = (f32x4){0.f, 0.f, 0.f, 0.f}; asm volatile("" ::: "memory"); }
    }
    __device__ __forceinline__ void operator()(const f32x4 (&acc)[2][2][4][2], const Unit& u, int wr, int wc, int fr, int fq) const {
        int tid = threadIdx.x; int row0 = u.pm * BM + wr * 64 + fr, col0 = u.pn * BM + wc * 32 + 4 * fq;
        asm volatile("" : "+v"(tid), "+v"(row0), "+v"(col0));
        u32x2 pr_[2][2][2], rs_[2][2][2]; float rr_[2];
#define PLE_LOAD(g_, b_) do { const int ai_ = (g_) >> 2, m_ = (g_) & 3, row_ = row0 + ai_ * HALF + m_ * 16; rr_[b_] = r2[row_]; \
        _Pragma("unroll") for (int bj = 0; bj < 2; ++bj) _Pragma("unroll") for (int n = 0; n < 2; ++n) { \
            pr_[b_][bj][n] = scr[(((ai_ * 2 + bj) * 4 + m_) * 2 + n) * 512 + tid]; rs_[b_][bj][n] = *(const u32x2*)(APLE + (size_t)row_ * 1280 + 256 + col0 + bj * HALF + n * 16); } } while (0)
        PLE_LOAD(0, 0);
#pragma unroll
        for (int g = 0; g < 8; ++g) { const int ai = g >> 2, m = g & 3; const int row = row0 + ai * HALF + m * 16;
            if (g < 7) PLE_LOAD(g + 1, (g + 1) & 1);
            asm volatile("" ::: "memory");
            const float rr = rr_[g & 1] * (1.f / SWG); float ss = 0.f;
#pragma unroll
            for (int bj = 0; bj < 2; ++bj)
#pragma unroll
                for (int n = 0; n < 2; ++n) { const size_t o = (size_t)row * 1024 + col0 + bj * HALF + n * 16;
                    const f32x4 pr = bfx4(pr_[g & 1][bj][n]); const f32x4 a = acc[ai][bj][m][n] * rr;
                    const f32x4 v = bfx4(rs_[g & 1][bj][n]) + sig4(a) * pr;
                    u32x2 w; w.x = cvt_pk_bf16(v[0], v[1]); w.y = cvt_pk_bf16(v[2], v[3]);
                    *(u32x2*)(X3 + o) = w; ss += (v[0] * v[0] + v[1] * v[1]) + (v[2] * v[2] + v[3] * v[3]); }
            ss += __shfl_xor(ss, 16); ss += __shfl_xor(ss, 32);
            if (fq == 0) ssp[(size_t)row * 16 + u.pn * 4 + wc] = ss; }
#undef PLE_LOAD
    }
};
}

#define GAS __attribute__((address_space(1)))
#define LAS __attribute__((address_space(3)))
typedef unsigned v4u __attribute__((ext_vector_type(4)));
typedef GAS unsigned gu32;
constexpr int NWAVES = 8;
constexpr int RING_BYTES = 131072, LDSCTL_OFF = RING_BYTES + 4096, MISC_OFF = LDSCTL_OFF + 320, LDS_BYTES = 147456;
constexpr size_t WS_WIN = 12 * MiB, WS_WAB = 26 * MiB, WS_WO = 30 * MiB, WS_WPLE = 32 * MiB, WS_WR = 35 * MiB, WS_WGU = 36 * MiB, WS_WD = 100 * MiB;
constexpr size_t WS_LR = 132 * MiB;
constexpr size_t WS_SCR = 464 * MiB;
constexpr size_t WS_END2 = 496 * MiB;
constexpr int CW_BAR = 4096;
#define LDS_WAIT() asm volatile("s_waitcnt lgkmcnt(0)" ::: "memory")
#define VM_WAIT() asm volatile("s_waitcnt vmcnt(0)" ::: "memory")

#define XB_TMO      128
#define XB_XCNT(j)  (256  + 64 * (j))
#define XB_XSUB(j)  (1280 + 64 * (j))
#define XB_XGEN(j)  (2304 + 64 * (j))
#define XB_TOP      3328
#define XB_TOPGEN   3392
#define XCD_BAR_WORDS 3456
#define XB_SPIN_CAP (1u << 18)
__device__ __forceinline__ unsigned xb_ld(unsigned* p)              { return __hip_atomic_load(p, __ATOMIC_RELAXED, __HIP_MEMORY_SCOPE_AGENT); }
__device__ __forceinline__ unsigned xb_add(unsigned* p, unsigned v) { return __hip_atomic_fetch_add(p, v, __ATOMIC_RELAXED, __HIP_MEMORY_SCOPE_AGENT); }
__device__ __forceinline__ unsigned xb_xcc_id() { return (unsigned)__builtin_amdgcn_s_getreg((3 << 11) | 20) & 0xFu; }
#define XB_SPIN(cond, bar) do { unsigned _sp = 0; while (cond) { __builtin_amdgcn_s_sleep(1); \
    if ((++_sp & 255u) == 0u) { if (xb_ld(&(bar)[XB_TMO])) break; if (_sp > XB_SPIN_CAP) { atomicAdd(&(bar)[XB_TMO], 1u); break; } } } } while (0)
struct XcdBarrier { unsigned* bar; unsigned x; volatile LAS unsigned* st; };
__device__ __forceinline__ XcdBarrier xcd_barrier_post(unsigned* bar, volatile LAS unsigned* st) {
    XcdBarrier b; b.bar = bar; b.x = xb_xcc_id(); b.st = st;
    if (threadIdx.x == 0) (void)xb_add(&bar[XB_XCNT(b.x)], 1u);
    return b;
}
__device__ __forceinline__ void xcd_barrier_complete(unsigned* bar, unsigned x, unsigned& nloc, unsigned& nx) {
    const unsigned G = gridDim.x * gridDim.y * gridDim.z;
    unsigned sum, cnt, mine, sp = 0u;
    for (;;) {
        sum = 0u; cnt = 0u; mine = 0u;
#pragma unroll
        for (unsigned j = 0; j < 16; ++j) { const unsigned c = xb_ld(&bar[XB_XCNT(j)]); sum += c; cnt += (c > 0u) ? 1u : 0u; mine = (j == x) ? c : mine; }
        if (sum == G) break;
        __builtin_amdgcn_s_sleep(1);
        if ((++sp & 255u) == 0u) { if (xb_ld(&bar[XB_TMO])) break; if (sp > XB_SPIN_CAP) { atomicAdd(&bar[XB_TMO], 1u); break; } }
    }
    nloc = mine > 0u ? mine : 1u; nx = cnt > 0u ? cnt : 1u;
}
__device__ __forceinline__ void xcd_barrier(const XcdBarrier& b) {
    asm volatile("s_waitcnt vmcnt(0)" ::: "memory");
    __syncthreads();
    if (threadIdx.x == 0) {
        unsigned* bar = b.bar;
        __builtin_amdgcn_s_waitcnt(0);
        unsigned nloc = b.st[0], nx = b.st[1];
        if (nloc == 0u) { xcd_barrier_complete(bar, b.x, nloc, nx); b.st[0] = nloc; b.st[1] = nx; }
        const unsigned old = xb_add(&bar[XB_XSUB(b.x)], 1u);
        const unsigned gen = old / nloc;
        if (old + 1u == (gen + 1u) * nloc) {
            __builtin_amdgcn_fence(__ATOMIC_RELEASE, "agent");
            asm volatile("s_waitcnt vmcnt(0)" ::: "memory");
            const unsigned og = xb_add(&bar[XB_TOP], 1u);
            const unsigned tg = og / nx;
            if (og + 1u == (tg + 1u) * nx) xb_add(&bar[XB_TOPGEN], 1u);
            else XB_SPIN(xb_ld(&bar[XB_TOPGEN]) == tg, bar);
            __builtin_amdgcn_fence(__ATOMIC_ACQUIRE, "agent");
            xb_add(&bar[XB_XGEN(b.x)], 1u);
            asm volatile("s_waitcnt vmcnt(0)" ::: "memory");
        } else {
            XB_SPIN(xb_ld(&bar[XB_XGEN(b.x)]) == gen, bar);
            __builtin_amdgcn_fence(__ATOMIC_ACQUIRE, "agent");
            asm volatile("s_waitcnt vmcnt(0)" ::: "memory");
        }
    }
    __syncthreads();
}

__device__ __forceinline__ unsigned pk2(float lo, float hi) { return f2bf(lo) | (f2bf(hi) << 16); }
struct TrItem { const float* W; const float* scale; unsigned char* dst; int ldn, k0, n0, ldb, drow0, dk0, fp8; float mul; };
__device__ __forceinline__ void tr_load(const TrItem& t, float4 (&v)[16], int lane) {
    const int lr_ = lane >> 4, lc = (lane & 15) * 4;
#pragma unroll
    for (int i = 0; i < 16; ++i) v[i] = *(const float4*)(t.W + (size_t)(t.k0 + 4 * i + lr_) * t.ldn + t.n0 + lc);
}
__device__ __forceinline__ void tr_finish(const TrItem& t, const float4 (&v)[16], LAS float* scr, int lane) {
    const int lr_ = lane >> 4, lc = (lane & 15) * 4;
#pragma unroll
    for (int i = 0; i < 16; ++i) { const int kk = 4 * i + lr_; const float sc = (t.scale ? t.scale[t.k0 + kk] : 1.f) * t.mul; LAS float* d = scr + kk * 65 + lc;
        d[0] = v[i].x * sc; d[1] = v[i].y * sc; d[2] = v[i].z * sc; d[3] = v[i].w * sc; }
    LDS_WAIT(); asm volatile("" ::: "memory");
    const int c = lane & 7;
    if (t.fp8) {
#pragma unroll
        for (int j = 0; j < 8; ++j) { const int n = (lane >> 3) + 8 * j; const LAS float* s_ = scr + (8 * c) * 65 + n;
            uint2 o; o.x = pg8::cvt4_fp8(s_[0 * 65], s_[1 * 65], s_[2 * 65], s_[3 * 65]); o.y = pg8::cvt4_fp8(s_[4 * 65], s_[5 * 65], s_[6 * 65], s_[7 * 65]);
            *(uint2*)(t.dst + (size_t)(t.drow0 + n) * t.ldb + t.dk0 + t.k0 + 8 * c) = o; }
    } else {
#pragma unroll
        for (int j = 0; j < 8; ++j) { const int n = (lane >> 3) + 8 * j; const LAS float* s_ = scr + (8 * c) * 65 + n;
            v4u o; o.x = pk2(s_[0 * 65], s_[1 * 65]); o.y = pk2(s_[2 * 65], s_[3 * 65]); o.z = pk2(s_[4 * 65], s_[5 * 65]); o.w = pk2(s_[6 * 65], s_[7 * 65]);
            *(GAS v4u*)((bf16*)t.dst + (size_t)(t.drow0 + n) * t.ldb + t.dk0 + t.k0 + 8 * c) = o; }
    }
    LDS_WAIT(); asm volatile("" ::: "memory");
}
__device__ __forceinline__ void tr_item8(const float* __restrict__ W, int ldn, int k0, int n0, unsigned char* dst, int ldb, int drow0, const float* __restrict__ scale, float mul, LAS float* scr, int lane) {
    TrItem t{W, scale, dst, ldn, k0, n0, ldb, drow0, 0, 1, mul}; float4 v[16]; tr_load(t, v, lane); tr_finish(t, v, scr, lane);
}
__device__ __forceinline__ int map_in(int n0) {
    const int q = n0 >> 7, s = q >> 3, i = q & 7, off = n0 & 127;
    if (s == 0) return 4096 + 128 * i + off;
    if (s == 1) return 256 * i + off;
    if (s == 2) return 256 * i + 128 + off;
    if (s == 3) return 256 * (8 + i) + off;
    if (s == 4) return 256 * (8 + i) + 128 + off;
    if (s == 5) return 5120 + 256 * i + off;
    return 5120 + 256 * i + 128 + off;
}

struct Args { const float* in[25]; float* out; unsigned char* ws; int ph_lo, ph_hi; };

__global__ void __launch_bounds__(NWAVES * 64, 2) mega(Args args) {
    extern __shared__ __attribute__((aligned(16))) unsigned char lds_raw[];
    LAS unsigned char* lds = (LAS unsigned char*)lds_raw;
    volatile LAS unsigned* MISC = (volatile LAS unsigned*)(lds + MISC_OFF);
    const int tid = threadIdx.x, lane = tid & 63, wave = __builtin_amdgcn_readfirstlane(tid >> 6);
    const int G = gridDim.x; const int bx = blockIdx.x; const int vcu = (G % 8 == 0) ? (bx % 8) * (G / 8) + bx / 8 : bx;
    unsigned char* ws = args.ws;
    gu32* ctl = (gu32*)(ws + WS_CTL);
    for (int u = tid; u < (LDS_BYTES - LDSCTL_OFF) / 4; u += NWAVES * 64) ((LAS unsigned*)(lds + LDSCTL_OFF))[u] = 0u;
    __syncthreads();
    XcdBarrier bar = xcd_barrier_post((unsigned*)(ctl + CW_BAR), MISC + 8);
    const int lo = args.ph_lo, hi = args.ph_hi;
#ifndef PH_MASK
#define PH_MASK 0x7ff
#endif
#define IN(k) (((PH_MASK >> (k)) & 1) && lo <= (k) && (k) < hi)
#define BOTH(k) (IN(k) && (IN((k) + 1) || rep_ + 1 < NREP(k)))
#ifndef REP_MASK
#define REP_MASK 0
#endif
#ifndef PROBE_SKIP_EPI
#define PROBE_SKIP_EPI 0
#endif
#define NREP(k) (((REP_MASK >> (k)) & 1) ? 2 : 1)
#ifndef PROBE_TS
#define PROBE_TS -1
#endif
    unsigned long long ts_acc_ = 0ull, ts_t0_ = 0ull;
#define TS_B(k) do { if (PROBE_TS == (k) && bx == 0 && tid == 0) ts_t0_ = __builtin_amdgcn_s_memrealtime(); } while (0)
#define TS_E(k) do { if (PROBE_TS == (k) && bx == 0 && tid == 0) ts_acc_ += __builtin_amdgcn_s_memrealtime() - ts_t0_; } while (0)
#define PHASE(k) if (IN(k)) _Pragma("unroll") for (int rep_ = 0; rep_ < NREP(k); ++rep_)
    const float* x = args.in[0];
    bf16* H = (bf16*)args.out;
    bf16* WinT = (bf16*)(ws + WS_WIN); bf16* WabT = (bf16*)(ws + WS_WAB); bf16* WoT = (bf16*)(ws + WS_WO); bf16* WpleT = (bf16*)(ws + WS_WPLE); bf16* WrT = (bf16*)(ws + WS_WR);
    unsigned char* Wgu8 = ws + WS_WGU; unsigned char* Wd8 = ws + WS_WD;
    bf16* UA = (bf16*)(ws + WS_RA); bf16* UB = (bf16*)(ws + WS_RB); bf16* AB = (bf16*)(ws + WS_RC); bf16* GA = (bf16*)(ws + WS_RD); bf16* GB = (bf16*)(ws + WS_RE);

    TS_B(0);
    PHASE(0) {
        LAS float* scr = (LAS float*)(lds + wave * 16640);
        const int gw = vcu * NWAVES + wave, NGW = G * NWAVES;
        constexpr int I_IN = 16 * 112, I_SQ = 16 * 16, I_PP = 4 * 16, I_EG = 32 * 16 * 8, I_ED = 32 * 8 * 16;
        constexpr int NITEMS = I_IN + 4 * I_SQ + I_PP + 2 * I_EG;
        TS_B(20);
        auto decode = [&](int it) -> TrItem {
            int r = it; TrItem t{}; t.mul = 1.f;
            if (r < 2 * I_EG) { const int up = r >= I_EG; if (up) r -= I_EG; const int e = r / 128, q = r % 128, kb = q / 8, nb = q % 8, n0 = 64 * nb;
                t.W = (up ? args.in[19] : args.in[18]) + (size_t)e * D * DE; t.ldn = DE; t.k0 = 64 * kb; t.n0 = n0; t.dst = Wgu8 + (size_t)e * 1024 * 1024; t.ldb = 1024; t.drow0 = 256 * (n0 >> 7) + (up ? 128 : 0) + (n0 & 127);
                t.scale = args.in[13]; t.mul = pg8::SW1; t.fp8 = 1; return t; } r -= 2 * I_EG;
            t.n0 = 64 * (r % 16); t.k0 = 64 * (r / 16); t.ldn = D; t.drow0 = t.n0;
            if (r < I_IN) { t.W = args.in[3]; t.ldn = INC; t.k0 = 64 * (r / 112); t.n0 = 64 * (r % 112); t.dst = (unsigned char*)WinT; t.ldb = 1024; t.drow0 = map_in(t.n0); return t; } r -= I_IN;
            t.n0 = 64 * (r % 16); t.k0 = 64 * (r / 16); t.drow0 = t.n0;
            if (r < I_SQ) { t.W = args.in[5]; t.dst = (unsigned char*)WabT; t.ldb = 2048; return t; } r -= I_SQ;
            t.n0 = 64 * (r % 16); t.k0 = 64 * (r / 16); t.drow0 = t.n0;
            if (r < I_SQ) { t.W = args.in[10]; t.dst = (unsigned char*)WabT; t.ldb = 2048; t.dk0 = 1024; return t; } r -= I_SQ;
            t.n0 = 64 * (r % 16); t.k0 = 64 * (r / 16); t.drow0 = t.n0;
            if (r < I_SQ) { t.W = args.in[12]; t.dst = (unsigned char*)WoT; t.ldb = 1024; return t; } r -= I_SQ;
            t.n0 = 64 * (r % 16); t.k0 = 64 * (r / 16); t.drow0 = t.n0;
            if (r < I_SQ) { t.W = args.in[22]; t.dst = (unsigned char*)WpleT; t.ldb = 1280; t.dk0 = 256; t.scale = args.in[21]; t.mul = pg8::SWG; t.fp8 = 1; return t; } r -= I_SQ;
            t.n0 = 64 * (r % 16); t.k0 = 64 * (r / 16); t.drow0 = t.n0;
            t.W = args.in[23]; t.dst = (unsigned char*)WpleT; t.ldb = 1280; t.mul = pg8::SWP; t.fp8 = 1; return t;
        };
        {
            float4 va[16], vb[16];
            int it = gw;
            if (it < NITEMS) {
                TrItem ta = decode(it); tr_load(ta, va, lane);
                for (;;) {
                    const int itb = it + NGW; const bool hb = itb < NITEMS; TrItem tb = ta;
                    if (hb) { tb = decode(itb); tr_load(tb, vb, lane); }
                    tr_finish(ta, va, scr, lane);
                    if (!hb) break;
                    const int ita = itb + NGW; const bool ha = ita < NITEMS;
                    if (ha) { ta = decode(ita); tr_load(ta, va, lane); }
                    tr_finish(tb, vb, scr, lane);
                    if (!ha) break;
                    it = ita;
                }
            }
        }
        __syncthreads(); TS_E(20); TS_B(21);
        for (int i = vcu * 512 + tid; i < 256 * 1024; i += G * 512) { const int rr = i >> 10, k = i & 1023; float v = 0.f;
            if (rr < 4) v = args.in[14][k * 4 + rr] * args.in[13][k]; else if (rr < 36) v = args.in[16][k * 32 + rr - 4] * args.in[13][k];
            WrT[i] = (bf16)f2bf(v); }
        __syncthreads(); TS_E(21); TS_B(22);
        const float* g = args.in[2];
        for (int row = 2 * gw; row < T; row += 2 * NGW) {
            const float4* xr = (const float4*)(x + (size_t)row * D);
            float4 v[2][4]; float s0 = 0.f, s1 = 0.f;
#pragma unroll
            for (int j = 0; j < 4; ++j) { v[0][j] = xr[lane + 64 * j]; v[1][j] = xr[256 + lane + 64 * j]; }
#pragma unroll
            for (int j = 0; j < 4; ++j) { s0 += v[0][j].x * v[0][j].x + v[0][j].y * v[0][j].y + v[0][j].z * v[0][j].z + v[0][j].w * v[0][j].w;
                                          s1 += v[1][j].x * v[1][j].x + v[1][j].y * v[1][j].y + v[1][j].z * v[1][j].z + v[1][j].w * v[1][j].w; }
            const float r0 = rsqrtf(wave_sum(s0) * (1.f / D) + EPS), r1_ = rsqrtf(wave_sum(s1) * (1.f / D) + EPS);
#pragma unroll
            for (int j = 0; j < 4; ++j) { const int c = 4 * (lane + 64 * j); const float4 gg = *(const float4*)(g + c);
                uint2 o; o.x = pk2(v[0][j].x * r0 * gg.x, v[0][j].y * r0 * gg.y); o.y = pk2(v[0][j].z * r0 * gg.z, v[0][j].w * r0 * gg.w);
                *(uint2*)(H + (size_t)row * D + c) = o;
                o.x = pk2(v[1][j].x * r1_ * gg.x, v[1][j].y * r1_ * gg.y); o.y = pk2(v[1][j].z * r1_ * gg.z, v[1][j].w * r1_ * gg.w);
                *(uint2*)(H + (size_t)(row + 1) * D + c) = o; }
        }
        __syncthreads(); TS_E(22);
        if (BOTH(0)) xcd_barrier(bar);
    }
    TS_E(0);
    TS_B(1);
    PHASE(1) {
        pg8::Gemm g{1024, 1024, 1024}; pg8::StaticOrder S; S.init(T, INC, G, bx, H, 1024, WinT, 1024);
        pg8::EpiInProj E{UA, (size_t)(WS_RB - WS_RA) / 2, args.in[11], (PROBE_SKIP_EPI && rep_ == 1) ? (args.ph_hi > 5 ? 1 : 0) : 0};
        pg8::gemm_phase<pg8::EpiInProj, pg8::StaticOrder, true>(lds, g, S, E);
        if (BOTH(1)) xcd_barrier(bar);
    }
    TS_E(1);

    bf16* ZZ = (bf16*)args.out; bf16* MIX = (bf16*)(ws + WS_RC); bf16* APLE = (bf16*)(ws + WS_RA);
    unsigned char* A8 = (unsigned char*)args.out;
    unsigned char* HMID8 = ws + WS_RC; bf16* YB = (bf16*)(ws + WS_RD); bf16* X3 = (bf16*)(ws + WS_RC); unsigned char* X8 = ws + WS_RB + 16 * MiB;
    int* tok_e = (int*)(ws + WS_TOK); float* tok_w = (float*)(ws + WS_TOK + 256 * 1024); int* tok_pos = (int*)(ws + WS_TOK + 512 * 1024);
    float* r1 = (float*)(ws + WS_TOK + 768 * 1024); float* r2 = (float*)(ws + WS_TOK + 896 * 1024);
    float* ssp1 = (float*)(ws + WS_SSP1); float* ssp3 = (float*)(ws + WS_SSP3); int* ltok = (int*)(ws + WS_LTOK); float* lw = (float*)(ws + WS_LW); float* lr = (float*)(ws + WS_LR);
    unsigned* cnt = (unsigned*)(ctl + CW_CNT);
    LAS int* tab = (LAS int*)(lds + LDSCTL_OFF + 1024);
#define MOE_TABLES() do { if (tid == 0) { int us = 0, es = 0; for (int e = 0; e < NE; ++e) { const int c = (int)cnt[e]; tab[e] = us; tab[40 + e] = es; tab[80 + e] = c; us += 4 * ((c + 255) >> 8); es += c; } tab[32] = us; tab[72] = es; } \
        LDS_WAIT(); __syncthreads(); } while (0)

    TS_B(2);
    PHASE(2) {
        typedef float f32x2 __attribute__((ext_vector_type(2)));
        const int c0_ = 2 * tid;
        const float* cwb = args.in[6]; const float* cwa = args.in[4];
        LAS float* red = (LAS float*)(lds + LDSCTL_OFF + 4096); LAS float* tot = (LAS float*)(lds + LDSCTL_OFF + 4096 + 2048);
        const int upw = (1024 + G - 1) / G;
        bool have_prev = false;
        for (int un = vcu * upw; un < (vcu + 1) * upw && un < 1024; ++un) {
            const int t0 = un * 32; const bool first = (t0 & (SEQ - 1)) == 0;
            int c0 = c0_; asm volatile("" : "+v"(c0));
            {
                const int rlo = (have_prev || first) ? 0 : -30;
                const int npieces = (32 - rlo) * 128;
                v4u pc[16];
#pragma unroll
                for (int i = 0; i < 16; ++i) { const int pidx = tid + 512 * i; if (pidx < npieces) { const int row = t0 + rlo + (pidx >> 7);
                        pc[i] = *(const v4u*)(UB + (size_t)row * 1024 + (pidx & 127) * 8); } }
#pragma unroll
                for (int i = 0; i < 16; ++i) { const int pidx = tid + 512 * i; if (pidx < npieces) { const int row = t0 + rlo + (pidx >> 7);
                        *(LAS v4u*)(lds + (row & 63) * 2048 + (pidx & 127) * 16) = pc[i]; } }
            }
            f32x2 wb[31];
#pragma unroll
            for (int k = 0; k < 31; ++k) wb[k] = *(const f32x2*)(cwb + k * 1024 + c0);
            const f32x2 bb = *(const f32x2*)(args.in[7] + c0);
            LDS_WAIT(); __syncthreads();
            f32x2 acc[32];
#pragma unroll
            for (int j = 0; j < 32; ++j) acc[j] = bb;
            const int sb = (t0 + 34) & 63;
#pragma unroll
            for (int si = 0; si < 62; ++si) {
                const bool dead = first && si < 30;
                const unsigned w = *(const LAS unsigned*)(lds + ((sb + si) & 63) * 2048 + tid * 4);
                f32x2 uv = (f32x2){__builtin_bit_cast(float, w << 16), __builtin_bit_cast(float, w & 0xffff0000u)};
                if (dead) uv = (f32x2){0.f, 0.f};
#pragma unroll
                for (int j = (si > 30 ? si - 30 : 0); j <= (si < 31 ? si : 31); ++j) acc[j] += wb[si - j] * uv;
                if ((si & 7) == 7) asm volatile("" ::: "memory");
            }
            float v1[32], v2[32];
#pragma unroll
            for (int j = 0; j < 32; ++j) { v1[j] = acc[j].x + acc[j].y; v2[j] = acc[j].x * acc[j].x + acc[j].y * acc[j].y; }
#define BFLY(v, NN, bit) _Pragma("unroll") for (int i = 0; i < (NN) / 2; ++i) { const bool up_ = (lane & (bit)) != 0; const float keep_ = up_ ? v[i + (NN) / 2] : v[i], send_ = up_ ? v[i] : v[i + (NN) / 2]; v[i] = keep_ + __shfl_xor(send_, (bit)); }
            BFLY(v1, 32, 16) BFLY(v1, 16, 8) BFLY(v1, 8, 4) BFLY(v1, 4, 2) BFLY(v1, 2, 1)
            BFLY(v2, 32, 16) BFLY(v2, 16, 8) BFLY(v2, 8, 4) BFLY(v2, 4, 2) BFLY(v2, 2, 1)
#undef BFLY
            v1[0] += __shfl_xor(v1[0], 32); v2[0] += __shfl_xor(v2[0], 32);
            red[wave * 64 + lane] = lane < 32 ? v1[0] : v2[0];
            LDS_WAIT(); __syncthreads();
            if (tid < 64) { float sm = 0.f;
#pragma unroll
                for (int w8 = 0; w8 < 8; ++w8) sm += red[w8 * 64 + tid];
                tot[tid] = sm; }
            LDS_WAIT(); __syncthreads();
            asm volatile("" : "+v"(c0));
            unsigned rua[34], rab[32];
#pragma unroll
            for (int j = 0; j < 34; ++j) rua[j] = *(const unsigned*)(UA + (size_t)((first && j < 2) ? t0 : t0 - 2 + j) * 1024 + c0);
#pragma unroll
            for (int j = 0; j < 32; ++j) rab[j] = *(const unsigned*)(AB + (size_t)(t0 + j) * 1024 + c0);
            const f32x2 lg = *(const f32x2*)(args.in[8] + c0), lb = *(const f32x2*)(args.in[9] + c0);
#pragma unroll
            for (int j = 0; j < 32; ++j) { const float mu = tot[j] * (1.f / 1024.f); const float var = tot[32 + j] * (1.f / 1024.f) - mu * mu; const float rstd = rsqrtf(var + EPS);
                const f32x2 y = (acc[j] - mu) * rstd * lg + lb;
                *(unsigned*)(ZZ + (size_t)(t0 + j) * 2048 + 1024 + c0) = pg8::cvt_pk_bf16(y.x * pg8::fsig(y.x), y.y * pg8::fsig(y.y)); }
            asm volatile("" : "+v"(c0));
            const f32x2 wa0 = *(const f32x2*)(cwa + c0), wa1 = *(const f32x2*)(cwa + 1024 + c0), wa2 = *(const f32x2*)(cwa + 2048 + c0);
#define BF2(w_) ((f32x2){__builtin_bit_cast(float, (w_) << 16), __builtin_bit_cast(float, (w_) & 0xffff0000u)})
            if (first) { rua[0] = 0u; rua[1] = 0u; }
#pragma unroll
            for (int j = 0; j < 32; ++j) { const f32x2 za = BF2(rab[j]) * (wa0 * BF2(rua[j]) + wa1 * BF2(rua[j + 1]) + wa2 * BF2(rua[j + 2]));
                *(unsigned*)(ZZ + (size_t)(t0 + j) * 2048 + c0) = pg8::cvt_pk_bf16(za.x, za.y); }
#undef BF2
            have_prev = true;
        }
        if (BOTH(2)) xcd_barrier(bar);
    }
    TS_E(2);
    TS_B(3);
    PHASE(3) {
        pg8::Gemm g{2048, 2048, 2048}; pg8::StaticOrder S; S.init(T, D, G, bx, ZZ, 2048, WabT, 2048);
        pg8::EpiMix E{GA, GB, MIX};
        pg8::gemm_phase<pg8::EpiMix, pg8::StaticOrder, true>(lds, g, S, E);
        if (BOTH(3)) xcd_barrier(bar);
    }
    TS_E(3);
    TS_B(4);
    PHASE(4) {
        pg8::Gemm g{1024, 1024, 1024}; pg8::StaticOrder S; S.init(T, D, G, bx, MIX, 1024, WoT, 1024);
        pg8::EpiWo E{x, APLE, X8, ssp1};
        pg8::gemm_phase<pg8::EpiWo, pg8::StaticOrder, true>(lds, g, S, E);
        if (BOTH(4)) xcd_barrier(bar);
    }
    TS_E(4);
    TS_B(5);
    PHASE(5) {
        pg8::Gemm g{1280, 1024, 1024}; pg8::StaticOrder S; S.init(T, 256, G, bx, APLE + 256, 1280, WrT, 1024);
        pg8::EpiRouter E{ssp1, args.in[15], args.in[17], cnt, tok_e, tok_w, tok_pos, r1, ltok, lw, lr};
        pg8::gemm_phase<pg8::EpiRouter, pg8::StaticOrder, false>(lds, g, S, E);
        const int nidle = G > 128 ? G - 128 : G, me = G > 128 ? bx - 128 : bx;
        if (me >= 0) { const float* p = args.in[1];
            { LAS float* scr = (LAS float*)(lds + wave * 16640);
              for (int r = me * NWAVES + wave; r < 32 * 8 * 16; r += nidle * NWAVES) { const int e = r / 128, q = r % 128, kb = q / 16, nb = q % 16;
                  tr_item8(args.in[20] + (size_t)e * DE * D, D, 64 * kb, 64 * nb, Wd8 + (size_t)e * 1024 * 512, 512, 64 * nb, nullptr, pg8::SW2, scr, lane); } }
            const size_t stride = (size_t)nidle * 512;
            for (size_t i0 = (size_t)me * 512 + tid; i0 < (size_t)T * 64; i0 += 8 * stride) {
                float4 v[8];
#pragma unroll
                for (int q = 0; q < 8; ++q) { const size_t i = i0 + q * stride; if (i < (size_t)T * 64) v[q] = *(const float4*)(p + (i >> 6) * PLE + (int)(i & 63) * 4); }
#pragma unroll
                for (int q = 0; q < 8; ++q) { const size_t i = i0 + q * stride; if (i < (size_t)T * 64) *(unsigned*)(A8 + (i >> 6) * 1280 + (int)(i & 63) * 4) = pg8::cvt4_fp8(v[q].x, v[q].y, v[q].z, v[q].w); }
            } }
        if (BOTH(5)) xcd_barrier(bar);
    }
    TS_E(5);
    TS_B(6);
    PHASE(6) {
        MOE_TABLES();
        pg8::Gemm g{512, 512, 512};
        pg8::MoeOrder<true> S{tab, tab[32], G, bx, (const char*)X8, (const char*)Wgu8, (size_t)1024 * 1024, (size_t)256 * 1024, 512, ltok};
        pg8::EpiMoeUp E{lr, HMID8};
        pg8::gemm_phase<pg8::EpiMoeUp, pg8::MoeOrder<true>, true, true>(lds, g, S, E);
        if (BOTH(6)) xcd_barrier(bar);
    }
    TS_E(6);
    TS_B(7);
    PHASE(7) {
        MOE_TABLES();
        pg8::Gemm g{256, 256, 256};
        pg8::MoeOrder<false> S{tab, tab[32], G, bx, (const char*)HMID8, (const char*)Wd8, (size_t)1024 * 512, (size_t)256 * 512, 256, ltok};
        pg8::EpiMoeDown E{lw, YB};
        pg8::gemm_phase<pg8::EpiMoeDown, pg8::MoeOrder<false>, true, true>(lds, g, S, E);
        if (BOTH(7)) xcd_barrier(bar);
    }
    TS_E(7);
    TS_B(8);
    PHASE(8) {
        MOE_TABLES();
        const int gw = vcu * NWAVES + wave, NGW = G * NWAVES;
        for (int t = 2 * gw; t < T; t += 2 * NGW) {
            int sl[2][2];
#pragma unroll
            for (int q = 0; q < 2; ++q) { const int4 te = *(const int4*)(tok_e + t * 2), tp = *(const int4*)(tok_pos + t * 2);
                sl[0][0] = tab[40 + te.x] + tp.x; sl[0][1] = tab[40 + te.y] + tp.y; sl[1][0] = tab[40 + te.z] + tp.z; sl[1][1] = tab[40 + te.w] + tp.w; }
            v4u xv[2][2], ya[2][2], yb[2][2];
#pragma unroll
            for (int q = 0; q < 2; ++q)
#pragma unroll
                for (int j = 0; j < 2; ++j) { const int c = 8 * (lane + 64 * j);
                    xv[q][j] = *(const v4u*)(APLE + (size_t)(t + q) * APITCH + 256 + c); ya[q][j] = *(const v4u*)(YB + (size_t)sl[q][0] * D + c); yb[q][j] = *(const v4u*)(YB + (size_t)sl[q][1] * D + c); }
#pragma unroll
            for (int q = 0; q < 2; ++q) { float s_ = 0.f;
#pragma unroll
                for (int j = 0; j < 2; ++j) { const int c = 8 * (lane + 64 * j); v4u o;
#pragma unroll
                    for (int k = 0; k < 4; ++k) { const float lo = bf2f(xv[q][j][k] & 0xffff) + bf2f(ya[q][j][k] & 0xffff) + bf2f(yb[q][j][k] & 0xffff), hi = bf2f(xv[q][j][k] >> 16) + bf2f(ya[q][j][k] >> 16) + bf2f(yb[q][j][k] >> 16);
                        s_ += lo * lo + hi * hi; o[k] = pk2(lo, hi); }
                    *(v4u*)(APLE + (size_t)(t + q) * APITCH + 256 + c) = o;
                    uint2 o8; o8.x = pg8::cvt4_fp8(bf2f(o[0] & 0xffff), bf2f(o[0] >> 16), bf2f(o[1] & 0xffff), bf2f(o[1] >> 16)); o8.y = pg8::cvt4_fp8(bf2f(o[2] & 0xffff), bf2f(o[2] >> 16), bf2f(o[3] & 0xffff), bf2f(o[3] >> 16));
                    *(uint2*)(A8 + (size_t)(t + q) * 1280 + 256 + c) = o8; }
                s_ = wave_sum(s_);
                if (lane == 0) r2[t + q] = rsqrtf(s_ * (1.f / D) + EPS); }
        }
        if (BOTH(8)) xcd_barrier(bar);
    }
    TS_E(8);
    TS_B(9);
    PHASE(9) {
        pg8::Gemm g{640, 640, 640}; pg8::StaticOrder S; S.init(T, D, G, bx, A8, 640, WpleT, 640);
        pg8::EpiPle E{APLE, r2, X3, ssp3, (pg8::u32x2*)(ws + WS_SCR + (size_t)bx * 131072)};
        pg8::gemm_phase<pg8::EpiPle, pg8::StaticOrder, true, true>(lds, g, S, E);
        if (BOTH(9)) xcd_barrier(bar);
    }
    TS_E(9);
    TS_B(10);
    PHASE(10) {
        const int gw = vcu * NWAVES + wave, NGW = G * NWAVES; const float* gfin = args.in[24];
        for (int row = 2 * gw; row < T; row += 2 * NGW) {
            float ss0 = lane < 16 ? ssp3[(size_t)row * 16 + lane] : 0.f, ss1 = lane < 16 ? ssp3[(size_t)(row + 1) * 16 + lane] : 0.f;
            uint2 w[2][4];
#pragma unroll
            for (int j = 0; j < 4; ++j) { const int c = 4 * (lane + 64 * j); w[0][j] = *(const uint2*)(X3 + (size_t)row * D + c); w[1][j] = *(const uint2*)(X3 + (size_t)(row + 1) * D + c); }
            ss0 = wave_sum(ss0); ss1 = wave_sum(ss1);
            const float r0 = rsqrtf(ss0 * (1.f / D) + EPS), r1_ = rsqrtf(ss1 * (1.f / D) + EPS);
#pragma unroll
            for (int j = 0; j < 4; ++j) { const int c = 4 * (lane + 64 * j); const float4 gg = *(const float4*)(gfin + c);
                *(float4*)(args.out + (size_t)row * D + c) = make_float4(bf2f(w[0][j].x & 0xffff) * r0 * gg.x, bf2f(w[0][j].x >> 16) * r0 * gg.y, bf2f(w[0][j].y & 0xffff) * r0 * gg.z, bf2f(w[0][j].y >> 16) * r0 * gg.w);
                *(float4*)(args.out + (size_t)(row + 1) * D + c) = make_float4(bf2f(w[1][j].x & 0xffff) * r1_ * gg.x, bf2f(w[1][j].x >> 16) * r1_ * gg.y, bf2f(w[1][j].y & 0xffff) * r1_ * gg.z, bf2f(w[1][j].y >> 16) * r1_ * gg.w); }
        }
    }
    TS_E(10);
    if (PROBE_TS >= 0 && bx == 0 && tid == 0) { const unsigned long long t1_ = __builtin_amdgcn_s_memrealtime(); while (__builtin_amdgcn_s_memrealtime() - t1_ < 4ull * ts_acc_) __builtin_amdgcn_s_sleep(8); }
#undef MOE_TABLES
#undef IN
#undef BOTH
}


#ifndef OPT_UPTO
#define OPT_UPTO 11
#endif
extern "C" void kernel_launch(void* const* d_in, const int* in_sizes, int n_in, void* d_out, int out_size, void* d_ws, size_t ws_size, hipStream_t stream) {
    static int grid = 0;
    if (grid == 0) {
        if (n_in != 25 || in_sizes[0] != T * D || out_size != T * D || ws_size < WS_END2) { fprintf(stderr, "kernel_launch: unexpected shapes (n_in %d, in0 %d, out %d, ws %zu)\n", n_in, n_in > 0 ? in_sizes[0] : -1, out_size, ws_size); grid = -1; return; }
        int dev = 0, cus = 0, per_cu = 0;
        if (hipGetDevice(&dev) != hipSuccess || hipDeviceGetAttribute(&cus, hipDeviceAttributeMultiprocessorCount, dev) != hipSuccess) { fprintf(stderr, "kernel_launch: device query failed\n"); grid = -1; return; }
        if (hipFuncSetAttribute((const void*)mega, hipFuncAttributeMaxDynamicSharedMemorySize, LDS_BYTES) != hipSuccess) { fprintf(stderr, "kernel_launch: hipFuncSetAttribute failed\n"); grid = -1; return; }
        if (hipOccupancyMaxActiveBlocksPerMultiprocessor(&per_cu, (const void*)mega, NWAVES * 64, LDS_BYTES) != hipSuccess || per_cu < 1) { fprintf(stderr, "kernel_launch: occupancy query says %d blocks per CU\n", per_cu); (void)hipGetLastError(); grid = -1; return; }
        grid = cus;
    }
    if (grid < 0) return;
    const float* x = (const float*)d_in[0]; const float* p = (const float*)d_in[1];
    const float* conv_a_w = (const float*)d_in[4]; const float* w_out_a = (const float*)d_in[5]; const float* conv_b_w = (const float*)d_in[6]; const float* conv_b_b = (const float*)d_in[7];
    const float* ln_b_g = (const float*)d_in[8]; const float* ln_b_b = (const float*)d_in[9]; const float* w_out_b = (const float*)d_in[10];
    const float* w_o = (const float*)d_in[12]; const float* ffn_g = (const float*)d_in[13]; const float* w_rg = (const float*)d_in[14]; const float* b_rg = (const float*)d_in[15];
    const float* w_re = (const float*)d_in[16]; const float* b_re = (const float*)d_in[17]; const float* w_eg = (const float*)d_in[18]; const float* w_eu = (const float*)d_in[19];
    const float* w_ed = (const float*)d_in[20]; const float* ple_g = (const float*)d_in[21]; const float* w_pg = (const float*)d_in[22]; const float* w_pp = (const float*)d_in[23];
    const float* fin_g = (const float*)d_in[24];
    unsigned char* ws = (unsigned char*)d_ws; float* out = (float*)d_out;
    unsigned* ctl = (unsigned*)(ws + WS_CTL);
    int* tok_e = (int*)(ws + WS_TOK); float* tok_w = (float*)(ws + WS_TOK + 256 * 1024); int* tok_pos = (int*)(ws + WS_TOK + 512 * 1024);
    float* r1 = (float*)(ws + WS_TOK + 768 * 1024); float* r2 = (float*)(ws + WS_TOK + 896 * 1024);
    float* ssp1 = (float*)(ws + WS_SSP1); int* ltok = (int*)(ws + WS_LTOK); float* lw = (float*)(ws + WS_LW);
    bf16* UA = (bf16*)(ws + WS_RA); bf16* UB = (bf16*)(ws + WS_RB); bf16* AB = (bf16*)(ws + WS_RC); bf16* GA = (bf16*)(ws + WS_RD); bf16* GB = (bf16*)(ws + WS_RE);
    bf16* ZZ = (bf16*)d_out; bf16* MIX = (bf16*)(ws + WS_RC); float* X1 = (float*)(ws + WS_RA); bf16* APLE = (bf16*)(ws + WS_RA);
    bf16* HMID = (bf16*)(ws + WS_RC); bf16* YB = (bf16*)(ws + WS_RD); float* X3 = (float*)(ws + WS_RC);

    if (hipMemsetAsync(ws + WS_CTL, 0, 1 * MiB, stream) != hipSuccess) { fprintf(stderr, "kernel_launch: memset failed\n"); return; }
    Args a{};
    for (int i = 0; i < 25; ++i) a.in[i] = (const float*)d_in[i];
    a.out = out; a.ws = ws; a.ph_lo = 0; a.ph_hi = OPT_UPTO;
    void* kargs[] = {&a};
    const hipError_t le = hipLaunchCooperativeKernel((const void*)mega, dim3(grid), dim3(NWAVES * 64), kargs, LDS_BYTES, stream);
    if (le != hipSuccess) { fprintf(stderr, "kernel_launch: cooperative launch failed: %s (grid %d)\n", hipGetErrorString(le), grid); return; }
#if OPT_UPTO < 11
    if (OPT_UPTO <= 1) nv_inproj<<<dim3(T / 8, 4), 256, 0, stream>>>((const bf16*)d_out, (const float*)d_in[3], (const float*)d_in[11], UA, UB, AB, GA, GB);
    if (OPT_UPTO <= 2) nv_conv<<<T, 256, 0, stream>>>(UA, UB, AB, conv_a_w, conv_b_w, conv_b_b, ln_b_g, ln_b_b, ZZ);
    if (OPT_UPTO <= 3) nv_outab<<<dim3(T / 8, 4), 256, 0, stream>>>(ZZ, w_out_a, w_out_b, GA, GB, MIX);
    if (OPT_UPTO <= 4) { nv_wo<<<dim3(T / 8, 4), 256, 0, stream>>>(MIX, w_o, x, X1, APLE); nv_rowss<<<T / 4, 256, 0, stream>>>(X1, ssp1); }
    if (OPT_UPTO <= 5) { nv_router<<<T / 4, 256, 0, stream>>>(X1, ssp1, ffn_g, w_rg, b_rg, w_re, b_re, ctl + CW_CNT, tok_e, tok_w, tok_pos, r1, ltok, lw); nv_pcvt<<<T * PLE / 4 / 256, 256, 0, stream>>>(p, APLE); }
    if (OPT_UPTO <= 6) nv_moe_up<<<dim3(T / 8, NE), 256, 0, stream>>>(X1, r1, ffn_g, w_eg, w_eu, ctl + CW_CNT, ltok, HMID);
    if (OPT_UPTO <= 7) nv_moe_down<<<dim3(T / 8, NE), 256, 0, stream>>>(HMID, w_ed, ctl + CW_CNT, lw, YB);
    if (OPT_UPTO <= 8) nv_combine<<<T / 4, 256, 0, stream>>>(X1, YB, ctl + CW_CNT, tok_e, tok_pos, APLE, r2);
    if (OPT_UPTO <= 9) nv_ple<<<dim3(T / 8, 4), 256, 0, stream>>>(X1, r2, ple_g, w_pg, p, w_pp, X3);
    if (OPT_UPTO <= 10) nv_final<<<T / 4, 256, 0, stream>>>(X3, fin_g, out);
#endif
}
```

```cpp
#include <hip/hip_runtime.h>
#include <cstdio>
#include <cstdint>

typedef unsigned short bf16;
constexpr int T = 32768, D = 1024, SEQ = 2048, PLE = 256, NE = 32, NG = 4, EPG = 8, DE = 512, INC = 7168;
constexpr float EPS = 1e-6f;
constexpr size_t MiB = 1u << 20;
constexpr size_t WS_CTL = 0;
constexpr size_t WS_TOK = 1 * MiB;
constexpr size_t WS_SSP1 = 2 * MiB;
constexpr size_t WS_SSP3 = 4 * MiB;
constexpr size_t WS_LTOK = 6 * MiB;
constexpr size_t WS_LW = 136 * MiB;
constexpr size_t WS_RA = 144 * MiB, WS_RB = 208 * MiB, WS_RC = 272 * MiB, WS_RD = 336 * MiB, WS_RE = 400 * MiB;
constexpr size_t WS_END = 464 * MiB;
constexpr int APITCH = 1280;
constexpr int CW_CNT = 64;

__device__ __forceinline__ unsigned f2bf(float f) { unsigned u = __builtin_bit_cast(unsigned, f); return (u + 0x7fffu + ((u >> 16) & 1u)) >> 16; }
__device__ __forceinline__ float bf2f(unsigned short b) { return __builtin_bit_cast(float, (unsigned)b << 16); }
__device__ __forceinline__ float sigmoidf_(float v) { return 1.f / (1.f + __expf(-v)); }
__device__ __forceinline__ float siluf_(float v) { return v / (1.f + __expf(-v)); }
__device__ __forceinline__ float wave_sum(float v) {
#pragma unroll
    for (int o = 1; o < 64; o <<= 1) v += __shfl_xor(v, o);
    return v;
}

#define REP_MASK 0
#define OPT_UPTO 11
namespace pg8 {
#define PG8_LAS __attribute__((address_space(3)))
typedef unsigned short bf16_t;
typedef short bf16x8 __attribute__((ext_vector_type(8)));
typedef float f32x4 __attribute__((ext_vector_type(4)));
typedef unsigned u32x4 __attribute__((ext_vector_type(4)));
typedef unsigned u32x2 __attribute__((ext_vector_type(2)));
constexpr int BM = 256, BK = 64, HALF = 128, HTB = HALF * BK * 2, STAGE_BYTES = 8 * HTB, NXCD = 8, WGM = 8;
__host__ __device__ __forceinline__ int lds_byte(int r, int c) { const int st = (r >> 4) * 2 + (c >> 5), rr = r & 15, cc = c & 31, ob = rr * 64 + cc * 2; return st * 1024 + (ob ^ (((ob >> 9) & 1) << 5)); }
__host__ __device__ __forceinline__ void stage_rc(int b, int& R, int& C) { const int st = b / 1024, sb = b % 1024, swz = sb ^ (((sb >> 9) & 1) << 5); R = (st >> 1) * 16 + swz / 64; C = (st & 1) * 32 + (swz % 64) / 2; }
__host__ __device__ __forceinline__ int perm32(int rho) { const int n = rho >> 4, i = rho & 15; return 8 * (i >> 2) + 4 * n + (i & 3); }

struct Unit { int pm, pn, e, nrow, slot0; };
struct Gemm { int lda, ldb, K; };

__device__ __forceinline__ unsigned cvt_pk_bf16(float lo, float hi) { unsigned r; asm volatile("v_cvt_pk_bf16_f32 %0, %1, %2" : "=v"(r) : "v"(lo), "v"(hi)); return r; }
__device__ __forceinline__ float fsig(float v) { return __builtin_amdgcn_rcpf(1.f + __expf(-v)); }
__device__ __forceinline__ f32x4 sig4(f32x4 v) { return (f32x4){fsig(v[0]), fsig(v[1]), fsig(v[2]), fsig(v[3])}; }
__device__ __forceinline__ f32x4 bfx4(u32x2 w) { return (f32x4){__builtin_bit_cast(float, w.x << 16), __builtin_bit_cast(float, w.x & 0xffff0000u), __builtin_bit_cast(float, w.y << 16), __builtin_bit_cast(float, w.y & 0xffff0000u)}; }

struct StaticOrder {
    static constexpr bool GATHER = false;
    int nM, nN, nwg, G, c; const char* A; const char* Bt; size_t atile, btile;
    __device__ __forceinline__ void init(int M, int N, int G_, int c_, const void* A_, int lda, const void* Bt_, int ldb) { nM = M / BM; nN = N / BM; nwg = nM * nN; G = G_; c = c_; A = (const char*)A_; Bt = (const char*)Bt_; atile = (size_t)BM * lda * 2; btile = (size_t)BM * ldb * 2; }
    __device__ __forceinline__ bool next(int i, Unit& u) const {
        const long L = (long)i * G + c; if (L >= nwg) return false;
        int wgid = (int)L; { const int q = nwg / NXCD, r = nwg % NXCD, xcd = wgid % NXCD, off = wgid / NXCD; wgid = (xcd < r ? xcd * (q + 1) : r * (q + 1) + (xcd - r) * q) + off; }
        const int nig = WGM * nN, gid = wgid / nig, fm = gid * WGM, gsz = (nM - fm) < WGM ? (nM - fm) : WGM;
        u.pm = fm + ((wgid % nig) % gsz); u.pn = (wgid % nig) / gsz; u.e = 0; u.nrow = 256; u.slot0 = 0; return true;
    }
    __device__ __forceinline__ void ptrs(const Unit& u, const char*& cA, const char*& cB) const { cA = A + (size_t)u.pm * atile; cB = Bt + (size_t)u.pn * btile; }
    __device__ __forceinline__ void rows(const Unit&, const int (&)[2], const int (&)[2], unsigned (&)[2][2]) const {}
};

typedef int v4i_t __attribute__((ext_vector_type(4)));
typedef int v8i_t __attribute__((ext_vector_type(8)));
__device__ __forceinline__ v8i_t cat8(bf16x8 lo, bf16x8 hi) { const v4i_t l = __builtin_bit_cast(v4i_t, lo), h = __builtin_bit_cast(v4i_t, hi); return __builtin_shufflevector(l, h, 0, 1, 2, 3, 4, 5, 6, 7); }
__device__ __forceinline__ void mfma8(f32x4& acc, v8i_t b, v8i_t a, int one) {
    asm volatile("s_nop 1\n\tv_mfma_scale_f32_16x16x128_f8f6f4 %0, %1, %2, %0, %3, %3 op_sel_hi:[0,0,0]" : "+v"(acc) : "v"(b), "v"(a), "v"(one));
}
#define MFMA_DRAIN() asm volatile("s_nop 15\n\ts_nop 7" ::: "memory")
template <class Epi, class Sched, bool ALIGN_EPI, bool FP8 = false>
__device__ __forceinline__ void gemm_phase(PG8_LAS unsigned char* lds, const Gemm g, const Sched& S, const Epi& E) {
    const int tid = threadIdx.x, wid = __builtin_amdgcn_readfirstlane(tid >> 6), lane = tid & 63, wr = wid >> 2, wc = wid & 3, fr = lane & 15, fq = lane >> 4;
    const int K = g.K, nt = K / BK;
    int Rr[2], Cc[2]; unsigned vA[2][2], vN[2][2], voffB[2];
#pragma unroll
    for (int i = 0; i < 2; ++i) { int R, C; stage_rc(tid * 16 + i * 8192, R, C); Rr[i] = R; Cc[i] = C; const int Rb = Epi::PERM ? ((R & ~31) + perm32(R & 31)) : R;
        voffB[i] = (unsigned)(Rb * g.ldb + C) * 2u; vA[0][i] = (unsigned)(R * g.lda + C) * 2u; vA[1][i] = (unsigned)((R + HALF) * g.lda + C) * 2u; vN[0][i] = vA[0][i]; vN[1][i] = vA[1][i]; }
    const size_t kstep = (size_t)(BK * 2);
    const size_t hstepB = (size_t)HALF * g.ldb * 2;
    const unsigned ldsw = (unsigned)wid * 1024u;
    const int aoff = FP8 ? lds_byte(wr * 64 + fr, fq * 16) : lds_byte(wr * 64 + fr, fq * 8), boff = FP8 ? lds_byte(wc * 32 + fr, fq * 16) : lds_byte(wc * 32 + fr, fq * 8);
    constexpr int kstr = FP8 ? 16 : 1024;
#define PG8_SA(b, h) (((b) * 2 + (h)) * HTB)
#define PG8_SB(b, h) ((4 + (b) * 2 + (h)) * HTB)
#define PG8_STAGE(bufoff, gbase, voff) do { _Pragma("unroll") for (int _i = 0; _i < 2; ++_i) \
        __builtin_amdgcn_global_load_lds((const unsigned*)((const char*)(gbase) + (voff)[_i]), (PG8_LAS unsigned*)(lds + (bufoff) + ldsw + _i * 8192), 16, 0, 0); } while (0)
#define PG8_LDA(dst, b, h) do { _Pragma("unroll") for (int m = 0; m < 4; ++m) _Pragma("unroll") for (int k = 0; k < 2; ++k) dst[m][k] = *(const PG8_LAS bf16x8*)(lds + PG8_SA(b, h) + aoff + m * 2048 + k * kstr); } while (0)
#define PG8_LDB(dst, b, h) do { _Pragma("unroll") for (int n = 0; n < 2; ++n) _Pragma("unroll") for (int k = 0; k < 2; ++k) dst[n][k] = *(const PG8_LAS bf16x8*)(lds + PG8_SB(b, h) + boff + n * 2048 + k * kstr); } while (0)
#define PG8_MMA(ai, bj, At, Bt) do { __builtin_amdgcn_s_setprio(1); _Pragma("unroll") for (int m = 0; m < 4; ++m) _Pragma("unroll") for (int n = 0; n < 2; ++n) { \
        if constexpr (FP8) mfma8(acc[ai][bj][m][n], cat8(Bt[n][0], Bt[n][1]), cat8(At[m][0], At[m][1]), one8); \
        else { _Pragma("unroll") for (int k = 0; k < 2; ++k) acc[ai][bj][m][n] = __builtin_amdgcn_mfma_f32_16x16x32_bf16(Bt[n][k], At[m][k], acc[ai][bj][m][n], 0, 0, 0); } } \
        __builtin_amdgcn_s_setprio(0); } while (0)
#define PG8_WAIT_V(n) asm volatile("s_waitcnt vmcnt(" #n ")" ::: "memory")
#define PG8_WAIT_L(n) asm volatile("s_waitcnt lgkmcnt(" #n ")" ::: "memory")
#define PG8_BAR __builtin_amdgcn_s_barrier()
#define PG8_SCHED __builtin_amdgcn_sched_barrier(0)
    int one8 = 0x7f7f7f7f; asm volatile("" : "+v"(one8));
    Unit cur, nxt; int ui = 0;
    if (!S.next(0, cur)) return;
    f32x4 acc[2][2][4][2];
#pragma unroll
    for (int a = 0; a < 2; ++a)
#pragma unroll
        for (int b = 0; b < 2; ++b)
#pragma unroll
            for (int m = 0; m < 4; ++m)
#pragma unroll
                for (int n = 0; n < 2; ++n) acc[a][b][m][n] = (f32x4){0.f, 0.f, 0.f, 0.f};
    bf16x8 At[4][2], B0[2][2], B1[2][2];
    const char* cA; const char* cB; S.ptrs(cur, cA, cB);
    if constexpr (Sched::GATHER) S.rows(cur, Rr, Cc, vA);
    PG8_STAGE(PG8_SB(0, 0), cB, voffB); PG8_STAGE(PG8_SB(0, 1), cB + hstepB, voffB); PG8_STAGE(PG8_SA(0, 0), cA, vA[0]); PG8_STAGE(PG8_SA(0, 1), cA, vA[1]);
    if (wr == 1) PG8_BAR;
    PG8_WAIT_V(2); PG8_BAR;
    PG8_STAGE(PG8_SB(1, 0), cB + kstep, voffB); PG8_STAGE(PG8_SA(1, 0), cA + kstep, vA[0]); PG8_STAGE(PG8_SB(1, 1), cB + hstepB + kstep, voffB);
    PG8_WAIT_V(6); PG8_BAR;
    for (;;) {
        const bool has_next = S.next(ui + 1, nxt);
        const char* nA = cA; const char* nB = cB;
        if (has_next) { S.ptrs(nxt, nA, nB); if constexpr (Sched::GATHER) S.rows(nxt, Rr, Cc, vN); }
        else { if constexpr (Sched::GATHER) {
#pragma unroll
            for (int h = 0; h < 2; ++h)
#pragma unroll
                for (int i = 0; i < 2; ++i) vN[h][i] = vA[h][i]; } }
        for (int t = 0; t < nt; t += 2) {
            const bool last = (t == nt - 2);
            if constexpr (Epi::MID_T > 0) { if (t == Epi::MID_T) { if constexpr (FP8) MFMA_DRAIN(); E.mid(acc, cur, wr, wc, fr, fq); } }
            const char* a1 = cA + (size_t)(t + 1) * kstep;
            const char* a2 = last ? nA : cA + (size_t)(t + 2) * kstep; const char* b2 = last ? nB : cB + (size_t)(t + 2) * kstep;
            const char* a3 = a2 + kstep; const char* b3 = b2 + kstep;
            PG8_LDB(B0, 0, 0); PG8_LDB(B1, 0, 1); PG8_SCHED; PG8_LDA(At, 0, 0); PG8_STAGE(PG8_SA(1, 1), a1, vA[1]);
            PG8_WAIT_V(8); PG8_WAIT_L(0); PG8_BAR; PG8_MMA(0, 0, At, B0); PG8_MMA(0, 1, At, B1); PG8_BAR; PG8_SCHED;
            if constexpr (Sched::GATHER) { if (last) {
#pragma unroll
                for (int h = 0; h < 2; ++h)
#pragma unroll
                    for (int i = 0; i < 2; ++i) vA[h][i] = vN[h][i]; } }
            PG8_LDA(At, 0, 1); PG8_STAGE(PG8_SB(0, 0), b2, voffB); PG8_STAGE(PG8_SB(0, 1), b2 + hstepB, voffB); PG8_STAGE(PG8_SA(0, 0), a2, vA[0]);
            PG8_WAIT_V(8); PG8_WAIT_L(0); PG8_BAR; PG8_MMA(1, 0, At, B0); PG8_MMA(1, 1, At, B1); PG8_BAR; PG8_SCHED;
            PG8_LDB(B0, 1, 0); PG8_LDB(B1, 1, 1); PG8_SCHED; PG8_LDA(At, 1, 0); PG8_STAGE(PG8_SA(0, 1), a2, vA[1]);
            PG8_WAIT_V(8); PG8_WAIT_L(0); PG8_BAR; PG8_MMA(0, 0, At, B0); PG8_MMA(0, 1, At, B1); PG8_BAR; PG8_SCHED;
            PG8_LDA(At, 1, 1); PG8_STAGE(PG8_SB(1, 0), b3, voffB); PG8_STAGE(PG8_SB(1, 1), b3 + hstepB, voffB); PG8_STAGE(PG8_SA(1, 0), a3, vA[0]);
            PG8_WAIT_V(8); PG8_WAIT_L(0); PG8_BAR; PG8_MMA(1, 0, At, B0); PG8_MMA(1, 1, At, B1); PG8_BAR; PG8_SCHED;
        }
        if constexpr (ALIGN_EPI) { if (wr == 0) PG8_BAR; }
        if constexpr (FP8) MFMA_DRAIN();
        if constexpr (!Epi::AFTER_DRAIN) { E(acc, cur, wr, wc, fr, fq); }
        if (!has_next) break;
#pragma unroll
        for (int a = 0; a < 2; ++a)
#pragma unroll
            for (int b = 0; b < 2; ++b)
#pragma unroll
                for (int m = 0; m < 4; ++m)
#pragma unroll
                    for (int n = 0; n < 2; ++n) acc[a][b][m][n] = (f32x4){0.f, 0.f, 0.f, 0.f};
        cur = nxt; cA = nA; cB = nB; ++ui;
        if constexpr (ALIGN_EPI) { if (wr == 1) PG8_BAR; }
    }
    PG8_WAIT_V(0);
    if constexpr (!ALIGN_EPI) { if (wr == 0) PG8_BAR; }
    PG8_BAR;
    if constexpr (Epi::AFTER_DRAIN) { E.fused(acc, cur, wr, wc, fr, fq, lds, wid, lane); }
#undef PG8_SA
#undef PG8_SB
#undef PG8_STAGE
#undef PG8_LDA
#undef PG8_LDB
#undef PG8_MMA
#undef PG8_WAIT_V
#undef PG8_WAIT_L
#undef PG8_BAR
#undef PG8_SCHED
}

struct EpiInProj {
    static constexpr bool PERM = true, AFTER_DRAIN = false; static constexpr int MID_T = 0;
    bf16_t* R0; size_t rs; const float* b_gate; int skip;
    __device__ __forceinline__ void operator()(const f32x4 (&acc)[2][2][4][2], const Unit& u, int wr, int wc, int fr, int fq) const {
        const int row0 = u.pm * BM + wr * 64 + fr, cc = wc * 32 + 8 * fq;
        if (skip) return;
        if (u.pn >= 20) {
            const int ch = (u.pn - 20) * 128 + cc;
            f32x4 ba[2], bb[2];
#pragma unroll
            for (int n = 0; n < 2; ++n) { ba[n] = *(const f32x4*)(b_gate + ch + 4 * n); bb[n] = *(const f32x4*)(b_gate + 1024 + ch + 4 * n); }
#pragma unroll
            for (int ai = 0; ai < 2; ++ai)
#pragma unroll
                for (int m = 0; m < 4; ++m) {
                    const f32x4 a0 = sig4(acc[ai][0][m][0] + ba[0]), a1 = sig4(acc[ai][0][m][1] + ba[1]), g0 = sig4(acc[ai][1][m][0] + bb[0]), g1 = sig4(acc[ai][1][m][1] + bb[1]);
                    f32x4 r0, r1;
#pragma unroll
                    for (int j = 0; j < 4; ++j) { r0[j] = a0[j] * __builtin_amdgcn_rcpf(g0[j]); r1[j] = a1[j] * __builtin_amdgcn_rcpf(g1[j]); }
                    u32x4 w; w.x = cvt_pk_bf16(r0[0], r0[1]); w.y = cvt_pk_bf16(r0[2], r0[3]); w.z = cvt_pk_bf16(r1[0], r1[1]); w.w = cvt_pk_bf16(r1[2], r1[3]);
                    const size_t o = (size_t)(row0 + ai * HALF + m * 16) * 1024 + ch;
                    *(u32x4*)(R0 + 3 * rs + o) = w;
                    w.x = cvt_pk_bf16(g0[0], g0[1]); w.y = cvt_pk_bf16(g0[2], g0[3]); w.z = cvt_pk_bf16(g1[0], g1[1]); w.w = cvt_pk_bf16(g1[2], g1[3]);
                    *(u32x4*)(R0 + 4 * rs + o) = w; }
        } else if (u.pn < 16) {
            const bool sg = u.pn >= 8; bf16_t* O = R0 + (size_t)(sg ? 1 : 0) * rs + (u.pn & 7) * 128 + cc;
#pragma unroll
            for (int ai = 0; ai < 2; ++ai)
#pragma unroll
                for (int m = 0; m < 4; ++m) {
                    f32x4 b0 = acc[ai][1][m][0], b1 = acc[ai][1][m][1];
                    if (sg) { b0 = sig4(b0); b1 = sig4(b1); }
                    const f32x4 v0 = acc[ai][0][m][0] * b0, v1 = acc[ai][0][m][1] * b1;
                    u32x4 w; w.x = cvt_pk_bf16(v0[0], v0[1]); w.y = cvt_pk_bf16(v0[2], v0[3]); w.z = cvt_pk_bf16(v1[0], v1[1]); w.w = cvt_pk_bf16(v1[2], v1[3]);
                    *(u32x4*)(O + (size_t)(row0 + ai * HALF + m * 16) * 1024) = w; }
        } else {
            const int ct = (u.pn - 16) * 256 + cc;
            bf16_t* O = R0 + (size_t)2 * rs + ct;
#pragma unroll
            for (int ai = 0; ai < 2; ++ai)
#pragma unroll
                for (int m = 0; m < 4; ++m)
#pragma unroll
                    for (int bj = 0; bj < 2; ++bj) {
                        const f32x4 v0 = acc[ai][bj][m][0], v1 = acc[ai][bj][m][1];
                        u32x4 w; w.x = cvt_pk_bf16(v0[0], v0[1]); w.y = cvt_pk_bf16(v0[2], v0[3]); w.z = cvt_pk_bf16(v1[0], v1[1]); w.w = cvt_pk_bf16(v1[2], v1[3]);
                        *(u32x4*)(O + (size_t)(row0 + ai * HALF + m * 16) * 1024 + bj * HALF) = w; }
        }
    }
};

struct EpiMix {
    static constexpr bool PERM = true, AFTER_DRAIN = false; static constexpr int MID_T = 16;
    const bf16_t *GA, *GB; bf16_t* MIX;
    __device__ __forceinline__ void mid(f32x4 (&acc)[2][2][4][2], const Unit& u, int wr, int wc, int fr, int fq) const {
        int row0 = u.pm * BM + wr * 64 + fr, col0 = u.pn * BM + wc * 32 + 8 * fq;
        asm volatile("" : "+v"(row0), "+v"(col0));
        u32x4 gb_[2][2];
#pragma unroll
        for (int bj = 0; bj < 2; ++bj) gb_[0][bj] = *(const u32x4*)(GA + (size_t)row0 * 1024 + col0 + bj * HALF);
#pragma unroll
        for (int g = 0; g < 8; ++g) { const int ai = g >> 2, m = g & 3;
            if (g < 7) { const int ai2 = (g + 1) >> 2, m2 = (g + 1) & 3;
#pragma unroll
                for (int bj = 0; bj < 2; ++bj) gb_[(g + 1) & 1][bj] = *(const u32x4*)(GA + (size_t)(row0 + ai2 * HALF + m2 * 16) * 1024 + col0 + bj * HALF); }
            asm volatile("" ::: "memory");
#pragma unroll
            for (int bj = 0; bj < 2; ++bj) { const u32x4 gr = gb_[g & 1][bj];
                acc[ai][bj][m][0] *= bfx4((u32x2){gr.x, gr.y}); acc[ai][bj][m][1] *= bfx4((u32x2){gr.z, gr.w}); }
        }
    }
    __device__ __forceinline__ void operator()(const f32x4 (&acc)[2][2][4][2], const Unit& u, int wr, int wc, int fr, int fq) const {
        int row0 = u.pm * BM + wr * 64 + fr, col0 = u.pn * BM + wc * 32 + 8 * fq;
        asm volatile("" : "+v"(row0), "+v"(col0));
        u32x4 gb_[2][2];
#pragma unroll
        for (int bj = 0; bj < 2; ++bj) gb_[0][bj] = *(const u32x4*)(GB + (size_t)row0 * 1024 + col0 + bj * HALF);
#pragma unroll
        for (int g = 0; g < 8; ++g) { const int ai = g >> 2, m = g & 3;
            if (g < 7) { const int ai2 = (g + 1) >> 2, m2 = (g + 1) & 3;
#pragma unroll
                for (int bj = 0; bj < 2; ++bj) gb_[(g + 1) & 1][bj] = *(const u32x4*)(GB + (size_t)(row0 + ai2 * HALF + m2 * 16) * 1024 + col0 + bj * HALF); }
            asm volatile("" ::: "memory");
#pragma unroll
            for (int bj = 0; bj < 2; ++bj) { const u32x4 gb = gb_[g & 1][bj]; const size_t o = (size_t)(row0 + ai * HALF + m * 16) * 1024 + col0 + bj * HALF;
                const f32x4 v0 = acc[ai][bj][m][0] * bfx4((u32x2){gb.x, gb.y}), v1 = acc[ai][bj][m][1] * bfx4((u32x2){gb.z, gb.w});
                u32x4 w; w.x = cvt_pk_bf16(v0[0], v0[1]); w.y = cvt_pk_bf16(v0[2], v0[3]); w.z = cvt_pk_bf16(v1[0], v1[1]); w.w = cvt_pk_bf16(v1[2], v1[3]);
                *(u32x4*)(MIX + o) = w; }
        }
    }
};
__device__ __forceinline__ unsigned cvt4_fp8(float a, float b, float c, float d) { int w = __builtin_amdgcn_cvt_pk_fp8_f32(a, b, 0, false); w = __builtin_amdgcn_cvt_pk_fp8_f32(c, d, w, true); return (unsigned)w; }
struct EpiWo {
    static constexpr bool PERM = true, AFTER_DRAIN = false; static constexpr int MID_T = 0;
    const float* x; bf16_t* APLE; unsigned char* X8; float* ssp;
    __device__ __forceinline__ void operator()(const f32x4 (&acc)[2][2][4][2], const Unit& u, int wr, int wc, int fr, int fq) const {
        int row0 = u.pm * BM + wr * 64 + fr, col0 = u.pn * BM + wc * 32 + 8 * fq;
        asm volatile("" : "+v"(row0), "+v"(col0));
        f32x4 xb_[2][2][2];
#pragma unroll
        for (int bj = 0; bj < 2; ++bj)
#pragma unroll
            for (int n = 0; n < 2; ++n) xb_[0][bj][n] = *(const f32x4*)(x + (size_t)row0 * 1024 + col0 + bj * HALF + 4 * n);
#pragma unroll
        for (int g = 0; g < 8; ++g) { const int ai = g >> 2, m = g & 3; const int row = row0 + ai * HALF + m * 16; float ss = 0.f;
            if (g < 7) { const int ai2 = (g + 1) >> 2, m2 = (g + 1) & 3;
#pragma unroll
                for (int bj = 0; bj < 2; ++bj)
#pragma unroll
                    for (int n = 0; n < 2; ++n) xb_[(g + 1) & 1][bj][n] = *(const f32x4*)(x + (size_t)(row0 + ai2 * HALF + m2 * 16) * 1024 + col0 + bj * HALF + 4 * n); }
            asm volatile("" ::: "memory");
#pragma unroll
            for (int bj = 0; bj < 2; ++bj) { const size_t o = (size_t)row * 1024 + col0 + bj * HALF;
                const f32x4 v0 = xb_[g & 1][bj][0] + acc[ai][bj][m][0], v1 = xb_[g & 1][bj][1] + acc[ai][bj][m][1];
                ss += ((v0[0] * v0[0] + v0[1] * v0[1]) + (v0[2] * v0[2] + v0[3] * v0[3])) + ((v1[0] * v1[0] + v1[1] * v1[1]) + (v1[2] * v1[2] + v1[3] * v1[3]));
                u32x4 w; w.x = cvt_pk_bf16(v0[0], v0[1]); w.y = cvt_pk_bf16(v0[2], v0[3]); w.z = cvt_pk_bf16(v1[0], v1[1]); w.w = cvt_pk_bf16(v1[2], v1[3]);
                *(u32x4*)(APLE + (size_t)row * 1280 + 256 + col0 + bj * HALF) = w;
                u32x2 q; q.x = cvt4_fp8(v0[0], v0[1], v0[2], v0[3]); q.y = cvt4_fp8(v1[0], v1[1], v1[2], v1[3]);
                *(u32x2*)(X8 + o) = q; }
            ss += __shfl_xor(ss, 16); ss += __shfl_xor(ss, 32);
            if (fq == 0) ssp[(size_t)row * 16 + u.pn * 4 + wc] = ss; }
    }
};
struct EpiRouter {
    static constexpr bool PERM = false, AFTER_DRAIN = true; static constexpr int MID_T = 0;
    const float* ssp1; const float* brg; const float* bre; unsigned* cnt; int* tok_e; float* tok_w; int* tok_pos; float* r1; int* ltok; float* lw; float* lr;
    __device__ __forceinline__ void fused(f32x4 (&acc)[2][2][4][2], const Unit& u, int wr, int wc, int fr, int fq, PG8_LAS unsigned char* lds, int wid, int lane) const {
        PG8_LAS float* L = (PG8_LAS float*)lds;
        PG8_LAS int* hist = (PG8_LAS int*)(lds + 40960);
        const int tid = wid * 64 + lane;
        if (tid < 64) hist[tid] = 0;
        if (wc == 0) {
#pragma unroll
            for (int ai = 0; ai < 2; ++ai)
#pragma unroll
                for (int m = 0; m < 4; ++m)
#pragma unroll
                    for (int n = 0; n < 2; ++n) *(PG8_LAS f32x4*)(L + (ai * HALF + wr * 64 + m * 16 + fr) * 40 + 16 * n + 4 * fq) = acc[ai][0][m][n];
        } else if (wc == 1 && fq == 0) {
#pragma unroll
            for (int ai = 0; ai < 2; ++ai)
#pragma unroll
                for (int m = 0; m < 4; ++m) *(PG8_LAS f32x4*)(L + (ai * HALF + wr * 64 + m * 16 + fr) * 40 + 32) = acc[ai][0][m][0];
        }
        asm volatile("s_waitcnt lgkmcnt(0)" ::: "memory"); __builtin_amdgcn_s_barrier(); asm volatile("" ::: "memory");
        int ea = 0, eb = 0, la = 0, lb = 0; float wa_ = 0.f, wb_ = 0.f, r = 0.f; const int t = u.pm * BM + tid;
        if (tid < 256) {
            float ss = 0.f;
#pragma unroll
            for (int i = 0; i < 16; i += 4) { const f32x4 pv = *(const f32x4*)(ssp1 + (size_t)t * 16 + i); ss += (pv[0] + pv[1]) + (pv[2] + pv[3]); }
            r = rsqrtf(ss * (1.f / 1024.f) + 1e-6f);
            float lg[40];
#pragma unroll
            for (int i = 0; i < 36; i += 4) { const f32x4 v = *(const PG8_LAS f32x4*)(L + tid * 40 + i); lg[i] = v[0]; lg[i + 1] = v[1]; lg[i + 2] = v[2]; lg[i + 3] = v[3]; }
            float gl[4]; int grp = 0;
#pragma unroll
            for (int i = 0; i < 4; ++i) gl[i] = lg[i] * r + brg[i];
            float gm = gl[0];
#pragma unroll
            for (int i = 1; i < 4; ++i) if (gl[i] > gm) { gm = gl[i]; grp = i; }
            float den = 0.f;
#pragma unroll
            for (int i = 0; i < 4; ++i) den += __expf(gl[i] - gm);
            const float pg = 1.f / den;
            float el[8];
#pragma unroll
            for (int i = 0; i < 8; ++i) { float v = 0.f;
#pragma unroll
                for (int g2 = 0; g2 < 4; ++g2) v = (grp == g2) ? lg[4 + g2 * 8 + i] * r + bre[g2 * 8 + i] : v;
                el[i] = v; }
            int i0 = 0; float v0 = el[0];
#pragma unroll
            for (int i = 1; i < 8; ++i) if (el[i] > v0) { v0 = el[i]; i0 = i; }
            int i1 = -1; float v1 = -3.0e38f;
#pragma unroll
            for (int i = 0; i < 8; ++i) if (i != i0 && el[i] > v1) { v1 = el[i]; i1 = i; }
            const float e1 = __expf(v1 - v0); const float s0 = 1.f / (1.f + e1), s1 = e1 / (1.f + e1);
            ea = grp * 8 + i0; eb = grp * 8 + i1; wa_ = s0 * pg; wb_ = s1 * pg;
            la = __hip_atomic_fetch_add(&hist[ea], 1, __ATOMIC_RELAXED, __HIP_MEMORY_SCOPE_WORKGROUP); lb = __hip_atomic_fetch_add(&hist[eb], 1, __ATOMIC_RELAXED, __HIP_MEMORY_SCOPE_WORKGROUP);
        }
        asm volatile("s_waitcnt lgkmcnt(0)" ::: "memory"); __builtin_amdgcn_s_barrier(); asm volatile("" ::: "memory");
        if (tid < 32) { const int h = hist[tid]; hist[32 + tid] = h ? (int)atomicAdd(cnt + tid, (unsigned)h) : 0; }
        asm volatile("s_waitcnt vmcnt(0) lgkmcnt(0)" ::: "memory"); __builtin_amdgcn_s_barrier(); asm volatile("" ::: "memory");
        if (tid < 256) {
            const int pa = hist[32 + ea] + la, pb = hist[32 + eb] + lb;
            tok_e[t * 2] = ea; tok_e[t * 2 + 1] = eb; tok_w[t * 2] = wa_; tok_w[t * 2 + 1] = wb_; tok_pos[t * 2] = pa; tok_pos[t * 2 + 1] = pb; r1[t] = r;
            ltok[(size_t)ea * 32768 + pa] = t; lw[(size_t)ea * 32768 + pa] = wa_; lr[(size_t)ea * 32768 + pa] = r;
            ltok[(size_t)eb * 32768 + pb] = t; lw[(size_t)eb * 32768 + pb] = wb_; lr[(size_t)eb * 32768 + pb] = r;
        }
    }
};
template <bool GATHER_> struct MoeOrder {
    static constexpr bool GATHER = GATHER_;
    const PG8_LAS int* tab; int nwg, G, c; const char* A; const char* Bt; size_t bexp, btile; int lda; const int* ltok;
    __device__ __forceinline__ bool next(int i, Unit& u) const {
        const long L = (long)i * G + c; if (L >= nwg) return false;
        int wgid = (int)L; { const int q = nwg / NXCD, r = nwg % NXCD, xcd = wgid % NXCD, off = wgid / NXCD; wgid = (xcd < r ? xcd * (q + 1) : r * (q + 1) + (xcd - r) * q) + off; }
        int e = 0;
        for (int k = 1; k < 32; ++k) e += (__builtin_amdgcn_readfirstlane(tab[k]) <= wgid) ? 1 : 0;
        const int rem = wgid - __builtin_amdgcn_readfirstlane(tab[e]);
        u.pn = rem & 3; u.pm = rem >> 2; u.e = e; u.nrow = __builtin_amdgcn_readfirstlane(tab[80 + e]) - 256 * u.pm; u.slot0 = __builtin_amdgcn_readfirstlane(tab[40 + e]) + 256 * u.pm; return true;
    }
    __device__ __forceinline__ void ptrs(const Unit& u, const char*& cA, const char*& cB) const {
        cA = GATHER ? A : A + (size_t)u.slot0 * lda * 2; cB = Bt + (size_t)u.e * bexp + (size_t)u.pn * btile; }
    __device__ __forceinline__ void rows(const Unit& u, const int (&Rr)[2], const int (&Cc)[2], unsigned (&off)[2][2]) const {
#pragma unroll
        for (int h = 0; h < 2; ++h)
#pragma unroll
            for (int i = 0; i < 2; ++i) { const int r = h * HALF + Rr[i]; const int tok = (r < u.nrow) ? ltok[(size_t)u.e * 32768 + 256 * u.pm + r] : 0; off[h][i] = (unsigned)(tok * lda + Cc[i]) * 2u; }
    }
};
constexpr float SW1 = 32.f, SW2 = 16.f, SH = 4.f, SWP = 16.f, SWG = 32.f;
struct EpiMoeUp {
    static constexpr bool PERM = true, AFTER_DRAIN = false; static constexpr int MID_T = 0;
    const float* lr; unsigned char* HMID8;
    __device__ __forceinline__ void operator()(const f32x4 (&acc)[2][2][4][2], const Unit& u, int wr, int wc, int fr, int fq) const {
        const int cc = u.pn * 128 + wc * 32 + 8 * fq;
#pragma unroll
        for (int ai = 0; ai < 2; ++ai)
#pragma unroll
            for (int m = 0; m < 4; ++m) { const int row = ai * HALF + wr * 64 + m * 16 + fr;
                if (row < u.nrow) { const float r = lr[(size_t)u.e * 32768 + 256 * u.pm + row] * (1.f / SW1);
                    f32x4 v[2];
#pragma unroll
                    for (int n = 0; n < 2; ++n)
#pragma unroll
                        for (int j = 0; j < 4; ++j) { const float g = acc[ai][0][m][n][j] * r, up = acc[ai][1][m][n][j] * r; v[n][j] = g * fsig(g) * up * SH; }
                    u32x2 q; q.x = cvt4_fp8(v[0][0], v[0][1], v[0][2], v[0][3]); q.y = cvt4_fp8(v[1][0], v[1][1], v[1][2], v[1][3]);
                    *(u32x2*)(HMID8 + (size_t)(u.slot0 + row) * 512 + cc) = q; } }
    }
};
constexpr float SY = 8.f;
struct EpiMoeDown {
    static constexpr bool PERM = true, AFTER_DRAIN = false; static constexpr int MID_T = 0;
    const float* lw; unsigned char* YB;
    __device__ __forceinline__ void operator()(const f32x4 (&acc)[2][2][4][2], const Unit& u, int wr, int wc, int fr, int fq) const {
        const int cc = u.pn * 256 + wc * 32 + 8 * fq;
#pragma unroll
        for (int ai = 0; ai < 2; ++ai)
#pragma unroll
            for (int m = 0; m < 4; ++m) { const int row = ai * HALF + wr * 64 + m * 16 + fr;
                if (row < u.nrow) { const float gw = lw[(size_t)u.e * 32768 + 256 * u.pm + row] * (SY / (SH * SW2));
#pragma unroll
                    for (int bj = 0; bj < 2; ++bj) { const f32x4 v0 = acc[ai][bj][m][0] * gw, v1 = acc[ai][bj][m][1] * gw;
                        u32x2 q; q.x = cvt4_fp8(v0[0], v0[1], v0[2], v0[3]); q.y = cvt4_fp8(v1[0], v1[1], v1[2], v1[3]);
                        *(u32x2*)(YB + (size_t)(u.slot0 + row) * 1024 + cc + bj * HALF) = q; } } }
    }
};
struct EpiPle {
    static constexpr bool PERM = true, AFTER_DRAIN = false; static constexpr int MID_T = 2;
    const bf16_t* APLE; const float* r2; bf16_t* X3; float* ssp; u32x4* scr;
    __device__ __forceinline__ void mid(f32x4 (&acc)[2][2][4][2], const Unit&, int, int, int, int) const {
        int tid = threadIdx.x;
        asm volatile("" : "+v"(tid));
#pragma unroll
        for (int ai = 0; ai < 2; ++ai)
#pragma unroll
            for (int bj = 0; bj < 2; ++bj)
#pragma unroll
                for (int m = 0; m < 4; ++m) { const f32x4 v0 = acc[ai][bj][m][0] * (1.f / SWP), v1 = acc[ai][bj][m][1] * (1.f / SWP);
                    u32x4 w; w.x = cvt_pk_bf16(v0[0], v0[1]); w.y = cvt_pk_bf16(v0[2], v0[3]); w.z = cvt_pk_bf16(v1[0], v1[1]); w.w = cvt_pk_bf16(v1[2], v1[3]);
                    scr[((ai * 2 + bj) * 4 + m) * 512 + tid] = w; acc[ai][bj][m][0] = (f32x4){0.f, 0.f, 0.f, 0.f}; acc[ai][bj][m][1] = (f32x4){0.f, 0.f, 0.f, 0.f}; asm volatile("" ::: "memory"); }
    }
    __device__ __forceinline__ void operator()(const f32x4 (&acc)[2][2][4][2], const Unit& u, int wr, int wc, int fr, int fq) const {
        int tid = threadIdx.x; int row0 = u.pm * BM + wr * 64 + fr, col0 = u.pn * BM + wc * 32 + 8 * fq;
        asm volatile("" : "+v"(tid), "+v"(row0), "+v"(col0));
        u32x4 pr_[2][2], rs_[2][2]; float rr_[2];
#define PLE_LOAD(g_, b_) do { const int ai_ = (g_) >> 2, m_ = (g_) & 3, row_ = row0 + ai_ * HALF + m_ * 16; rr_[b_] = r2[row_]; \
        _Pragma("unroll") for (int bj = 0; bj < 2; ++bj) { \
            pr_[b_][bj] = scr[((ai_ * 2 + bj) * 4 + m_) * 512 + tid]; rs_[b_][bj] = *(const u32x4*)(APLE + (size_t)row_ * 1280 + 256 + col0 + bj * HALF); } } while (0)
        PLE_LOAD(0, 0);
#pragma unroll
        for (int g = 0; g < 8; ++g) { const int ai = g >> 2, m = g & 3; const int row = row0 + ai * HALF + m * 16;
            if (g < 7) PLE_LOAD(g + 1, (g + 1) & 1);
            asm volatile("" ::: "memory");
            const float rr = rr_[g & 1] * (1.f / SWG); float ss = 0.f;
#pragma unroll
            for (int bj = 0; bj < 2; ++bj) { const u32x4 pw = pr_[g & 1][bj], rw = rs_[g & 1][bj];
                const f32x4 v0 = bfx4((u32x2){rw.x, rw.y}) + sig4(acc[ai][bj][m][0] * rr) * bfx4((u32x2){pw.x, pw.y});
                const f32x4 v1 = bfx4((u32x2){rw.z, rw.w}) + sig4(acc[ai][bj][m][1] * rr) * bfx4((u32x2){pw.z, pw.w});
                u32x4 w; w.x = cvt_pk_bf16(v0[0], v0[1]); w.y = cvt_pk_bf16(v0[2], v0[3]); w.z = cvt_pk_bf16(v1[0], v1[1]); w.w = cvt_pk_bf16(v1[2], v1[3]);
                *(u32x4*)(X3 + (size_t)row * 1024 + col0 + bj * HALF) = w;
                ss += ((v0[0] * v0[0] + v0[1] * v0[1]) + (v0[2] * v0[2] + v0[3] * v0[3])) + ((v1[0] * v1[0] + v1[1] * v1[1]) + (v1[2] * v1[2] + v1[3] * v1[3])); }
            ss += __shfl_xor(ss, 16); ss += __shfl_xor(ss, 32);
            if (fq == 0) ssp[(size_t)row * 16 + u.pn * 4 + wc] = ss; }
#undef PLE_LOAD
    }
};
}

#define GAS __attribute__((address_space(1)))
#define LAS __attribute__((address_space(3)))
typedef unsigned v4u __attribute__((ext_vector_type(4)));
typedef GAS unsigned gu32;
constexpr int NWAVES = 8;
constexpr int RING_BYTES = 131072, LDSCTL_OFF = RING_BYTES + 4096, MISC_OFF = LDSCTL_OFF + 320, LDS_BYTES = 147456;
constexpr size_t WS_WIN = 12 * MiB, WS_WAB = 26 * MiB, WS_WO = 30 * MiB, WS_WPLE = 32 * MiB, WS_WR = 35 * MiB, WS_WGU = 36 * MiB, WS_WD = 100 * MiB;
constexpr size_t WS_LR = 132 * MiB;
constexpr size_t WS_SCR = 464 * MiB;
constexpr size_t WS_END2 = 496 * MiB;
constexpr int CW_BAR = 4096;
#define LDS_WAIT() asm volatile("s_waitcnt lgkmcnt(0)" ::: "memory")
#define VM_WAIT() asm volatile("s_waitcnt vmcnt(0)" ::: "memory")

#define XB_TMO      128
#define XB_XCNT(j)  (256  + 64 * (j))
#define XB_XSUB(j)  (1280 + 64 * (j))
#define XB_XGEN(j)  (2304 + 64 * (j))
#define XB_TOP      3328
#define XB_TOPGEN   3392
#define XCD_BAR_WORDS 3456
#define XB_SPIN_CAP (1u << 18)
__device__ __forceinline__ unsigned xb_ld(unsigned* p)              { return __hip_atomic_load(p, __ATOMIC_RELAXED, __HIP_MEMORY_SCOPE_AGENT); }
__device__ __forceinline__ unsigned xb_add(unsigned* p, unsigned v) { return __hip_atomic_fetch_add(p, v, __ATOMIC_RELAXED, __HIP_MEMORY_SCOPE_AGENT); }
__device__ __forceinline__ unsigned xb_xcc_id() { return (unsigned)__builtin_amdgcn_s_getreg((3 << 11) | 20) & 0xFu; }
#define XB_SPIN(cond, bar) do { unsigned _sp = 0; while (cond) { __builtin_amdgcn_s_sleep(1); \
    if ((++_sp & 255u) == 0u) { if (xb_ld(&(bar)[XB_TMO])) break; if (_sp > XB_SPIN_CAP) { atomicAdd(&(bar)[XB_TMO], 1u); break; } } } } while (0)
struct XcdBarrier { unsigned* bar; unsigned x; volatile LAS unsigned* st; };
__device__ __forceinline__ XcdBarrier xcd_barrier_post(unsigned* bar, volatile LAS unsigned* st) {
    XcdBarrier b; b.bar = bar; b.x = xb_xcc_id(); b.st = st;
    if (threadIdx.x == 0) (void)xb_add(&bar[XB_XCNT(b.x)], 1u);
    return b;
}
__device__ __forceinline__ void xcd_barrier_complete(unsigned* bar, unsigned x, unsigned& nloc, unsigned& nx) {
    const unsigned G = gridDim.x * gridDim.y * gridDim.z;
    unsigned sum, cnt, mine, sp = 0u;
    for (;;) {
        sum = 0u; cnt = 0u; mine = 0u;
#pragma unroll
        for (unsigned j = 0; j < 16; ++j) { const unsigned c = xb_ld(&bar[XB_XCNT(j)]); sum += c; cnt += (c > 0u) ? 1u : 0u; mine = (j == x) ? c : mine; }
        if (sum == G) break;
        __builtin_amdgcn_s_sleep(1);
        if ((++sp & 255u) == 0u) { if (xb_ld(&bar[XB_TMO])) break; if (sp > XB_SPIN_CAP) { atomicAdd(&bar[XB_TMO], 1u); break; } }
    }
    nloc = mine > 0u ? mine : 1u; nx = cnt > 0u ? cnt : 1u;
}
__device__ __forceinline__ void xcd_barrier(const XcdBarrier& b) {
    asm volatile("s_waitcnt vmcnt(0)" ::: "memory");
    __syncthreads();
    if (threadIdx.x == 0) {
        unsigned* bar = b.bar;
        __builtin_amdgcn_s_waitcnt(0);
        unsigned nloc = b.st[0], nx = b.st[1];
        if (nloc == 0u) { xcd_barrier_complete(bar, b.x, nloc, nx); b.st[0] = nloc; b.st[1] = nx; }
        const unsigned old = xb_add(&bar[XB_XSUB(b.x)], 1u);
        const unsigned gen = old / nloc;
        if (old + 1u == (gen + 1u) * nloc) {
            __builtin_amdgcn_fence(__ATOMIC_RELEASE, "agent");
            asm volatile("s_waitcnt vmcnt(0)" ::: "memory");
            const unsigned og = xb_add(&bar[XB_TOP], 1u);
            const unsigned tg = og / nx;
            if (og + 1u == (tg + 1u) * nx) xb_add(&bar[XB_TOPGEN], 1u);
            else XB_SPIN(xb_ld(&bar[XB_TOPGEN]) == tg, bar);
            __builtin_amdgcn_fence(__ATOMIC_ACQUIRE, "agent");
            xb_add(&bar[XB_XGEN(b.x)], 1u);
            asm volatile("s_waitcnt vmcnt(0)" ::: "memory");
        } else {
            XB_SPIN(xb_ld(&bar[XB_XGEN(b.x)]) == gen, bar);
            __builtin_amdgcn_fence(__ATOMIC_ACQUIRE, "agent");
            asm volatile("s_waitcnt vmcnt(0)" ::: "memory");
        }
    }
    __syncthreads();
}

__device__ __forceinline__ unsigned pk2(float lo, float hi) { return f2bf(lo) | (f2bf(hi) << 16); }
struct TrItem { const float* W; const float* scale; unsigned char* dst; int ldn, k0, n0, ldb, drow0, dk0, fp8; float mul; };
__device__ __forceinline__ void tr_load(const TrItem& t, float4 (&v)[16], int lane) {
    const int lr_ = lane >> 4, lc = (lane & 15) * 4;
#pragma unroll
    for (int i = 0; i < 16; ++i) v[i] = *(const float4*)(t.W + (size_t)(t.k0 + 4 * i + lr_) * t.ldn + t.n0 + lc);
}
__device__ __forceinline__ void tr_finish(const TrItem& t, const float4 (&v)[16], LAS float* scr, int lane) {
    const int lr_ = lane >> 4, lc = (lane & 15) * 4;
#pragma unroll
    for (int i = 0; i < 16; ++i) { const int kk = 4 * i + lr_; const float sc = (t.scale ? t.scale[t.k0 + kk] : 1.f) * t.mul; LAS float* d = scr + kk * 65 + lc;
        d[0] = v[i].x * sc; d[1] = v[i].y * sc; d[2] = v[i].z * sc; d[3] = v[i].w * sc; }
    LDS_WAIT(); asm volatile("" ::: "memory");
    const int c = lane & 7;
    if (t.fp8) {
#pragma unroll
        for (int j = 0; j < 8; ++j) { const int n = (lane >> 3) + 8 * j; const LAS float* s_ = scr + (8 * c) * 65 + n;
            uint2 o; o.x = pg8::cvt4_fp8(s_[0 * 65], s_[1 * 65], s_[2 * 65], s_[3 * 65]); o.y = pg8::cvt4_fp8(s_[4 * 65], s_[5 * 65], s_[6 * 65], s_[7 * 65]);
            *(uint2*)(t.dst + (size_t)(t.drow0 + n) * t.ldb + t.dk0 + t.k0 + 8 * c) = o; }
    } else {
#pragma unroll
        for (int j = 0; j < 8; ++j) { const int n = (lane >> 3) + 8 * j; const LAS float* s_ = scr + (8 * c) * 65 + n;
            v4u o; o.x = pk2(s_[0 * 65], s_[1 * 65]); o.y = pk2(s_[2 * 65], s_[3 * 65]); o.z = pk2(s_[4 * 65], s_[5 * 65]); o.w = pk2(s_[6 * 65], s_[7 * 65]);
            *(GAS v4u*)((bf16*)t.dst + (size_t)(t.drow0 + n) * t.ldb + t.dk0 + t.k0 + 8 * c) = o; }
    }
    LDS_WAIT(); asm volatile("" ::: "memory");
}
__device__ __forceinline__ void tr_item8(const float* __restrict__ W, int ldn, int k0, int n0, unsigned char* dst, int ldb, int drow0, const float* __restrict__ scale, float mul, LAS float* scr, int lane) {
    TrItem t{W, scale, dst, ldn, k0, n0, ldb, drow0, 0, 1, mul}; float4 v[16]; tr_load(t, v, lane); tr_finish(t, v, scr, lane);
}
__device__ __forceinline__ int map_in(int n0) {
    const int q = n0 >> 7, s = q >> 3, i = q & 7, off = n0 & 127;
    if (s == 0) return 4096 + 128 * i + off;
    if (s == 1) return 256 * i + off;
    if (s == 2) return 256 * i + 128 + off;
    if (s == 3) return 256 * (8 + i) + off;
    if (s == 4) return 256 * (8 + i) + 128 + off;
    if (s == 5) return 5120 + 256 * i + off;
    return 5120 + 256 * i + 128 + off;
}

struct Args { const float* in[25]; float* out; unsigned char* ws; int ph_lo, ph_hi; };

__global__ void __launch_bounds__(NWAVES * 64, 2) mega(Args args) {
    extern __shared__ __attribute__((aligned(16))) unsigned char lds_raw[];
    LAS unsigned char* lds = (LAS unsigned char*)lds_raw;
    volatile LAS unsigned* MISC = (volatile LAS unsigned*)(lds + MISC_OFF);
    const int tid = threadIdx.x, lane = tid & 63, wave = __builtin_amdgcn_readfirstlane(tid >> 6);
    const int G = gridDim.x; const int bx = blockIdx.x; const int vcu = (G % 8 == 0) ? (bx % 8) * (G / 8) + bx / 8 : bx;
    unsigned char* ws = args.ws;
    gu32* ctl = (gu32*)(ws + WS_CTL);
    for (int u = tid; u < (LDS_BYTES - LDSCTL_OFF) / 4; u += NWAVES * 64) ((LAS unsigned*)(lds + LDSCTL_OFF))[u] = 0u;
    __syncthreads();
    XcdBarrier bar = xcd_barrier_post((unsigned*)(ctl + CW_BAR), MISC + 8);
    const int lo = args.ph_lo, hi = args.ph_hi;
#ifndef PH_MASK
#define PH_MASK 0x7ff
#endif
#define IN(k) (((PH_MASK >> (k)) & 1) && lo <= (k) && (k) < hi)
#define BOTH(k) (IN(k) && (IN((k) + 1) || rep_ + 1 < NREP(k)))
#ifndef REP_MASK
#define REP_MASK 0
#endif
#ifndef PROBE_SKIP_EPI
#define PROBE_SKIP_EPI 0
#endif
#define NREP(k) (((REP_MASK >> (k)) & 1) ? 2 : 1)
#ifndef PROBE_TS
#define PROBE_TS -1
#endif
    unsigned long long ts_acc_ = 0ull, ts_t0_ = 0ull;
#define TS_B(k) do { if (PROBE_TS == (k) && bx == 0 && tid == 0) ts_t0_ = __builtin_amdgcn_s_memrealtime(); } while (0)
#define TS_E(k) do { if (PROBE_TS == (k) && bx == 0 && tid == 0) ts_acc_ += __builtin_amdgcn_s_memrealtime() - ts_t0_; } while (0)
#define PHASE(k) if (IN(k)) _Pragma("unroll") for (int rep_ = 0; rep_ < NREP(k); ++rep_)
    const float* x = args.in[0];
    bf16* H = (bf16*)args.out;
    bf16* WinT = (bf16*)(ws + WS_WIN); bf16* WabT = (bf16*)(ws + WS_WAB); bf16* WoT = (bf16*)(ws + WS_WO); bf16* WpleT = (bf16*)(ws + WS_WPLE); bf16* WrT = (bf16*)(ws + WS_WR);
    unsigned char* Wgu8 = ws + WS_WGU; unsigned char* Wd8 = ws + WS_WD;
    bf16* UA = (bf16*)(ws + WS_RA); bf16* UB = (bf16*)(ws + WS_RB); bf16* AB = (bf16*)(ws + WS_RC); bf16* GA = (bf16*)(ws + WS_RD); bf16* GB = (bf16*)(ws + WS_RE);

    TS_B(0);
    PHASE(0) {
        LAS float* scr = (LAS float*)(lds + wave * 16640);
        const int gw = vcu * NWAVES + wave, NGW = G * NWAVES;
        constexpr int I_IN = 16 * 112, I_SQ = 16 * 16, I_PP = 4 * 16, I_EG = 32 * 16 * 8, I_ED = 32 * 8 * 16;
        constexpr int NITEMS = I_IN + 4 * I_SQ + I_PP + 2 * I_EG;
        TS_B(20);
        auto decode = [&](int it) -> TrItem {
            int r = it; TrItem t{}; t.mul = 1.f;
            if (r < 2 * I_EG) { const int up = r >= I_EG; if (up) r -= I_EG; const int e = r / 128, q = r % 128, kb = q / 8, nb = q % 8, n0 = 64 * nb;
                t.W = (up ? args.in[19] : args.in[18]) + (size_t)e * D * DE; t.ldn = DE; t.k0 = 64 * kb; t.n0 = n0; t.dst = Wgu8 + (size_t)e * 1024 * 1024; t.ldb = 1024; t.drow0 = 256 * (n0 >> 7) + (up ? 128 : 0) + (n0 & 127);
                t.scale = args.in[13]; t.mul = pg8::SW1; t.fp8 = 1; return t; } r -= 2 * I_EG;
            t.n0 = 64 * (r % 16); t.k0 = 64 * (r / 16); t.ldn = D; t.drow0 = t.n0;
            if (r < I_IN) { t.W = args.in[3]; t.ldn = INC; t.k0 = 64 * (r / 112); t.n0 = 64 * (r % 112); t.dst = (unsigned char*)WinT; t.ldb = 1024; t.drow0 = map_in(t.n0); return t; } r -= I_IN;
            t.n0 = 64 * (r % 16); t.k0 = 64 * (r / 16); t.drow0 = t.n0;
            if (r < I_SQ) { t.W = args.in[5]; t.dst = (unsigned char*)WabT; t.ldb = 2048; return t; } r -= I_SQ;
            t.n0 = 64 * (r % 16); t.k0 = 64 * (r / 16); t.drow0 = t.n0;
            if (r < I_SQ) { t.W = args.in[10]; t.dst = (unsigned char*)WabT; t.ldb = 2048; t.dk0 = 1024; return t; } r -= I_SQ;
            t.n0 = 64 * (r % 16); t.k0 = 64 * (r / 16); t.drow0 = t.n0;
            if (r < I_SQ) { t.W = args.in[12]; t.dst = (unsigned char*)WoT; t.ldb = 1024; return t; } r -= I_SQ;
            t.n0 = 64 * (r % 16); t.k0 = 64 * (r / 16); t.drow0 = t.n0;
            if (r < I_SQ) { t.W = args.in[22]; t.dst = (unsigned char*)WpleT; t.ldb = 1280; t.dk0 = 256; t.scale = args.in[21]; t.mul = pg8::SWG; t.fp8 = 1; return t; } r -= I_SQ;
            t.n0 = 64 * (r % 16); t.k0 = 64 * (r / 16); t.drow0 = t.n0;
            t.W = args.in[23]; t.dst = (unsigned char*)WpleT; t.ldb = 1280; t.mul = pg8::SWP; t.fp8 = 1; return t;
        };
        {
            float4 va[16], vb[16];
            int it = gw;
            if (it < NITEMS) {
                TrItem ta = decode(it); tr_load(ta, va, lane);
                for (;;) {
                    const int itb = it + NGW; const bool hb = itb < NITEMS; TrItem tb = ta;
                    if (hb) { tb = decode(itb); tr_load(tb, vb, lane); }
                    tr_finish(ta, va, scr, lane);
                    if (!hb) break;
                    const int ita = itb + NGW; const bool ha = ita < NITEMS;
                    if (ha) { ta = decode(ita); tr_load(ta, va, lane); }
                    tr_finish(tb, vb, scr, lane);
                    if (!ha) break;
                    it = ita;
                }
            }
        }
        __syncthreads(); TS_E(20); TS_B(21);
        for (int i = vcu * 512 + tid; i < 256 * 1024; i += G * 512) { const int rr = i >> 10, k = i & 1023; float v = 0.f;
            if (rr < 4) v = args.in[14][k * 4 + rr] * args.in[13][k]; else if (rr < 36) v = args.in[16][k * 32 + rr - 4] * args.in[13][k];
            WrT[i] = (bf16)f2bf(v); }
        __syncthreads(); TS_E(21); TS_B(22);
        const float* g = args.in[2];
        for (int row = 2 * gw; row < T; row += 2 * NGW) {
            const float4* xr = (const float4*)(x + (size_t)row * D);
            float4 v[2][4]; float s0 = 0.f, s1 = 0.f;
#pragma unroll
            for (int j = 0; j < 4; ++j) { v[0][j] = xr[lane + 64 * j]; v[1][j] = xr[256 + lane + 64 * j]; }
#pragma unroll
            for (int j = 0; j < 4; ++j) { s0 += v[0][j].x * v[0][j].x + v[0][j].y * v[0][j].y + v[0][j].z * v[0][j].z + v[0][j].w * v[0][j].w;
                                          s1 += v[1][j].x * v[1][j].x + v[1][j].y * v[1][j].y + v[1][j].z * v[1][j].z + v[1][j].w * v[1][j].w; }
            const float r0 = rsqrtf(wave_sum(s0) * (1.f / D) + EPS), r1_ = rsqrtf(wave_sum(s1) * (1.f / D) + EPS);
#pragma unroll
            for (int j = 0; j < 4; ++j) { const int c = 4 * (lane + 64 * j); const float4 gg = *(const float4*)(g + c);
                uint2 o; o.x = pk2(v[0][j].x * r0 * gg.x, v[0][j].y * r0 * gg.y); o.y = pk2(v[0][j].z * r0 * gg.z, v[0][j].w * r0 * gg.w);
                *(uint2*)(H + (size_t)row * D + c) = o;
                o.x = pk2(v[1][j].x * r1_ * gg.x, v[1][j].y * r1_ * gg.y); o.y = pk2(v[1][j].z * r1_ * gg.z, v[1][j].w * r1_ * gg.w);
                *(uint2*)(H + (size_t)(row + 1) * D + c) = o; }
        }
        __syncthreads(); TS_E(22);
        if (BOTH(0)) xcd_barrier(bar);
    }
    TS_E(0);
    TS_B(1);
    PHASE(1) {
        pg8::Gemm g{1024, 1024, 1024}; pg8::StaticOrder S; S.init(T, INC, G, bx, H, 1024, WinT, 1024);
        pg8::EpiInProj E{UA, (size_t)(WS_RB - WS_RA) / 2, args.in[11], (PROBE_SKIP_EPI && rep_ == 1) ? (args.ph_hi > 5 ? 1 : 0) : 0};
        pg8::gemm_phase<pg8::EpiInProj, pg8::StaticOrder, true>(lds, g, S, E);
        if (BOTH(1)) xcd_barrier(bar);
    }
    TS_E(1);

    bf16* ZZ = (bf16*)args.out; bf16* MIX = (bf16*)(ws + WS_RC); bf16* APLE = (bf16*)(ws + WS_RA);
    unsigned char* A8 = (unsigned char*)args.out;
    unsigned char* HMID8 = ws + WS_RC; unsigned char* YB = ws + WS_RD; bf16* X3 = (bf16*)(ws + WS_RC); unsigned char* X8 = ws + WS_RB + 16 * MiB;
    int* tok_e = (int*)(ws + WS_TOK); float* tok_w = (float*)(ws + WS_TOK + 256 * 1024); int* tok_pos = (int*)(ws + WS_TOK + 512 * 1024);
    float* r1 = (float*)(ws + WS_TOK + 768 * 1024); float* r2 = (float*)(ws + WS_TOK + 896 * 1024);
    float* ssp1 = (float*)(ws + WS_SSP1); float* ssp3 = (float*)(ws + WS_SSP3); int* ltok = (int*)(ws + WS_LTOK); float* lw = (float*)(ws + WS_LW); float* lr = (float*)(ws + WS_LR);
    unsigned* cnt = (unsigned*)(ctl + CW_CNT);
    LAS int* tab = (LAS int*)(lds + LDSCTL_OFF + 1024);
#define MOE_TABLES() do { if (tid == 0) { int us = 0, es = 0; for (int e = 0; e < NE; ++e) { const int c = (int)cnt[e]; tab[e] = us; tab[40 + e] = es; tab[80 + e] = c; us += 4 * ((c + 255) >> 8); es += c; } tab[32] = us; tab[72] = es; } \
        LDS_WAIT(); __syncthreads(); } while (0)

    TS_B(2);
    PHASE(2) {
        typedef float f32x2 __attribute__((ext_vector_type(2)));
        const int c0_ = 2 * tid;
        const float* cwb = args.in[6]; const float* cwa = args.in[4];
        LAS float* red = (LAS float*)(lds + LDSCTL_OFF + 4096); LAS float* tot = (LAS float*)(lds + LDSCTL_OFF + 4096 + 2048);
        const int upw = (1024 + G - 1) / G;
        bool have_prev = false;
        for (int un = vcu * upw; un < (vcu + 1) * upw && un < 1024; ++un) {
            const int t0 = un * 32; const bool first = (t0 & (SEQ - 1)) == 0;
            int c0 = c0_; asm volatile("" : "+v"(c0));
            {
                const int rlo = (have_prev || first) ? 0 : -30;
                const int npieces = (32 - rlo) * 128;
                v4u pc[16];
#pragma unroll
                for (int i = 0; i < 16; ++i) { const int pidx = tid + 512 * i; if (pidx < npieces) { const int row = t0 + rlo + (pidx >> 7);
                        pc[i] = *(const v4u*)(UB + (size_t)row * 1024 + (pidx & 127) * 8); } }
#pragma unroll
                for (int i = 0; i < 16; ++i) { const int pidx = tid + 512 * i; if (pidx < npieces) { const int row = t0 + rlo + (pidx >> 7);
                        *(LAS v4u*)(lds + (row & 63) * 2048 + (pidx & 127) * 16) = pc[i]; } }
            }
            f32x2 wb[31];
#pragma unroll
            for (int k = 0; k < 31; ++k) wb[k] = *(const f32x2*)(cwb + k * 1024 + c0);
            const f32x2 bb = *(const f32x2*)(args.in[7] + c0);
            LDS_WAIT(); __syncthreads();
            f32x2 acc[32];
#pragma unroll
            for (int j = 0; j < 32; ++j) acc[j] = bb;
            const int sb = (t0 + 34) & 63;
#pragma unroll
            for (int si = 0; si < 62; ++si) {
                const bool dead = first && si < 30;
                const unsigned w = *(const LAS unsigned*)(lds + ((sb + si) & 63) * 2048 + tid * 4);
                f32x2 uv = (f32x2){__builtin_bit_cast(float, w << 16), __builtin_bit_cast(float, w & 0xffff0000u)};
                if (dead) uv = (f32x2){0.f, 0.f};
#pragma unroll
                for (int j = (si > 30 ? si - 30 : 0); j <= (si < 31 ? si : 31); ++j) acc[j] += wb[si - j] * uv;
                if ((si & 7) == 7) asm volatile("" ::: "memory");
            }
            float v1[32], v2[32];
#pragma unroll
            for (int j = 0; j < 32; ++j) { v1[j] = acc[j].x + acc[j].y; v2[j] = acc[j].x * acc[j].x + acc[j].y * acc[j].y; }
#define BFLY(v, NN, bit) _Pragma("unroll") for (int i = 0; i < (NN) / 2; ++i) { const bool up_ = (lane & (bit)) != 0; const float keep_ = up_ ? v[i + (NN) / 2] : v[i], send_ = up_ ? v[i] : v[i + (NN) / 2]; v[i] = keep_ + __shfl_xor(send_, (bit)); }
            BFLY(v1, 32, 16) BFLY(v1, 16, 8) BFLY(v1, 8, 4) BFLY(v1, 4, 2) BFLY(v1, 2, 1)
            BFLY(v2, 32, 16) BFLY(v2, 16, 8) BFLY(v2, 8, 4) BFLY(v2, 4, 2) BFLY(v2, 2, 1)
#undef BFLY
            v1[0] += __shfl_xor(v1[0], 32); v2[0] += __shfl_xor(v2[0], 32);
            red[wave * 64 + lane] = lane < 32 ? v1[0] : v2[0];
            LDS_WAIT(); __syncthreads();
            if (tid < 64) { float sm = 0.f;
#pragma unroll
                for (int w8 = 0; w8 < 8; ++w8) sm += red[w8 * 64 + tid];
                tot[tid] = sm; }
            LDS_WAIT(); __syncthreads();
            asm volatile("" : "+v"(c0));
            unsigned rua[34], rab[32];
#pragma unroll
            for (int j = 0; j < 34; ++j) rua[j] = *(const unsigned*)(UA + (size_t)((first && j < 2) ? t0 : t0 - 2 + j) * 1024 + c0);
#pragma unroll
            for (int j = 0; j < 32; ++j) rab[j] = *(const unsigned*)(AB + (size_t)(t0 + j) * 1024 + c0);
            const f32x2 lg = *(const f32x2*)(args.in[8] + c0), lb = *(const f32x2*)(args.in[9] + c0);
#pragma unroll
            for (int j = 0; j < 32; ++j) { const float mu = tot[j] * (1.f / 1024.f); const float var = tot[32 + j] * (1.f / 1024.f) - mu * mu; const float rstd = rsqrtf(var + EPS);
                const f32x2 y = (acc[j] - mu) * rstd * lg + lb;
                *(unsigned*)(ZZ + (size_t)(t0 + j) * 2048 + 1024 + c0) = pg8::cvt_pk_bf16(y.x * pg8::fsig(y.x), y.y * pg8::fsig(y.y)); }
            asm volatile("" : "+v"(c0));
            const f32x2 wa0 = *(const f32x2*)(cwa + c0), wa1 = *(const f32x2*)(cwa + 1024 + c0), wa2 = *(const f32x2*)(cwa + 2048 + c0);
#define BF2(w_) ((f32x2){__builtin_bit_cast(float, (w_) << 16), __builtin_bit_cast(float, (w_) & 0xffff0000u)})
            if (first) { rua[0] = 0u; rua[1] = 0u; }
#pragma unroll
            for (int j = 0; j < 32; ++j) { const f32x2 za = BF2(rab[j]) * (wa0 * BF2(rua[j]) + wa1 * BF2(rua[j + 1]) + wa2 * BF2(rua[j + 2]));
                *(unsigned*)(ZZ + (size_t)(t0 + j) * 2048 + c0) = pg8::cvt_pk_bf16(za.x, za.y); }
#undef BF2
            have_prev = true;
        }
        if (BOTH(2)) xcd_barrier(bar);
    }
    TS_E(2);
    TS_B(3);
    PHASE(3) {
        pg8::Gemm g{2048, 2048, 2048}; pg8::StaticOrder S; S.init(T, D, G, bx, ZZ, 2048, WabT, 2048);
        pg8::EpiMix E{GA, GB, MIX};
        pg8::gemm_phase<pg8::EpiMix, pg8::StaticOrder, true>(lds, g, S, E);
        if (BOTH(3)) xcd_barrier(bar);
    }
    TS_E(3);
    TS_B(4);
    PHASE(4) {
        pg8::Gemm g{1024, 1024, 1024}; pg8::StaticOrder S; S.init(T, D, G, bx, MIX, 1024, WoT, 1024);
        pg8::EpiWo E{x, APLE, X8, ssp1};
        pg8::gemm_phase<pg8::EpiWo, pg8::StaticOrder, true>(lds, g, S, E);
        if (BOTH(4)) xcd_barrier(bar);
    }
    TS_E(4);
    TS_B(5);
    PHASE(5) {
        pg8::Gemm g{1280, 1024, 1024}; pg8::StaticOrder S; S.init(T, 256, G, bx, APLE + 256, 1280, WrT, 1024);
        pg8::EpiRouter E{ssp1, args.in[15], args.in[17], cnt, tok_e, tok_w, tok_pos, r1, ltok, lw, lr};
        pg8::gemm_phase<pg8::EpiRouter, pg8::StaticOrder, false>(lds, g, S, E);
        const int nidle = G > 128 ? G - 128 : G, me = G > 128 ? bx - 128 : bx;
        if (me >= 0) { const float* p = args.in[1];
            { LAS float* scr = (LAS float*)(lds + wave * 16640);
              for (int r = me * NWAVES + wave; r < 32 * 8 * 16; r += nidle * NWAVES) { const int e = r / 128, q = r % 128, kb = q / 16, nb = q % 16;
                  tr_item8(args.in[20] + (size_t)e * DE * D, D, 64 * kb, 64 * nb, Wd8 + (size_t)e * 1024 * 512, 512, 64 * nb, nullptr, pg8::SW2, scr, lane); } }
            const size_t stride = (size_t)nidle * 512;
            for (size_t i0 = (size_t)me * 512 + tid; i0 < (size_t)T * 64; i0 += 8 * stride) {
                float4 v[8];
#pragma unroll
                for (int q = 0; q < 8; ++q) { const size_t i = i0 + q * stride; if (i < (size_t)T * 64) v[q] = *(const float4*)(p + (i >> 6) * PLE + (int)(i & 63) * 4); }
#pragma unroll
                for (int q = 0; q < 8; ++q) { const size_t i = i0 + q * stride; if (i < (size_t)T * 64) *(unsigned*)(A8 + (i >> 6) * 1280 + (int)(i & 63) * 4) = pg8::cvt4_fp8(v[q].x, v[q].y, v[q].z, v[q].w); }
            } }
        if (BOTH(5)) xcd_barrier(bar);
    }
    TS_E(5);
    TS_B(6);
    PHASE(6) {
        MOE_TABLES();
        pg8::Gemm g{512, 512, 512};
        pg8::MoeOrder<true> S{tab, tab[32], G, bx, (const char*)X8, (const char*)Wgu8, (size_t)1024 * 1024, (size_t)256 * 1024, 512, ltok};
        pg8::EpiMoeUp E{lr, HMID8};
        pg8::gemm_phase<pg8::EpiMoeUp, pg8::MoeOrder<true>, true, true>(lds, g, S, E);
        if (BOTH(6)) xcd_barrier(bar);
    }
    TS_E(6);
    TS_B(7);
    PHASE(7) {
        MOE_TABLES();
        pg8::Gemm g{256, 256, 256};
        pg8::MoeOrder<false> S{tab, tab[32], G, bx, (const char*)HMID8, (const char*)Wd8, (size_t)1024 * 512, (size_t)256 * 512, 256, ltok};
        pg8::EpiMoeDown E{lw, YB};
        pg8::gemm_phase<pg8::EpiMoeDown, pg8::MoeOrder<false>, true, true>(lds, g, S, E);
        if (BOTH(7)) xcd_barrier(bar);
    }
    TS_E(7);
    TS_B(8);
    PHASE(8) {
        MOE_TABLES();
        const int gw = vcu * NWAVES + wave, NGW = G * NWAVES;
        for (int t = 2 * gw; t < T; t += 2 * NGW) {
            int sl[2][2];
#pragma unroll
            for (int q = 0; q < 2; ++q) { const int4 te = *(const int4*)(tok_e + t * 2), tp = *(const int4*)(tok_pos + t * 2);
                sl[0][0] = tab[40 + te.x] + tp.x; sl[0][1] = tab[40 + te.y] + tp.y; sl[1][0] = tab[40 + te.z] + tp.z; sl[1][1] = tab[40 + te.w] + tp.w; }
            v4u xv[2][2]; uint2 ya[2][2], yb[2][2];
#pragma unroll
            for (int q = 0; q < 2; ++q)
#pragma unroll
                for (int j = 0; j < 2; ++j) { const int c = 8 * (lane + 64 * j);
                    xv[q][j] = *(const v4u*)(APLE + (size_t)(t + q) * APITCH + 256 + c); ya[q][j] = *(const uint2*)(YB + (size_t)sl[q][0] * D + c); yb[q][j] = *(const uint2*)(YB + (size_t)sl[q][1] * D + c); }
#pragma unroll
            for (int q = 0; q < 2; ++q) { float s_ = 0.f;
#pragma unroll
                for (int j = 0; j < 2; ++j) { const int c = 8 * (lane + 64 * j); v4u o;
#pragma unroll
                    for (int k = 0; k < 4; ++k) { const unsigned wa_ = (k < 2 ? ya[q][j].x : ya[q][j].y), wb_ = (k < 2 ? yb[q][j].x : yb[q][j].y);
                        const float ylo = (k & 1) ? (__builtin_amdgcn_cvt_f32_fp8(wa_, 2) + __builtin_amdgcn_cvt_f32_fp8(wb_, 2)) : (__builtin_amdgcn_cvt_f32_fp8(wa_, 0) + __builtin_amdgcn_cvt_f32_fp8(wb_, 0));
                        const float yhi = (k & 1) ? (__builtin_amdgcn_cvt_f32_fp8(wa_, 3) + __builtin_amdgcn_cvt_f32_fp8(wb_, 3)) : (__builtin_amdgcn_cvt_f32_fp8(wa_, 1) + __builtin_amdgcn_cvt_f32_fp8(wb_, 1));
                        const float lo = bf2f(xv[q][j][k] & 0xffff) + ylo * (1.f / pg8::SY), hi = bf2f(xv[q][j][k] >> 16) + yhi * (1.f / pg8::SY);
                        s_ += lo * lo + hi * hi; o[k] = pk2(lo, hi); }
                    *(v4u*)(APLE + (size_t)(t + q) * APITCH + 256 + c) = o;
                    uint2 o8; o8.x = pg8::cvt4_fp8(bf2f(o[0] & 0xffff), bf2f(o[0] >> 16), bf2f(o[1] & 0xffff), bf2f(o[1] >> 16)); o8.y = pg8::cvt4_fp8(bf2f(o[2] & 0xffff), bf2f(o[2] >> 16), bf2f(o[3] & 0xffff), bf2f(o[3] >> 16));
                    *(uint2*)(A8 + (size_t)(t + q) * 1280 + 256 + c) = o8; }
                s_ = wave_sum(s_);
                if (lane == 0) r2[t + q] = rsqrtf(s_ * (1.f / D) + EPS); }
        }
        if (BOTH(8)) xcd_barrier(bar);
    }
    TS_E(8);
    TS_B(9);
    PHASE(9) {
        pg8::Gemm g{640, 640, 640}; pg8::StaticOrder S; S.init(T, D, G, bx, A8, 640, WpleT, 640);
        pg8::EpiPle E{APLE, r2, X3, ssp3, (pg8::u32x4*)(ws + WS_SCR + (size_t)bx * 131072)};
        pg8::gemm_phase<pg8::EpiPle, pg8::StaticOrder, true, true>(lds, g, S, E);
        if (BOTH(9)) xcd_barrier(bar);
    }
    TS_E(9);
    TS_B(10);
    PHASE(10) {
        const int gw = vcu * NWAVES + wave, NGW = G * NWAVES; const float* gfin = args.in[24];
        for (int row = 2 * gw; row < T; row += 2 * NGW) {
            float ss0 = lane < 16 ? ssp3[(size_t)row * 16 + lane] : 0.f, ss1 = lane < 16 ? ssp3[(size_t)(row + 1) * 16 + lane] : 0.f;
            uint2 w[2][4];
#pragma unroll
            for (int j = 0; j < 4; ++j) { const int c = 4 * (lane + 64 * j); w[0][j] = *(const uint2*)(X3 + (size_t)row * D + c); w[1][j] = *(const uint2*)(X3 + (size_t)(row + 1) * D + c); }
            ss0 = wave_sum(ss0); ss1 = wave_sum(ss1);
            const float r0 = rsqrtf(ss0 * (1.f / D) + EPS), r1_ = rsqrtf(ss1 * (1.f / D) + EPS);
#pragma unroll
            for (int j = 0; j < 4; ++j) { const int c = 4 * (lane + 64 * j); const float4 gg = *(const float4*)(gfin + c);
                *(float4*)(args.out + (size_t)row * D + c) = make_float4(bf2f(w[0][j].x & 0xffff) * r0 * gg.x, bf2f(w[0][j].x >> 16) * r0 * gg.y, bf2f(w[0][j].y & 0xffff) * r0 * gg.z, bf2f(w[0][j].y >> 16) * r0 * gg.w);
                *(float4*)(args.out + (size_t)(row + 1) * D + c) = make_float4(bf2f(w[1][j].x & 0xffff) * r1_ * gg.x, bf2f(w[1][j].x >> 16) * r1_ * gg.y, bf2f(w[1][j].y & 0xffff) * r1_ * gg.z, bf2f(w[1][j].y >> 16) * r1_ * gg.w); }
        }
    }
    TS_E(10);
    if (PROBE_TS >= 0 && bx == 0 && tid == 0) { const unsigned long long t1_ = __builtin_amdgcn_s_memrealtime(); while (__builtin_amdgcn_s_memrealtime() - t1_ < 4ull * ts_acc_) __builtin_amdgcn_s_sleep(8); }
#undef MOE_TABLES
#undef IN
#undef BOTH
}


#ifndef OPT_UPTO
#define OPT_UPTO 11
#endif
extern "C" void kernel_launch(void* const* d_in, const int* in_sizes, int n_in, void* d_out, int out_size, void* d_ws, size_t ws_size, hipStream_t stream) {
    static int grid = 0;
    if (grid == 0) {
        if (n_in != 25 || in_sizes[0] != T * D || out_size != T * D || ws_size < WS_END2) { fprintf(stderr, "kernel_launch: unexpected shapes (n_in %d, in0 %d, out %d, ws %zu)\n", n_in, n_in > 0 ? in_sizes[0] : -1, out_size, ws_size); grid = -1; return; }
        int dev = 0, cus = 0, per_cu = 0;
        if (hipGetDevice(&dev) != hipSuccess || hipDeviceGetAttribute(&cus, hipDeviceAttributeMultiprocessorCount, dev) != hipSuccess) { fprintf(stderr, "kernel_launch: device query failed\n"); grid = -1; return; }
        if (hipFuncSetAttribute((const void*)mega, hipFuncAttributeMaxDynamicSharedMemorySize, LDS_BYTES) != hipSuccess) { fprintf(stderr, "kernel_launch: hipFuncSetAttribute failed\n"); grid = -1; return; }
        if (hipOccupancyMaxActiveBlocksPerMultiprocessor(&per_cu, (const void*)mega, NWAVES * 64, LDS_BYTES) != hipSuccess || per_cu < 1) { fprintf(stderr, "kernel_launch: occupancy query says %d blocks per CU\n", per_cu); (void)hipGetLastError(); grid = -1; return; }
        grid = cus;
    }
    if (grid < 0) return;
    const float* x = (const float*)d_in[0]; const float* p = (const float*)d_in[1];
    const float* conv_a_w = (const float*)d_in[4]; const float* w_out_a = (const float*)d_in[5]; const float* conv_b_w = (const float*)d_in[6]; const float* conv_b_b = (const float*)d_in[7];
    const float* ln_b_g = (const float*)d_in[8]; const float* ln_b_b = (const float*)d_in[9]; const float* w_out_b = (const float*)d_in[10];
    const float* w_o = (const float*)d_in[12]; const float* ffn_g = (const float*)d_in[13]; const float* w_rg = (const float*)d_in[14]; const float* b_rg = (const float*)d_in[15];
    const float* w_re = (const float*)d_in[16]; const float* b_re = (const float*)d_in[17]; const float* w_eg = (const float*)d_in[18]; const float* w_eu = (const float*)d_in[19];
    const float* w_ed = (const float*)d_in[20]; const float* ple_g = (const float*)d_in[21]; const float* w_pg = (const float*)d_in[22]; const float* w_pp = (const float*)d_in[23];
    const float* fin_g = (const float*)d_in[24];
    unsigned char* ws = (unsigned char*)d_ws; float* out = (float*)d_out;
    unsigned* ctl = (unsigned*)(ws + WS_CTL);
    int* tok_e = (int*)(ws + WS_TOK); float* tok_w = (float*)(ws + WS_TOK + 256 * 1024); int* tok_pos = (int*)(ws + WS_TOK + 512 * 1024);
    float* r1 = (float*)(ws + WS_TOK + 768 * 1024); float* r2 = (float*)(ws + WS_TOK + 896 * 1024);
    float* ssp1 = (float*)(ws + WS_SSP1); int* ltok = (int*)(ws + WS_LTOK); float* lw = (float*)(ws + WS_LW);
    bf16* UA = (bf16*)(ws + WS_RA); bf16* UB = (bf16*)(ws + WS_RB); bf16* AB = (bf16*)(ws + WS_RC); bf16* GA = (bf16*)(ws + WS_RD); bf16* GB = (bf16*)(ws + WS_RE);
    bf16* ZZ = (bf16*)d_out; bf16* MIX = (bf16*)(ws + WS_RC); float* X1 = (float*)(ws + WS_RA); bf16* APLE = (bf16*)(ws + WS_RA);
    bf16* HMID = (bf16*)(ws + WS_RC); bf16* YB = (bf16*)(ws + WS_RD); float* X3 = (float*)(ws + WS_RC);

    if (hipMemsetAsync(ws + WS_CTL, 0, 1 * MiB, stream) != hipSuccess) { fprintf(stderr, "kernel_launch: memset failed\n"); return; }
    Args a{};
    for (int i = 0; i < 25; ++i) a.in[i] = (const float*)d_in[i];
    a.out = out; a.ws = ws; a.ph_lo = 0; a.ph_hi = OPT_UPTO;
    void* kargs[] = {&a};
    const hipError_t le = hipLaunchCooperativeKernel((const void*)mega, dim3(grid), dim3(NWAVES * 64), kargs, LDS_BYTES, stream);
    if (le != hipSuccess) { fprintf(stderr, "kernel_launch: cooperative launch failed: %s (grid %d)\n", hipGetErrorString(le), grid); return; }
#if OPT_UPTO < 11
    if (OPT_UPTO <= 1) nv_inproj<<<dim3(T / 8, 4), 256, 0, stream>>>((const bf16*)d_out, (const float*)d_in[3], (const float*)d_in[11], UA, UB, AB, GA, GB);
    if (OPT_UPTO <= 2) nv_conv<<<T, 256, 0, stream>>>(UA, UB, AB, conv_a_w, conv_b_w, conv_b_b, ln_b_g, ln_b_b, ZZ);
    if (OPT_UPTO <= 3) nv_outab<<<dim3(T / 8, 4), 256, 0, stream>>>(ZZ, w_out_a, w_out_b, GA, GB, MIX);
    if (OPT_UPTO <= 4) { nv_wo<<<dim3(T / 8, 4), 256, 0, stream>>>(MIX, w_o, x, X1, APLE); nv_rowss<<<T / 4, 256, 0, stream>>>(X1, ssp1); }
    if (OPT_UPTO <= 5) { nv_router<<<T / 4, 256, 0, stream>>>(X1, ssp1, ffn_g, w_rg, b_rg, w_re, b_re, ctl + CW_CNT, tok_e, tok_w, tok_pos, r1, ltok, lw); nv_pcvt<<<T * PLE / 4 / 256, 256, 0, stream>>>(p, APLE); }
    if (OPT_UPTO <= 6) nv_moe_up<<<dim3(T / 8, NE), 256, 0, stream>>>(X1, r1, ffn_g, w_eg, w_eu, ctl + CW_CNT, ltok, HMID);
    if (OPT_UPTO <= 7) nv_moe_down<<<dim3(T / 8, NE), 256, 0, stream>>>(HMID, w_ed, ctl + CW_CNT, lw, YB);
    if (OPT_UPTO <= 8) nv_combine<<<T / 4, 256, 0, stream>>>(X1, YB, ctl + CW_CNT, tok_e, tok_pos, APLE, r2);
    if (OPT_UPTO <= 9) nv_ple<<<dim3(T / 8, 4), 256, 0, stream>>>(X1, r2, ple_g, w_pg, p, w_pp, X3);
    if (OPT_UPTO <= 10) nv_final<<<T / 4, 256, 0, stream>>>(X3, fin_g, out);
#endif
}
```
